# Optimizing an MI355X kernel written in HIP

```python
import jax, jax.numpy as jnp
from jax import lax
import numpy as np

D_MODEL = 1024
BATCH = 2
SEQ = 8192
DEPTH = 2

N_MIXERS = 2
NORM_EPS = 1e-5
DILATED_GROUPS = ((128, 1), (512, 4), (2048, 16))
N_GROUPS = len(DILATED_GROUPS)
ATTN_HEADS = 8
HEAD_DIM = D_MODEL // ATTN_HEADS
ATTN_WIDTH = ATTN_HEADS * HEAD_DIM
ATTN_IN = N_GROUPS * 3 * ATTN_WIDTH
ATTN_BLOCK = 128
ROPE_THETA = 10000.0
GLA_HEADS = 4
GLA_KEY_DIM = D_MODEL // 2
GLA_VAL_DIM = D_MODEL
GLA_DK = GLA_KEY_DIM // GLA_HEADS
GLA_DV = GLA_VAL_DIM // GLA_HEADS
GLA_GATE_RANK = 16
GLA_GATE_NORMALIZER = 16.0
GLA_CHUNK = 64
GLA_IN = 2 * GLA_KEY_DIM + 2 * GLA_VAL_DIM + GLA_GATE_RANK
D_FF = 4 * D_MODEL

kernel_name = "hybrid_dilated_attn_gla_sqrelu"


def rmsnorm(x, w):
    xf = x.astype(jnp.float32)
    y = xf * lax.rsqrt(jnp.mean(xf * xf, axis=-1, keepdims=True) + NORM_EPS)
    return (y * w.astype(jnp.float32)).astype(x.dtype)


def rope_tables(seq_len, dim):
    pos = jnp.arange(seq_len, dtype=jnp.float32)
    inv_freq = ROPE_THETA ** (-jnp.arange(0, dim, 2, dtype=jnp.float32) / dim)
    ang = pos[:, None] * inv_freq[None, :]
    return jnp.cos(ang), jnp.sin(ang)


def apply_rope(t, cos, sin):
    tf = t.astype(jnp.float32)
    half = tf.shape[-1] // 2
    t1, t2 = tf[..., :half], tf[..., half:]
    c = cos[None, :, None, :]
    s = sin[None, :, None, :]
    return jnp.concatenate([t1 * c - t2 * s, t2 * c + t1 * s], axis=-1)


def dilated_group_attention(q, k, v, dil, n_back):
    B, S, H, D = q.shape
    L = S // dil

    def to_res(t):
        return t.reshape(B, L, dil, H, D).transpose(0, 2, 3, 1, 4)

    C = min(ATTN_BLOCK, L)
    nb = -(-L // C)
    Lp = nb * C
    K = n_back + C
    qr = jnp.pad(to_res(q), ((0, 0), (0, 0), (0, 0), (0, Lp - L), (0, 0)))
    qr = qr.reshape(B, dil, H, nb, C, D)
    kv_pad = ((0, 0), (0, 0), (0, 0), (n_back, Lp - L), (0, 0))
    kr = jnp.pad(to_res(k), kv_pad)
    vr = jnp.pad(to_res(v), kv_pad)
    idx = jnp.arange(nb)[:, None] * C + jnp.arange(K)[None, :]
    kb = kr[:, :, :, idx, :]
    vb = vr[:, :, :, idx, :]
    s = jnp.einsum('bzhnqd,bzhnkd->bzhnqk', qr, kb)
    qi = jnp.arange(C)[:, None]
    kj = jnp.arange(K)[None, :]
    rel = qi - kj + n_back
    key_idx = jnp.arange(nb)[:, None, None] * C + kj[None] - n_back
    mask = (rel >= 0) & (rel <= n_back) & (key_idx >= 0)
    s = jnp.where(mask, s, -jnp.inf)
    m = jnp.max(s, axis=-1, keepdims=True)
    p = jnp.exp(s - m)
    l = jnp.sum(p, axis=-1)
    o = jnp.einsum('bzhnqk,bzhnkd->bzhnqd', p, vb) / l[..., None]
    lse = m[..., 0] + jnp.log(l)
    o = o.reshape(B, dil, H, Lp, D)[:, :, :, :L]
    o = o.transpose(0, 3, 1, 2, 4).reshape(B, S, H, D)
    lse = lse.reshape(B, dil, H, Lp)[:, :, :, :L]
    lse = lse.transpose(0, 3, 1, 2).reshape(B, S, H)
    return o, lse


def dilated_attention(h, w_in, w_out):
    B, S, _ = h.shape
    qkv = (h @ w_in).reshape(B, S, N_GROUPS, 3, ATTN_HEADS, HEAD_DIM)
    cos, sin = rope_tables(S, HEAD_DIM)
    outs, lses = [], []
    for g, (window, dil) in enumerate(DILATED_GROUPS):
        q = apply_rope(qkv[:, :, g, 0], cos, sin) * (HEAD_DIM ** -0.5)
        k = apply_rope(qkv[:, :, g, 1], cos, sin)
        v = qkv[:, :, g, 2].astype(jnp.float32)
        o_g, lse_g = dilated_group_attention(q, k, v, dil, window // dil)
        outs.append(o_g)
        lses.append(lse_g)
    alpha = jax.nn.softmax(jnp.stack(lses, axis=0), axis=0)
    o = jnp.sum(alpha[..., None] * jnp.stack(outs, axis=0), axis=0)
    return o.reshape(B, S, ATTN_WIDTH).astype(h.dtype) @ w_out


def gla_mixer(h, w_in, w_gate_up, b_gate, norm_w, w_out):
    B, S, _ = h.shape
    nc = S // GLA_CHUNK
    proj = h @ w_in
    s1 = GLA_KEY_DIM
    s2 = 2 * GLA_KEY_DIM
    s3 = s2 + GLA_VAL_DIM
    s4 = s3 + GLA_VAL_DIM
    q, k, v = proj[..., :s1], proj[..., s1:s2], proj[..., s2:s3]
    g_out, gate_lr = proj[..., s3:s4], proj[..., s4:]
    gk = gate_lr @ w_gate_up + b_gate
    log_a = jax.nn.log_sigmoid(gk.astype(jnp.float32)) / GLA_GATE_NORMALIZER

    def chunked(t, d):
        t = t.astype(jnp.float32).reshape(B, nc, GLA_CHUNK, GLA_HEADS, d)
        return t.transpose(0, 3, 1, 2, 4)

    qc = chunked(q, GLA_DK) * (GLA_DK ** -0.5)
    kc = chunked(k, GLA_DK)
    vc = chunked(v, GLA_DV)
    b = jnp.cumsum(chunked(log_a, GLA_DK), axis=-2)
    b_last = b[..., -1:, :]
    q_t = qc * jnp.exp(b)
    k_t = kc * jnp.exp(-b)
    causal = jnp.tril(jnp.ones((GLA_CHUNK, GLA_CHUNK), dtype=bool))
    A = jnp.where(causal, jnp.einsum('bhncd,bhnsd->bhncs', q_t, k_t), 0.0)
    o_intra = jnp.einsum('bhncs,bhnsv->bhncv', A, vc)
    U = jnp.einsum('bhncd,bhncv->bhndv', kc * jnp.exp(b_last - b), vc)
    decay = jnp.exp(b_last[..., 0, :])

    def step(state, inp):
        u, a = inp
        return a[..., None] * state + u, state

    init = jnp.zeros((B, GLA_HEADS, GLA_DK, GLA_DV), jnp.float32)
    _, s_prev = lax.scan(step, init, (jnp.moveaxis(U, 2, 0), jnp.moveaxis(decay, 2, 0)))
    s_prev = jnp.moveaxis(s_prev, 0, 2)
    o = o_intra + jnp.einsum('bhncd,bhndv->bhncv', q_t, s_prev)
    o = o.transpose(0, 2, 3, 1, 4).reshape(B, S, GLA_HEADS, GLA_DV)
    o = rmsnorm(o, norm_w)
    gate = jax.nn.silu(g_out.astype(jnp.float32)).reshape(B, S, GLA_HEADS, GLA_DV)
    o = (o * gate).reshape(B, S, GLA_VAL_DIM).astype(h.dtype)
    return o @ w_out


def sq_relu_mlp(h, w_up, w_down):
    a = jax.nn.relu(h @ w_up)
    return (a * a) @ w_down


def setup_inputs(seed: int = 0) -> dict:
    key = jax.random.key(seed)
    ks = jax.random.split(key, 16)
    n_attn = (DEPTH + 1) // N_MIXERS
    n_gla = DEPTH // N_MIXERS

    def w(k, shape, fan_in):
        return jax.random.normal(k, shape, jnp.float32) * (fan_in ** -0.5)

    def gain(k, shape):
        return 1.0 + 0.02 * jax.random.normal(k, shape, jnp.float32)

    return {
        "x": jax.random.normal(ks[0], (BATCH, SEQ, D_MODEL), jnp.float32),
        "norm_mix_w": gain(ks[1], (DEPTH, D_MODEL)),
        "norm_mlp_w": gain(ks[2], (DEPTH, D_MODEL)),
        "final_norm_w": gain(ks[3], (D_MODEL,)),
        "attn_w_in": w(ks[4], (n_attn, D_MODEL, ATTN_IN), D_MODEL),
        "attn_w_out": w(ks[5], (n_attn, ATTN_WIDTH, D_MODEL), ATTN_WIDTH),
        "gla_w_in": w(ks[6], (n_gla, D_MODEL, GLA_IN), D_MODEL),
        "gla_w_gate_up": w(ks[7], (n_gla, GLA_GATE_RANK, GLA_KEY_DIM), GLA_GATE_RANK),
        "gla_b_gate": 0.02 * jax.random.normal(ks[8], (n_gla, GLA_KEY_DIM), jnp.float32),
        "gla_norm_w": gain(ks[9], (n_gla, GLA_DV)),
        "gla_w_out": w(ks[10], (n_gla, GLA_VAL_DIM, D_MODEL), GLA_VAL_DIM),
        "mlp_w_up": w(ks[11], (DEPTH, D_MODEL, D_FF), D_MODEL),
        "mlp_w_down": w(ks[12], (DEPTH, D_FF, D_MODEL), D_FF),
    }


def reference(x, norm_mix_w, norm_mlp_w, final_norm_w, attn_w_in, attn_w_out,
              gla_w_in, gla_w_gate_up, gla_b_gate, gla_norm_w, gla_w_out,
              mlp_w_up, mlp_w_down):
    for i in range(DEPTH):
        h = rmsnorm(x, norm_mix_w[i])
        j = i // N_MIXERS
        if i % N_MIXERS == 0:
            x = x + dilated_attention(h, attn_w_in[j], attn_w_out[j])
        else:
            x = x + gla_mixer(h, gla_w_in[j], gla_w_gate_up[j], gla_b_gate[j],
                              gla_norm_w[j], gla_w_out[j])
        h = rmsnorm(x, norm_mlp_w[i])
        x = x + sq_relu_mlp(h, mlp_w_up[i], mlp_w_down[i])
    return rmsnorm(x, final_norm_w)
```

```cpp
#include <hip/hip_runtime.h>
#include <cstdio>
#include <cstdint>
#include <cmath>
#include <hip/hip_runtime.h>
#include <cstdio>
#include <cstdint>
namespace pg8 {
#define PG8_LAS __attribute__((address_space(3)))
typedef unsigned short bf16_t;
typedef short bf16x8 __attribute__((ext_vector_type(8)));
typedef _Float16 f16x8 __attribute__((ext_vector_type(8)));
typedef float f32x4 __attribute__((ext_vector_type(4)));
typedef unsigned u32x4 __attribute__((ext_vector_type(4)));
constexpr int BM = 256, BK = 64, HALF = 128, HTB = HALF * BK * 2  , STAGE_BYTES = 8 * HTB, NXCD = 8, WGM = 8;

__host__ __device__ __forceinline__ int lds_byte(int r, int c) { const int st = (r >> 4) * 2 + (c >> 5), rr = r & 15, cc = c & 31, ob = rr * 64 + cc * 2; return st * 1024 + (ob ^ (((ob >> 9) & 1) << 5)); }
__host__ __device__ __forceinline__ void stage_rc(int b, int& R, int& C) { const int st = b / 1024, sb = b % 1024, swz = sb ^ (((sb >> 9) & 1) << 5); R = (st >> 1) * 16 + swz / 64; C = (st & 1) * 32 + (swz % 64) / 2; }
__host__ __device__ __forceinline__ int perm32(int rho) { const int n = rho >> 4, i = rho & 15; return 8 * (i >> 2) + 4 * n + (i & 3); }

struct Unit { int pm, pn; };
struct Gemm { const bf16_t* A; const bf16_t* Bt; int M, N, K; };

struct StaticOrder {
    int nM, nN, nwg, G, c;
    __host__ __device__ void init(int M, int N, int G_, int c_) { nM = M / BM; nN = N / BM; nwg = nM * nN; G = G_; c = c_; }
    __host__ __device__ bool next(int i, Unit& u) const {
        const long L = (long)i * G + c; if (L >= nwg) return false;
        int wgid = (int)L; { const int q = nwg / NXCD, r = nwg % NXCD, xcd = wgid % NXCD, off = wgid / NXCD; wgid = (xcd < r ? xcd * (q + 1) : r * (q + 1) + (xcd - r) * q) + off; }
        const int nig = WGM * nN, gid = wgid / nig, fm = gid * WGM, gsz = (nM - fm) < WGM ? (nM - fm) : WGM;
        u.pm = fm + ((wgid % nig) % gsz); u.pn = (wgid % nig) / gsz; return true;
    }
    __device__ __forceinline__ void a_ready(const Unit&) const {}
    __device__ __forceinline__ void done(const Unit&) const {}
};

__device__ __forceinline__ unsigned cvt_pk_bf16(float lo, float hi) { unsigned r; asm volatile("v_cvt_pk_bf16_f32 %0, %1, %2" : "=v"(r) : "v"(lo), "v"(hi)); return r; }
typedef unsigned u32x2 __attribute__((ext_vector_type(2)));
typedef _Float16 h16x2 __attribute__((ext_vector_type(2)));
typedef float f32x2 __attribute__((ext_vector_type(2)));
__device__ __forceinline__ unsigned cvt_pk_h(float lo, float hi) { const f32x2 v = {lo, hi}; return __builtin_bit_cast(unsigned, __builtin_convertvector(v, h16x2)); }
constexpr int P_SEQ = 8192, P_DM = 1024, P_DFF = 4096, P_AH = 8, P_HD = 128;
constexpr int RSTD_LDS_OFF = 131072 + 512;
struct PlainOrder : StaticOrder { __device__ __forceinline__ void a_ready(const Unit&, int) const {} };
struct RstdOrder : StaticOrder {
    const float* ssq; PG8_LAS float* rl;
    __device__ __forceinline__ void a_ready(const Unit& u, int ui) const {
        int t = threadIdx.x; asm volatile("" : "+v"(t));
        const int row = t >> 1, hf = t & 1;
        const f32x4* p = (const f32x4*)(ssq + (size_t)(u.pm * BM + row) * 16 + hf * 8); const f32x4 a = p[0], b = p[1];
        float s = ((a[0] + a[1]) + (a[2] + a[3])) + ((b[0] + b[1]) + (b[2] + b[3])); s += __shfl_xor(s, 1);
        if (hf == 0) rl[(ui & 1) * 256 + row] = 1.0f / sqrtf(s * (1.0f / 1024.0f) + 1e-5f);
    }
};
__device__ __forceinline__ void row_rstd(const PG8_LAS float* rl, int ui, int wr, int fr, float (&rs)[2][4]) {
#pragma unroll
    for (int ai = 0; ai < 2; ++ai)
#pragma unroll
        for (int m = 0; m < 4; ++m) rs[ai][m] = rl[(ui & 1) * 256 + ai * HALF + wr * 64 + m * 16 + fr];
}
__device__ __forceinline__ u32x4 pack8h(const f32x4 a, const f32x4 b) { u32x4 w; w.x = cvt_pk_h(a[0], a[1]); w.y = cvt_pk_h(a[2], a[3]); w.z = cvt_pk_h(b[0], b[1]); w.w = cvt_pk_h(b[2], b[3]); return w; }
__device__ __forceinline__ u32x4 pack8(const f32x4 a, const f32x4 b) { u32x4 w; w.x = cvt_pk_bf16(a[0], a[1]); w.y = cvt_pk_bf16(a[2], a[3]); w.z = cvt_pk_bf16(b[0], b[1]); w.w = cvt_pk_bf16(b[2], b[3]); return w; }

struct EpiQKV {
    static constexpr bool PERM = true, AFTER_DRAIN = false;
    bf16_t* Q; bf16_t* K; bf16_t* V; const PG8_LAS float* rl; const float* cosT; const float* sinT; int ldil;
    __device__ __forceinline__ void operator()(const f32x4 (&acc)[2][2][4][2], const Unit& u, int wr, int wc, int fr, int fq, int ui) const {
        const int row0 = u.pm * BM + wr * 64 + fr;
        float rs[2][4]; row_rstd(rl, ui, wr, fr, rs);
        const int which = u.pn >> 2, hp = u.pn & 3, dmask = (1 << ldil) - 1, L = P_SEQ >> ldil;
        if (which < 2) {
            bf16_t* dst = which == 0 ? Q : K;
            const int head = 2 * hp + (wc >> 1), d0 = 32 * (wc & 1) + 8 * fq;
#pragma unroll
            for (int ai = 0; ai < 2; ++ai)
#pragma unroll
                for (int m = 0; m < 4; ++m) { const int row = row0 + ai * HALF + m * 16, b = row >> 13, t = row & (P_SEQ - 1), r = t & dmask, i = t >> ldil;
                    bf16_t* p = dst + ((size_t)((((b * P_AH + head) << ldil) + r)) * L + i) * P_HD + d0;
                    const float* ct = cosT + t * 64 + d0; const float* st = sinT + t * 64 + d0;
                    const f32x4 c0 = *(const f32x4*)ct, c1 = *(const f32x4*)(ct + 4), s0 = *(const f32x4*)st, s1 = *(const f32x4*)(st + 4);
                    const float sc = rs[ai][m];
                    const f32x4 x1a = acc[ai][0][m][0] * sc, x1b = acc[ai][0][m][1] * sc, x2a = acc[ai][1][m][0] * sc, x2b = acc[ai][1][m][1] * sc;
                    const f32x4 o1a = x1a * c0 - x2a * s0, o1b = x1b * c1 - x2b * s1, o2a = x2a * c0 + x1a * s0, o2b = x2b * c1 + x1b * s1;
                    *(u32x4*)p = pack8h(o1a, o1b); *(u32x4*)(p + 64) = pack8h(o2a, o2b);
                    if (m & 1) asm volatile("" ::: "memory"); }
        } else {
            const int dd = 32 * wc + 8 * fq;
#pragma unroll
            for (int ai = 0; ai < 2; ++ai)
#pragma unroll
                for (int m = 0; m < 4; ++m) { const int row = row0 + ai * HALF + m * 16, b = row >> 13, t = row & (P_SEQ - 1), r = t & dmask, i = t >> ldil;
                    const float sc = rs[ai][m];
#pragma unroll
                    for (int bj = 0; bj < 2; ++bj) { const int head = 2 * hp + bj;
                        bf16_t* p = V + ((size_t)((((b * P_AH + head) << ldil) + r)) * L + i) * P_HD + dd;
                        *(u32x4*)p = pack8h(acc[ai][bj][m][0] * sc, acc[ai][bj][m][1] * sc); } }
        }
    }
};
struct EpiResid {
    static constexpr bool PERM = false, AFTER_DRAIN = false;
    const float* resid; float* out; bf16_t* xb; float* ssq;
    __device__ __forceinline__ void operator()(const f32x4 (&acc)[2][2][4][2], const Unit& u, int wr, int wc, int fr, int fq, int ui) const {
        const int row0 = u.pm * BM + wr * 64 + fr, col0 = u.pn * BM + wc * 32 + 4 * fq;
#pragma unroll
        for (int ai = 0; ai < 2; ++ai)
#pragma unroll
            for (int m = 0; m < 4; ++m) { const int row = row0 + ai * HALF + m * 16; const size_t off = (size_t)row * P_DM + col0; float s = 0.f;
#pragma unroll
                for (int bj = 0; bj < 2; ++bj)
#pragma unroll
                    for (int n = 0; n < 2; ++n) { const f32x4 v = acc[ai][bj][m][n] + *(const f32x4*)(resid + off + bj * HALF + n * 16);
                        *(f32x4*)(out + off + bj * HALF + n * 16) = v; s += (v[0] * v[0] + v[1] * v[1]) + (v[2] * v[2] + v[3] * v[3]);
                        u32x2 w; w.x = cvt_pk_h(v[0], v[1]); w.y = cvt_pk_h(v[2], v[3]); *(u32x2*)(xb + off + bj * HALF + n * 16) = w; }
                s += __shfl_xor(s, 16); s += __shfl_xor(s, 32);
                if (fq == 0) ssq[(size_t)row * 16 + u.pn * 4 + wc] = s;
                asm volatile("" ::: "memory"); }
    }
};
struct EpiUp {
    static constexpr bool PERM = true, AFTER_DRAIN = false;
    bf16_t* H; const PG8_LAS float* rl;
    __device__ __forceinline__ void operator()(const f32x4 (&acc)[2][2][4][2], const Unit& u, int wr, int wc, int fr, int fq, int ui) const {
        const int row0 = u.pm * BM + wr * 64 + fr, col0 = u.pn * BM + wc * 32 + 8 * fq;
        float rs[2][4]; row_rstd(rl, ui, wr, fr, rs);
#pragma unroll
        for (int ai = 0; ai < 2; ++ai)
#pragma unroll
            for (int m = 0; m < 4; ++m) { bf16_t* rowp = H + (size_t)(row0 + ai * HALF + m * 16) * P_DFF + col0; const float sc = rs[ai][m];
#pragma unroll
                for (int bj = 0; bj < 2; ++bj) { f32x4 v0 = acc[ai][bj][m][0] * sc, v1 = acc[ai][bj][m][1] * sc;
                    v0 = __builtin_elementwise_max(v0, (f32x4){0.f, 0.f, 0.f, 0.f}); v1 = __builtin_elementwise_max(v1, (f32x4){0.f, 0.f, 0.f, 0.f});
                    const f32x4 cap = {65504.f, 65504.f, 65504.f, 65504.f};
                    *(u32x4*)(rowp + bj * HALF) = pack8h(__builtin_elementwise_min(v0 * v0, cap), __builtin_elementwise_min(v1 * v1, cap)); } }
    }
};
struct EpiGla {
    static constexpr bool PERM = true, AFTER_DRAIN = false;
    bf16_t* q; bf16_t* k; bf16_t* v; bf16_t* g; const PG8_LAS float* rl;
    __device__ __forceinline__ void operator()(const f32x4 (&acc)[2][2][4][2], const Unit& u, int wr, int wc, int fr, int fq, int ui) const {
        const int row0 = u.pm * BM + wr * 64 + fr;
        float rs[2][4]; row_rstd(rl, ui, wr, fr, rs);
        bf16_t* dst; int ld, coff;
        if (u.pn < 2) { dst = q; ld = 512; coff = u.pn * 256; } else if (u.pn < 4) { dst = k; ld = 512; coff = (u.pn - 2) * 256; }
        else if (u.pn < 8) { dst = v; ld = 1024; coff = (u.pn - 4) * 256; } else { dst = g; ld = 1024; coff = (u.pn - 8) * 256; }
        const int col0 = coff + wc * 32 + 8 * fq;
#pragma unroll
        for (int ai = 0; ai < 2; ++ai)
#pragma unroll
            for (int m = 0; m < 4; ++m) { bf16_t* rowp = dst + (size_t)(row0 + ai * HALF + m * 16) * ld + col0; const float sc = rs[ai][m];
#pragma unroll
                for (int bj = 0; bj < 2; ++bj) *(u32x4*)(rowp + bj * HALF) = pack8(acc[ai][bj][m][0] * sc, acc[ai][bj][m][1] * sc); }
    }
};
template <class Epi, class Sched, bool ALIGN_EPI = false, bool SP2 = false>
__device__ __forceinline__ void gemm_phase(PG8_LAS unsigned char* lds, const Gemm g, const Sched& S, const Epi& E) {
    int tid_ = threadIdx.x; asm volatile("" : "+v"(tid_));
    const int tid = tid_, wid = __builtin_amdgcn_readfirstlane(tid >> 6), lane = tid & 63, wr = wid >> 2, wc = wid & 3, fr = lane & 15, fq = lane >> 4;
    const int K = g.K, nt = K / BK;
    unsigned voffA[2], voffB[2];
#pragma unroll
    for (int i = 0; i < 2; ++i) { int R, C; stage_rc(tid * 16 + i * 8192, R, C); const int Rb = Epi::PERM ? ((R & ~31) + perm32(R & 31)) : R;
        voffA[i] = (unsigned)(R * K + C) * 2u; voffB[i] = (unsigned)(Rb * K + C) * 2u; }
    const size_t kstep = (size_t)(BK * 2);
    const size_t hstep = (size_t)HALF * K * 2;
    const size_t tstep = 2 * hstep;
    const unsigned ldsw = (unsigned)wid * 1024u;
    const int aoff = lds_byte(wr * 64 + fr, fq * 8), boff = lds_byte(wc * 32 + fr, fq * 8);
#define PG8_SA(b, h) (((b) * 2 + (h)) * HTB)
#define PG8_SB(b, h) ((4 + (b) * 2 + (h)) * HTB)
#define PG8_STAGE(bufoff, gbase, voff) do { _Pragma("unroll") for (int _i = 0; _i < 2; ++_i) \
        __builtin_amdgcn_global_load_lds((const unsigned*)((const char*)(gbase) + (voff)[_i]), (PG8_LAS unsigned*)(lds + (bufoff) + ldsw + _i * 8192), 16, 0, 0); } while (0)
#define PG8_LDA(dst, b, h) do { _Pragma("unroll") for (int m = 0; m < 4; ++m) _Pragma("unroll") for (int k = 0; k < 2; ++k) dst[m][k] = *(const PG8_LAS bf16x8*)(lds + PG8_SA(b, h) + aoff + m * 2048 + k * 1024); } while (0)
#define PG8_LDB(dst, b, h) do { _Pragma("unroll") for (int n = 0; n < 2; ++n) _Pragma("unroll") for (int k = 0; k < 2; ++k) dst[n][k] = *(const PG8_LAS bf16x8*)(lds + PG8_SB(b, h) + boff + n * 2048 + k * 1024); } while (0)
#define PG8_MMA(ai, bj, At, Bt) do { __builtin_amdgcn_s_setprio(1); _Pragma("unroll") for (int m = 0; m < 4; ++m) _Pragma("unroll") for (int n = 0; n < 2; ++n) _Pragma("unroll") for (int k = 0; k < 2; ++k) \
        acc[ai][bj][m][n] = __builtin_amdgcn_mfma_f32_16x16x32_f16(__builtin_bit_cast(f16x8, Bt[n][k]), __builtin_bit_cast(f16x8, At[m][k]), acc[ai][bj][m][n], 0, 0, 0); __builtin_amdgcn_s_setprio(0); } while (0)
#define PG8_WAIT_V(n) asm volatile("s_waitcnt vmcnt(" #n ")" ::: "memory")
#define PG8_WAIT_L(n) asm volatile("s_waitcnt lgkmcnt(" #n ")" ::: "memory")
#define PG8_BAR __builtin_amdgcn_s_barrier()
#define PG8_SCHED __builtin_amdgcn_sched_barrier(0)
    Unit cur, nxt; int ui = 0;
    if (!S.next(0, cur)) return;
    f32x4 acc[2][2][4][2];
#pragma unroll
    for (int a = 0; a < 2; ++a)
#pragma unroll
        for (int b = 0; b < 2; ++b)
#pragma unroll
            for (int m = 0; m < 4; ++m)
#pragma unroll
                for (int n = 0; n < 2; ++n) acc[a][b][m][n] = (f32x4){0.f, 0.f, 0.f, 0.f};
    bf16x8 At[4][2], B0[2][2], B1[2][2];
    const char* cA = (const char*)g.A + (size_t)cur.pm * tstep; const char* cB = (const char*)g.Bt + (size_t)cur.pn * tstep;
    S.a_ready(cur, 0);
    if constexpr (SP2) {
        PG8_STAGE(PG8_SB(0, 0), cB, voffB); PG8_STAGE(PG8_SB(0, 1), cB + hstep, voffB); PG8_STAGE(PG8_SA(0, 0), cA, voffA); PG8_STAGE(PG8_SA(0, 1), cA + hstep, voffA);
        if (wr == 1) PG8_BAR;
        PG8_WAIT_V(2); PG8_BAR;
        PG8_STAGE(PG8_SB(1, 0), cB + kstep, voffB); PG8_STAGE(PG8_SA(1, 0), cA + kstep, voffA); PG8_STAGE(PG8_SB(1, 1), cB + hstep + kstep, voffB);
        PG8_WAIT_V(6); PG8_BAR;
    } else {
        PG8_STAGE(PG8_SB(0, 0), cB, voffB); PG8_STAGE(PG8_SA(0, 0), cA, voffA); PG8_STAGE(PG8_SB(0, 1), cB + hstep, voffB); PG8_STAGE(PG8_SA(0, 1), cA + hstep, voffA);
        if (wr == 1) PG8_BAR;
        PG8_WAIT_V(4); PG8_BAR;
        PG8_STAGE(PG8_SB(1, 0), cB + kstep, voffB); PG8_STAGE(PG8_SA(1, 0), cA + kstep, voffA); PG8_STAGE(PG8_SB(1, 1), cB + hstep + kstep, voffB);
        PG8_WAIT_V(6); PG8_BAR;
    }
    for (;;) {
        const bool has_next = S.next(ui + 1, nxt);
        const char* nA = has_next ? (const char*)g.A + (size_t)nxt.pm * tstep : cA; const char* nB = has_next ? (const char*)g.Bt + (size_t)nxt.pn * tstep : cB;
        for (int t = 0; t < nt; t += 2) {
            const bool last = (t == nt - 2);
            const char* a1 = cA + (size_t)(t + 1) * kstep;
            const char* a2 = last ? nA : cA + (size_t)(t + 2) * kstep; const char* b2 = last ? nB : cB + (size_t)(t + 2) * kstep;
            const char* a3 = a2 + kstep; const char* b3 = b2 + kstep;
            if (last && has_next) S.a_ready(nxt, ui + 1);
            if constexpr (SP2) {
            PG8_LDB(B0, 0, 0); PG8_LDB(B1, 0, 1); PG8_SCHED; PG8_LDA(At, 0, 0); PG8_STAGE(PG8_SA(1, 1), a1 + hstep, voffA);
            PG8_WAIT_V(8); PG8_WAIT_L(0); PG8_BAR; PG8_MMA(0, 0, At, B0); PG8_MMA(0, 1, At, B1); PG8_BAR; PG8_SCHED;
            PG8_LDA(At, 0, 1); PG8_STAGE(PG8_SB(0, 0), b2, voffB); PG8_STAGE(PG8_SB(0, 1), b2 + hstep, voffB); PG8_STAGE(PG8_SA(0, 0), a2, voffA);
            PG8_WAIT_V(8); PG8_WAIT_L(0); PG8_BAR; PG8_MMA(1, 0, At, B0); PG8_MMA(1, 1, At, B1); PG8_BAR; PG8_SCHED;
            PG8_LDB(B0, 1, 0); PG8_LDB(B1, 1, 1); PG8_SCHED; PG8_LDA(At, 1, 0); PG8_STAGE(PG8_SA(0, 1), a2 + hstep, voffA);
            PG8_WAIT_V(8); PG8_WAIT_L(0); PG8_BAR; PG8_MMA(0, 0, At, B0); PG8_MMA(0, 1, At, B1); PG8_BAR; PG8_SCHED;
            PG8_LDA(At, 1, 1); PG8_STAGE(PG8_SB(1, 0), b3, voffB); PG8_STAGE(PG8_SB(1, 1), b3 + hstep, voffB); PG8_STAGE(PG8_SA(1, 0), a3, voffA);
            PG8_WAIT_V(8); PG8_WAIT_L(0); PG8_BAR; PG8_MMA(1, 0, At, B0); PG8_MMA(1, 1, At, B1); PG8_BAR; PG8_SCHED;
            } else {
            PG8_LDB(B0, 0, 0); PG8_SCHED; PG8_LDA(At, 0, 0); PG8_STAGE(PG8_SA(1, 1), a1 + hstep, voffA);
            PG8_WAIT_L(8); PG8_BAR; PG8_WAIT_L(0); PG8_MMA(0, 0, At, B0); PG8_BAR; PG8_SCHED;
            PG8_LDB(B1, 0, 1); PG8_STAGE(PG8_SB(0, 0), b2, voffB);
            PG8_BAR; PG8_WAIT_L(0); PG8_MMA(0, 1, At, B1); PG8_BAR;
            PG8_LDA(At, 0, 1); PG8_STAGE(PG8_SA(0, 0), a2, voffA);
            PG8_BAR; PG8_WAIT_L(0); PG8_MMA(1, 0, At, B0); PG8_BAR; PG8_SCHED;
            PG8_STAGE(PG8_SB(0, 1), b2 + hstep, voffB);
            PG8_WAIT_V(6); PG8_BAR; PG8_MMA(1, 1, At, B1); PG8_BAR;
            PG8_LDB(B0, 1, 0); PG8_SCHED; PG8_LDA(At, 1, 0); PG8_STAGE(PG8_SA(0, 1), a2 + hstep, voffA);
            PG8_WAIT_L(8); PG8_BAR; PG8_WAIT_L(0); PG8_MMA(0, 0, At, B0); PG8_BAR; PG8_SCHED;
            PG8_LDB(B1, 1, 1); PG8_STAGE(PG8_SB(1, 0), b3, voffB);
            PG8_BAR; PG8_WAIT_L(0); PG8_MMA(0, 1, At, B1); PG8_BAR;
            PG8_LDA(At, 1, 1); PG8_STAGE(PG8_SA(1, 0), a3, voffA);
            PG8_BAR; PG8_WAIT_L(0); PG8_MMA(1, 0, At, B0); PG8_BAR; PG8_SCHED;
            PG8_STAGE(PG8_SB(1, 1), b3 + hstep, voffB);
            PG8_WAIT_V(6); PG8_BAR; PG8_MMA(1, 1, At, B1); PG8_BAR;
            }
        }
        if constexpr (ALIGN_EPI) { if (wr == 0) PG8_BAR; }
        if constexpr (!Epi::AFTER_DRAIN) { E(acc, cur, wr, wc, fr, fq, ui); S.done(cur); }
        if (!has_next) break;
#pragma unroll
        for (int a = 0; a < 2; ++a)
#pragma unroll
            for (int b = 0; b < 2; ++b)
#pragma unroll
                for (int m = 0; m < 4; ++m)
#pragma unroll
                    for (int n = 0; n < 2; ++n) acc[a][b][m][n] = (f32x4){0.f, 0.f, 0.f, 0.f};
        cur = nxt; cA = nA; cB = nB; ++ui;
        if constexpr (ALIGN_EPI) { if (wr == 1) PG8_BAR; }
    }
    PG8_WAIT_V(0);
    if constexpr (!ALIGN_EPI) { if (wr == 0) PG8_BAR; }
    PG8_BAR;
    if constexpr (Epi::AFTER_DRAIN) { E.fused(acc, cur, wr, wc, fr, fq, lds, wid, lane); S.done(cur); }
#undef PG8_SA
#undef PG8_SB
#undef PG8_STAGE
#undef PG8_LDA
#undef PG8_LDB
#undef PG8_MMA
#undef PG8_WAIT_V
#undef PG8_WAIT_L
#undef PG8_BAR
#undef PG8_SCHED
}
}
#define GAS __attribute__((address_space(1)))
#define LAS __attribute__((address_space(3)))
typedef unsigned short bf16;
typedef unsigned v4u __attribute__((ext_vector_type(4)));
typedef float f32x4 __attribute__((ext_vector_type(4)));
typedef short bf16x8 __attribute__((ext_vector_type(8)));
typedef GAS unsigned gu32;
typedef GAS unsigned long long gu64;
#define RLX_AGENT __ATOMIC_RELAXED, __HIP_MEMORY_SCOPE_AGENT
#define LDS_WAIT() asm volatile("s_waitcnt lgkmcnt(0)" ::: "memory")
#define VM_WAIT() asm volatile("s_waitcnt vmcnt(0)" ::: "memory")
__device__ __forceinline__ unsigned long long rt() { return __builtin_amdgcn_s_memrealtime(); }
__device__ __forceinline__ unsigned f2bf(float f) { unsigned u = __builtin_bit_cast(unsigned, f); return (u + 0x7fffu + ((u >> 16) & 1u)) >> 16; }
__device__ __forceinline__ unsigned pk2(float lo, float hi) { return f2bf(lo) | (f2bf(hi) << 16); }

#define XB_TMO      128
#define XB_XCNT(j)  (256  + 64 * (j))
#define XB_XSUB(j)  (1280 + 64 * (j))
#define XB_XGEN(j)  (2304 + 64 * (j))
#define XB_TOP      3328
#define XB_TOPGEN   3392
#define XCD_BAR_WORDS 3456
#define XB_SPIN_CAP (1u << 18)

__device__ __forceinline__ unsigned xb_ld(unsigned* p)              { return __hip_atomic_load(p, __ATOMIC_RELAXED, __HIP_MEMORY_SCOPE_AGENT); }
__device__ __forceinline__ unsigned xb_add(unsigned* p, unsigned v) { return __hip_atomic_fetch_add(p, v, __ATOMIC_RELAXED, __HIP_MEMORY_SCOPE_AGENT); }
__device__ __forceinline__ unsigned xb_xcc_id() { return (unsigned)__builtin_amdgcn_s_getreg((3 << 11) | 20) & 0xFu; }
#define XB_SPIN(cond, bar) do { unsigned _sp = 0; while (cond) { __builtin_amdgcn_s_sleep(1); \
    if ((++_sp & 255u) == 0u) { if (xb_ld(&(bar)[XB_TMO])) break; if (_sp > XB_SPIN_CAP) { atomicAdd(&(bar)[XB_TMO], 1u); break; } } } } while (0)

struct XcdBarrier {
    unsigned* bar; unsigned x;
    volatile LAS unsigned* st;
};

__device__ __forceinline__ XcdBarrier xcd_barrier_post(unsigned* bar, volatile LAS unsigned* st) {
    XcdBarrier b; b.bar = bar; b.x = xb_xcc_id(); b.st = st;
    if (threadIdx.x == 0) (void)xb_add(&bar[XB_XCNT(b.x)], 1u);
    return b;
}
__device__ __forceinline__ void xcd_barrier_complete(unsigned* bar, unsigned x, unsigned& nloc, unsigned& nx) {
    const unsigned G = gridDim.x * gridDim.y * gridDim.z;
    unsigned sum, cnt, mine, sp = 0u;
    for (;;) {
        sum = 0u; cnt = 0u; mine = 0u;
#pragma unroll
        for (unsigned j = 0; j < 16; ++j) { const unsigned c = xb_ld(&bar[XB_XCNT(j)]); sum += c; cnt += (c > 0u) ? 1u : 0u; mine = (j == x) ? c : mine; }
        if (sum == G) break;
        __builtin_amdgcn_s_sleep(1);
        if ((++sp & 255u) == 0u) { if (xb_ld(&bar[XB_TMO])) break; if (sp > XB_SPIN_CAP) { atomicAdd(&bar[XB_TMO], 1u); break; } }
    }
    nloc = mine > 0u ? mine : 1u; nx = cnt > 0u ? cnt : 1u;
}

__device__ __forceinline__ void xcd_barrier(const XcdBarrier& b) {
    asm volatile("s_waitcnt vmcnt(0)" ::: "memory");
    __syncthreads();
    if (threadIdx.x == 0) {
        unsigned* bar = b.bar;
        __builtin_amdgcn_s_waitcnt(0);
        unsigned nloc = b.st[0], nx = b.st[1];
        if (nloc == 0u) { xcd_barrier_complete(bar, b.x, nloc, nx); b.st[0] = nloc; b.st[1] = nx; }
        const unsigned old = xb_add(&bar[XB_XSUB(b.x)], 1u);
        const unsigned gen = old / nloc;
        if (old + 1u == (gen + 1u) * nloc) {
            __builtin_amdgcn_fence(__ATOMIC_RELEASE, "agent");
            asm volatile("s_waitcnt vmcnt(0)" ::: "memory");
            const unsigned og = xb_add(&bar[XB_TOP], 1u);
            const unsigned tg = og / nx;
            if (og + 1u == (tg + 1u) * nx) xb_add(&bar[XB_TOPGEN], 1u);
            else XB_SPIN(xb_ld(&bar[XB_TOPGEN]) == tg, bar);
            __builtin_amdgcn_fence(__ATOMIC_ACQUIRE, "agent");
            xb_add(&bar[XB_XGEN(b.x)], 1u);
            asm volatile("s_waitcnt vmcnt(0)" ::: "memory");
        } else {
            XB_SPIN(xb_ld(&bar[XB_XGEN(b.x)]) == gen, bar);
            __builtin_amdgcn_fence(__ATOMIC_ACQUIRE, "agent");
            asm volatile("s_waitcnt vmcnt(0)" ::: "memory");
        }
    }
    __syncthreads();
}

constexpr int NWAVES = 8;
constexpr int BATCH = 2, SEQ = 8192, DM = 1024, MTOK = BATCH * SEQ, DFF = 4096;
constexpr int NGRP = 3, AH = 8, HD = 128, AIN = 9216;
constexpr int GH = 4, GDK = 128, GDV = 256, GKD = 512, GVD = 1024, GRANK = 16, GIN = 3088, GCH = 64;
constexpr float EPS = 1e-5f;
__host__ __device__ constexpr int grp_ldil(int g) { return g == 0 ? 0 : (g == 1 ? 2 : 4); }

constexpr size_t MiB = 1u << 20;
constexpr size_t WS_CTL = 0, CTL_ZERO_BYTES = 1 * MiB;
constexpr size_t WS_SSQ = 1 * MiB;
constexpr size_t WS_LSE = 2 * MiB;
constexpr size_t WS_COS = 3 * MiB, WS_SIN = 5 * MiB;
constexpr size_t WS_WG = 7 * MiB;
constexpr size_t WS_WQKV = 8 * MiB, WS_WO0 = 26 * MiB, WS_WUP0 = 28 * MiB, WS_WDN0 = 36 * MiB;
constexpr size_t WS_WGLA = 44 * MiB, WS_WO1 = 50 * MiB, WS_WUP1 = 52 * MiB, WS_WDN1 = 60 * MiB;
constexpr size_t WS_XB = 68 * MiB;
constexpr size_t WS_Q = 100 * MiB, WS_K = 132 * MiB, WS_V = 164 * MiB;
constexpr size_t WS_OM = 196 * MiB;
constexpr size_t WS_H = 100 * MiB;
constexpr size_t WS_GQ = 100 * MiB, WS_GK = 116 * MiB, WS_GV = 132 * MiB, WS_GG = 164 * MiB;
constexpr size_t WS_GB = 196 * MiB;
constexpr size_t WS_GS = 8 * MiB;
constexpr size_t WS_XB1 = 8 * MiB;
constexpr size_t WS_GD = 228 * MiB;
constexpr size_t WS_END = 256 * MiB;
constexpr int CW_TMO = 0, CW_CODE = 1, CW_BAR = 4096;

constexpr int RING_OFF = 0, RING_BYTES = 131072;
constexpr int LDSCTL_OFF = RING_BYTES, MISC_OFF = LDSCTL_OFF + 320;
constexpr int LDS_BYTES = 147456;
constexpr int GLR_LDS_OFF = 131072 + 512 + 2048;
static_assert(MISC_OFF + 128 <= LDS_BYTES, "LDS map");

enum Phase { PH_PRO = 0, PH_QKV0 = 1, PH_ATT0 = 2, PH_QKV1 = 3, PH_ATT1 = 4, PH_QKV2 = 5, PH_ATT2 = 6, PH_WO0 = 7, PH_UP0 = 8, PH_DN0 = 9,
             PH_GLAP = 10, PH_GLA1 = 11, PH_GLA2 = 12, PH_GLA3 = 13, PH_WO1 = 14, PH_UP1 = 15, PH_DN1 = 16, PH_FIN = 17, PH_N = 18 };

struct Frame {
    LAS unsigned char* lds;
    volatile LAS unsigned* MISC;
    gu32* ctl;
    int tid, lane, wave;
    int vcu, G;
};
__device__ __forceinline__ float wave_sum(float v) {
#pragma unroll
    for (int o = 1; o < 64; o <<= 1) v += __shfl_xor(v, o);
    return v;
}
__device__ __forceinline__ float bf2f(unsigned short h) { return __builtin_bit_cast(float, (unsigned)h << 16); }
__device__ __forceinline__ unsigned pkh(float lo, float hi) { return pg8::cvt_pk_h(lo, hi); }
__device__ __forceinline__ float hlo(unsigned w) { return (float)__builtin_bit_cast(pg8::h16x2, w)[0]; }
__device__ __forceinline__ float hhi(unsigned w) { return (float)__builtin_bit_cast(pg8::h16x2, w)[1]; }
__device__ __forceinline__ float h2f(unsigned short h) { return (float)__builtin_bit_cast(_Float16, h); }

__device__ __forceinline__ void xpose_item(const float* W, int ldn, int K, const float* nw, bf16* WT, int dst_row0, int k0, int n0, int nvalid, LAS float* scr, int lane) {
    const bool cv = (lane & 31) < nvalid;
#pragma unroll 8
    for (int i = 0; i < 32; ++i) { const int kk = 2 * i + (lane >> 5); float w = cv ? W[(size_t)(k0 + kk) * ldn + n0 + (lane & 31)] : 0.f; if (nw) w *= nw[k0 + kk]; scr[kk * 33 + (lane & 31)] = w; }
    LDS_WAIT(); asm volatile("" ::: "memory");
    const int c = lane & 7;
#pragma unroll
    for (int j = 0; j < 4; ++j) { const int n = (lane >> 3) + 8 * j; const LAS float* s = scr + (8 * c) * 33 + n;
        v4u o; o.x = pkh(s[0 * 33], s[1 * 33]); o.y = pkh(s[2 * 33], s[3 * 33]); o.z = pkh(s[4 * 33], s[5 * 33]); o.w = pkh(s[6 * 33], s[7 * 33]);
        if (n < nvalid) *(GAS v4u*)(WT + (size_t)(dst_row0 + n) * K + k0 + 8 * c) = o; }
    LDS_WAIT(); asm volatile("" ::: "memory");
}
__device__ __forceinline__ void sincos_f(float x, float& s, float& c) {
    const float k = __builtin_rintf(x * 0.636619772f);
    float r = __builtin_fmaf(-k, 1.5703125f, x); r = __builtin_fmaf(-k, 0.0004837512969970703f, r); r = __builtin_fmaf(-k, 7.549533620476723e-08f, r); r = __builtin_fmaf(-k, 2.5632829192545614e-12f, r);
    const float r2 = r * r;
    const float sr = r + r * r2 * (-1.6666654611e-1f + r2 * (8.3321608736e-3f + r2 * -1.9515295891e-4f));
    const float cr = 1.0f - 0.5f * r2 + r2 * r2 * (4.166664568298827e-2f + r2 * (-1.388731625493765e-3f + r2 * 2.443315711809948e-5f));
    const int q = (int)k & 3;
    s = (q == 0) ? sr : (q == 1) ? cr : (q == 2) ? -sr : -cr;
    c = (q == 0) ? cr : (q == 1) ? -sr : (q == 2) ? -cr : sr;
}
__device__ const float ROPE_INVF[64] = {1.000000000e+00f, 8.659643531e-01f, 7.498942614e-01f, 6.493816376e-01f, 5.623413324e-01f, 4.869675338e-01f, 4.216965139e-01f, 3.651741147e-01f, 3.162277639e-01f, 2.738419771e-01f, 2.371373773e-01f, 2.053525001e-01f, 1.778279394e-01f, 1.539926529e-01f, 1.333521307e-01f, 1.154782027e-01f, 1.000000015e-01f, 8.659642935e-02f, 7.498941571e-02f, 6.493816525e-02f, 5.623413250e-02f, 4.869675264e-02f, 4.216965288e-02f, 3.651741147e-02f, 3.162277490e-02f, 2.738419734e-02f, 2.371373773e-02f, 2.053525113e-02f, 1.778279431e-02f, 1.539926510e-02f, 1.333521493e-02f, 1.154782064e-02f, 9.999999776e-03f, 8.659643121e-03f, 7.498941850e-03f, 6.493816152e-03f, 5.623413250e-03f, 4.869675264e-03f, 4.216964822e-03f, 3.651741194e-03f, 3.162277630e-03f, 2.738419687e-03f, 2.371373586e-03f, 2.053524833e-03f, 1.778279431e-03f, 1.539926510e-03f, 1.333521446e-03f, 1.154781901e-03f, 1.000000047e-03f, 8.659643354e-04f, 7.498942432e-04f, 6.493816618e-04f, 5.623413017e-04f, 4.869675322e-04f, 4.216965172e-04f, 3.651741426e-04f, 3.162277571e-04f, 2.738419571e-04f, 2.371373703e-04f, 2.053525095e-04f, 1.778279402e-04f, 1.539926452e-04f, 1.333521504e-04f, 1.154782003e-04f};

struct Args { const float* in[13]; float* out; unsigned char* ws; int ph_lo, ph_hi, li, skip_mask; };

__global__ void __launch_bounds__(NWAVES * 64, 2) mega_fwd(Args args) {
    extern __shared__ __attribute__((aligned(16))) unsigned char lds[];
    Frame F;
    F.lds = (LAS unsigned char*)lds;
    F.MISC = (volatile LAS unsigned*)(F.lds + MISC_OFF);
    F.tid = threadIdx.x; F.lane = F.tid & 63; F.wave = __builtin_amdgcn_readfirstlane(F.tid >> 6);
    F.G = gridDim.x; { const int bx = blockIdx.x; F.vcu = (F.G % 8 == 0) ? (bx % 8) * (F.G / 8) + bx / 8 : bx; }
    unsigned char* ws = args.ws;
    F.ctl = (gu32*)(ws + WS_CTL);
    for (int u = F.tid; u < (LDS_BYTES - LDSCTL_OFF) / 4; u += NWAVES * 64) ((LAS unsigned*)(F.lds + LDSCTL_OFF))[u] = 0u;
    __syncthreads();
    const bool multi = (args.ph_hi - args.ph_lo) > 1;
    XcdBarrier bar; bar.bar = (unsigned*)(F.ctl + CW_BAR) + args.li * XCD_BAR_WORDS; bar.x = 0; bar.st = nullptr;
    if (multi) bar = xcd_barrier_post((unsigned*)(F.ctl + CW_BAR) + args.li * XCD_BAR_WORDS, F.MISC + 8);

    const float* x_in = args.in[0];
    const float* norm_mix_w = args.in[1]; const float* norm_mlp_w = args.in[2]; const float* final_w = args.in[3];
    float* const xres = args.out;
    float* const ssq = (float*)(ws + WS_SSQ);
    bf16* const XB = (bf16*)(ws + WS_XB);
    const int gw = F.vcu * NWAVES + F.wave, NGW = F.G * NWAVES;
    LAS float* const rl = (LAS float*)(F.lds + pg8::RSTD_LDS_OFF);

    for (int ph = args.ph_lo; ph < args.ph_hi; ++ph) {
      int tid = threadIdx.x; asm volatile("" : "+v"(tid));
      const int lane = tid & 63;
      if (!((args.skip_mask >> ph) & 1)) {
        if (ph == PH_PRO) {
#ifndef NO_PRO
            LAS float* scr = (LAS float*)(F.lds + RING_OFF + F.wave * 16384);
            constexpr int I_QKV = 16 * 288, I_O = 16 * 32, I_UP = 16 * 128, I_DN = 64 * 32, I_GLA = 16 * 97;
            constexpr int NITEMS = I_QKV + 2 * I_O + 2 * I_UP + 2 * I_DN + I_GLA;
            for (int it = gw; it < NITEMS; it += NGW) {
                int r = it; const float* W; int ldn, K = DM, nvalid = 32, dst_row0, k0, n0; const float* nw = nullptr; bf16* WT;
                if (r < I_QKV) { const int kb = r / 288, nb = r % 288; n0 = nb * 32; const int nin = n0 % 3072, which = nin / 1024, j = nin % 1024;
                    const int jd = which < 2 ? ((j & ~0xC0) | ((j & 0x40) << 1) | ((j & 0x80) >> 1)) : j;
                    W = args.in[4]; ldn = AIN; nw = norm_mix_w; WT = (bf16*)(ws + WS_WQKV); dst_row0 = n0 - j + jd; k0 = kb * 64; }
                else if ((r -= I_QKV) < I_O) { W = args.in[5]; ldn = DM; WT = (bf16*)(ws + WS_WO0); n0 = dst_row0 = (r % 32) * 32; k0 = (r / 32) * 64; }
                else if ((r -= I_O) < I_O) { W = args.in[10]; ldn = DM; WT = (bf16*)(ws + WS_WO1); n0 = dst_row0 = (r % 32) * 32; k0 = (r / 32) * 64; }
                else if ((r -= I_O) < I_UP) { W = args.in[11]; ldn = DFF; nw = norm_mlp_w; WT = (bf16*)(ws + WS_WUP0); n0 = dst_row0 = (r % 128) * 32; k0 = (r / 128) * 64; }
                else if ((r -= I_UP) < I_UP) { W = args.in[11] + (size_t)DM * DFF; ldn = DFF; nw = norm_mlp_w + DM; WT = (bf16*)(ws + WS_WUP1); n0 = dst_row0 = (r % 128) * 32; k0 = (r / 128) * 64; }
                else if ((r -= I_UP) < I_DN) { W = args.in[12]; ldn = DM; K = DFF; WT = (bf16*)(ws + WS_WDN0); n0 = dst_row0 = (r % 32) * 32; k0 = (r / 32) * 64; }
                else if ((r -= I_DN) < I_DN) { W = args.in[12] + (size_t)DFF * DM; ldn = DM; K = DFF; WT = (bf16*)(ws + WS_WDN1); n0 = dst_row0 = (r % 32) * 32; k0 = (r / 32) * 64; }
                else { r -= I_DN; const int kb = r / 97, nb = r % 97; W = args.in[6]; ldn = GIN; nw = norm_mix_w + DM; k0 = kb * 64; n0 = nb * 32;
                    if (nb < 96) { WT = (bf16*)(ws + WS_WGLA); dst_row0 = n0; } else { WT = (bf16*)(ws + WS_WG); dst_row0 = 0; nvalid = 16; } }
                xpose_item(W, ldn, K, nw, WT, dst_row0, k0, n0, nvalid, scr, lane);
            }
            { float* cosT = (float*)(ws + WS_COS); float* sinT = (float*)(ws + WS_SIN);
              for (int e = blockIdx.x * (NWAVES * 64) + tid; e < SEQ * 64; e += F.G * NWAVES * 64) { const int pos = e >> 6, i = e & 63;
                  const float ang = (float)pos * ROPE_INVF[i]; float sn, cs; sincos_f(ang, sn, cs); cosT[e] = cs; sinT[e] = sn; } }
            for (int m = gw; m < MTOK; m += NGW) { const GAS f32x4* xr = (const GAS f32x4*)(x_in + (size_t)m * DM) + lane; float s = 0.f;
                GAS unsigned long long* o8 = (GAS unsigned long long*)(XB + (size_t)m * DM) + lane;
#pragma unroll
                for (int j = 0; j < 4; ++j) { const f32x4 v = xr[64 * j]; s += (v.x * v.x + v.y * v.y) + (v.z * v.z + v.w * v.w);
                    o8[64 * j] = (unsigned long long)pkh(v.x, v.y) | ((unsigned long long)pkh(v.z, v.w) << 32); }
                s = wave_sum(s); if (lane < 16) ssq[(size_t)m * 16 + lane] = lane == 0 ? s : 0.f; }
#endif
        }
        else if (ph == PH_QKV0 || ph == PH_QKV1 || ph == PH_QKV2) {
            const int g = (ph - PH_QKV0) >> 1;
            pg8::Gemm gm{XB, (const bf16*)(ws + WS_WQKV) + (size_t)g * 3072 * DM, MTOK, 3072, DM}; pg8::RstdOrder S; S.init(MTOK, 3072, F.G, (int)blockIdx.x); S.ssq = ssq; S.rl = rl;
            pg8::EpiQKV E{(bf16*)(ws + WS_Q), (bf16*)(ws + WS_K), (bf16*)(ws + WS_V), rl, (const float*)(ws + WS_COS), (const float*)(ws + WS_SIN), g == 0 ? 0 : (g == 1 ? 2 : 4)};
#ifndef NO_QKV
            pg8::gemm_phase<pg8::EpiQKV, pg8::RstdOrder, true, true>(F.lds + RING_OFF, gm, S, E);
#endif
        }
        else if (ph == PH_ATT0 || ph == PH_ATT1 || ph == PH_ATT2) {
        }
        else if (ph == PH_WO0 || ph == PH_DN0 || ph == PH_WO1 || ph == PH_DN1) {
            const bf16* A; const bf16* Bt; int K; const float* resid = xres; bf16* xbo = XB;
            if (ph == PH_WO0) { A = (const bf16*)(ws + WS_OM); Bt = (const bf16*)(ws + WS_WO0); K = DM; resid = x_in; }
            else if (ph == PH_DN0) { A = (const bf16*)(ws + WS_H); Bt = (const bf16*)(ws + WS_WDN0); K = DFF; }
            else if (ph == PH_WO1) { A = XB; Bt = (const bf16*)(ws + WS_WO1); K = DM; xbo = (bf16*)(ws + WS_XB1); }
            else { A = (const bf16*)(ws + WS_H); Bt = (const bf16*)(ws + WS_WDN1); K = DFF; }
            pg8::Gemm gm{A, Bt, MTOK, DM, K}; pg8::PlainOrder S; S.init(MTOK, DM, F.G, (int)blockIdx.x);
            pg8::EpiResid E{resid, xres, xbo, ssq};
#ifndef NO_RES
            pg8::gemm_phase<pg8::EpiResid, pg8::PlainOrder, false, true>(F.lds + RING_OFF, gm, S, E);
#endif
        }
        else if (ph == PH_UP0 || ph == PH_UP1) {
            const bf16* A = ph == PH_UP0 ? XB : (const bf16*)(ws + WS_XB1);
            pg8::Gemm gm{A, (const bf16*)(ws + (ph == PH_UP0 ? WS_WUP0 : WS_WUP1)), MTOK, DFF, DM}; pg8::RstdOrder S; S.init(MTOK, DFF, F.G, (int)blockIdx.x); S.ssq = ssq; S.rl = rl;
            pg8::EpiUp E{(bf16*)(ws + WS_H), rl};
#ifndef NO_UP
            pg8::gemm_phase<pg8::EpiUp, pg8::RstdOrder, true, true>(F.lds + RING_OFF, gm, S, E);
#endif
        }
        else if (ph == PH_GLAP) {
            { pg8::Gemm gm{XB, (const bf16*)(ws + WS_WGLA), MTOK, 3072, DM}; pg8::RstdOrder S; S.init(MTOK, 3072, F.G, (int)blockIdx.x); S.ssq = ssq; S.rl = rl;
              pg8::EpiGla E{(bf16*)(ws + WS_GQ), (bf16*)(ws + WS_GK), (bf16*)(ws + WS_GV), (bf16*)(ws + WS_GG), rl};
#ifndef NO_GLAP
              pg8::gemm_phase<pg8::EpiGla, pg8::RstdOrder, true, true>(F.lds + RING_OFF, gm, S, E);
#endif
 }
#ifndef NO_GATE
            __syncthreads();
            { LAS float* la = (LAS float*)(F.lds + RING_OFF);
              LAS float* gl = (LAS float*)(F.lds + GLR_LDS_OFF) + F.wave * GRANK;
              const bf16* WG = (const bf16*)(ws + WS_WG); const float* wgu = args.in[7]; const float* bg = args.in[8]; float* GB = (float*)(ws + WS_GB);
              for (int ch = F.vcu; ch < MTOK / GCH; ch += F.G) {
#pragma unroll 1
                  for (int tt = F.wave; tt < GCH; tt += NWAVES) { const int row = ch * GCH + tt;
                      const GAS v4u* xr = (const GAS v4u*)(XB + (size_t)row * DM) + 2 * lane; const v4u xa = xr[0], xc = xr[1];
                      float sq = lane < 16 ? ssq[(size_t)row * 16 + lane] : 0.f; sq = wave_sum(sq); const float rstd = 1.0f / sqrtf(sq * (1.0f / DM) + EPS);
#pragma unroll 1
                      for (int j = 0; j < GRANK; ++j) { const GAS v4u* wr_ = (const GAS v4u*)(WG + (size_t)j * DM) + 2 * lane; const v4u wa = wr_[0], wc_ = wr_[1]; float d = 0.f;
#pragma unroll
                          for (int e = 0; e < 4; ++e) { d += hlo(xa[e]) * hlo(wa[e]) + hhi(xa[e]) * hhi(wa[e]); d += hlo(xc[e]) * hlo(wc_[e]) + hhi(xc[e]) * hhi(wc_[e]); }
                          d = wave_sum(d) * rstd; if (lane == 0) gl[j] = d; }
                      LDS_WAIT(); asm volatile("" ::: "memory");
#pragma unroll 1
                      for (int i = 0; i < 8; ++i) { const int c = lane + 64 * i; float gk = bg[c];
#pragma unroll
                          for (int j = 0; j < GRANK; ++j) gk += gl[j] * wgu[j * GKD + c];
                          const float ls = fminf(gk, 0.f) - log1pf(expf(-fabsf(gk)));
                          la[tt * GKD + c] = ls * (1.0f / 16.0f); }
                      LDS_WAIT(); asm volatile("" ::: "memory"); }
                  __syncthreads();
                  { const int c = tid; float run = 0.f;
#pragma unroll 4
                    for (int tt = 0; tt < GCH; ++tt) { run += la[tt * GKD + c]; GB[(size_t)(ch * GCH + tt) * GKD + c] = run; } }
                  __syncthreads();
              } }
#endif
        }
        else if (ph == PH_GLA1 || ph == PH_GLA2 || ph == PH_GLA3) {
        }
        else if (ph == PH_FIN) {
            for (int m = gw; m < MTOK; m += NGW) { GAS f32x4* xr = (GAS f32x4*)(xres + (size_t)m * DM) + lane; f32x4 v[4]; float s = 0.f;
#pragma unroll
                for (int j = 0; j < 4; ++j) { v[j] = xr[64 * j]; s += (v[j].x * v[j].x + v[j].y * v[j].y) + (v[j].z * v[j].z + v[j].w * v[j].w); }
                const float rstd = 1.0f / sqrtf(wave_sum(s) * (1.0f / DM) + EPS);
#pragma unroll
                for (int j = 0; j < 4; ++j) { const f32x4 w = *((const f32x4*)final_w + lane + 64 * j); xr[64 * j] = v[j] * rstd * w; } }
        }
      }
      if (ph + 1 < args.ph_hi) xcd_barrier(bar);
    }
}

__global__ void __launch_bounds__(256) naive_attn(const bf16* __restrict__ Q, const bf16* __restrict__ K, const bf16* __restrict__ V, bf16* OM, float* LSE, int g, int ldil) {
    __shared__ float qs[4][128];
    const int lane = threadIdx.x & 63, wv = threadIdx.x >> 6;
    const int item = blockIdx.x * 4 + wv, row = item >> 3, h = item & 7;
    const int b = row >> 13, t = row & (SEQ - 1), r = t & ((1 << ldil) - 1), i = t >> ldil, L = SEQ >> ldil;
    const size_t base = (size_t)((((b * AH + h) << ldil) + r)) * L;
    const bf16* Qr = Q + (base + i) * HD; const bf16* Ks = K + base * HD; const bf16* Vs = V + base * HD;
    qs[wv][lane] = h2f(Qr[lane]); qs[wv][lane + 64] = h2f(Qr[lane + 64]);
    __syncthreads();
    float sc[3];
#pragma unroll
    for (int sl = 0; sl < 3; ++sl) { const int jj = lane + 64 * sl; float s = -INFINITY;
        if (jj <= 128 && i - jj >= 0) { const v4u* kp = (const v4u*)(Ks + (size_t)(i - jj) * HD); s = 0.f;
            for (int c = 0; c < 16; ++c) { const v4u kv = kp[c];
#pragma unroll
                for (int e = 0; e < 4; ++e) s += qs[wv][8 * c + 2 * e] * hlo(kv[e]) + qs[wv][8 * c + 2 * e + 1] * hhi(kv[e]); }
            s *= 0.08838834764831845f; }
        sc[sl] = s; }
    float m = fmaxf(fmaxf(sc[0], sc[1]), sc[2]);
#pragma unroll
    for (int o = 1; o < 64; o <<= 1) m = fmaxf(m, __shfl_xor(m, o));
    float p[3], l = 0.f;
#pragma unroll
    for (int sl = 0; sl < 3; ++sl) { p[sl] = expf(sc[sl] - m); l += p[sl]; }
    l = wave_sum(l);
    float o0 = 0.f, o1 = 0.f;
#pragma unroll
    for (int sl = 0; sl < 3; ++sl)
        for (int ll = 0; ll < 64; ++ll) { const int jj = sl * 64 + ll; if (jj > 128 || i - jj < 0) break;
            const float pj = __shfl(p[sl], ll); const unsigned vv = ((const unsigned*)(Vs + (size_t)(i - jj) * HD))[lane];
            o0 += pj * hlo(vv); o1 += pj * hhi(vv); }
    o0 /= l; o1 /= l; float lse = m + logf(l);
    unsigned* op = (unsigned*)(OM + (size_t)row * DM + h * HD) + lane;
    if (g > 0) { const float lo = LSE[(size_t)row * 8 + h]; const unsigned ov = *op; const float mx = fmaxf(lo, lse), wo = expf(lo - mx), wn = expf(lse - mx), inv = 1.0f / (wo + wn);
        o0 = (wo * hlo(ov) + wn * o0) * inv; o1 = (wo * hhi(ov) + wn * o1) * inv; lse = mx + logf(wo + wn); }
    *op = pkh(o0, o1);
    if (lane == 0) LSE[(size_t)row * 8 + h] = lse;
}
__global__ void __launch_bounds__(1024) naive_gla(const bf16* __restrict__ q, const bf16* __restrict__ k, const bf16* __restrict__ v, const bf16* __restrict__ g, const float* __restrict__ Bc,
                                                    const float* __restrict__ normw, bf16* GO) {
    __shared__ float red[2][16];
    __shared__ __attribute__((aligned(16))) float as_[2][128], ks_[2][128], qs_[2][128];
    const int tid = threadIdx.x, vloc = tid >> 2, qt = tid & 3, wv = tid >> 6, lane = tid & 63;
    const int b = blockIdx.x >> 2, h = blockIdx.x & 3;
    float S[32];
#pragma unroll
    for (int j = 0; j < 32; ++j) S[j] = 0.f;
    const float nw = normw[vloc];
    for (int t = 0; t < SEQ; ++t) { const size_t row = (size_t)b * SEQ + t; const int bf = t & 1;
        if (tid < 128) { const float* bp = Bc + row * GKD + h * GDK + tid; const float la = bp[0] - ((t & 63) ? bp[-GKD] : 0.f);
            as_[bf][tid] = expf(la); ks_[bf][tid] = bf2f(k[row * GKD + h * GDK + tid]); qs_[bf][tid] = bf2f(q[row * GKD + h * GDK + tid]) * 0.08838834764831845f; }
        const float vv = bf2f(v[row * GVD + h * GDV + vloc]);
        __syncthreads();
        float o = 0.f;
#pragma unroll
        for (int c = 0; c < 8; ++c) { const f32x4 a4 = *(const f32x4*)&as_[bf][qt * 32 + 4 * c], k4 = *(const f32x4*)&ks_[bf][qt * 32 + 4 * c], q4 = *(const f32x4*)&qs_[bf][qt * 32 + 4 * c];
#pragma unroll
            for (int e = 0; e < 4; ++e) { const int j = 4 * c + e; S[j] = a4[e] * S[j] + k4[e] * vv; o += q4[e] * S[j]; } }
        o += __shfl_xor(o, 1); o += __shfl_xor(o, 2);
        float sq = qt == 0 ? o * o : 0.f; sq = wave_sum(sq);
        if (lane == 0) red[bf][wv] = sq;
        __syncthreads();
        float tot = 0.f;
#pragma unroll
        for (int w = 0; w < 16; ++w) tot += red[bf][w];
        const float rstd = 1.0f / sqrtf(tot * (1.0f / GDV) + EPS);
        if (qt == 0) { const float gg = bf2f(g[row * GVD + h * GDV + vloc]); const float y = o * rstd * nw * (gg / (1.0f + expf(-gg))); GO[row * GVD + h * GDV + vloc] = __builtin_bit_cast(unsigned short, (_Float16)y); }
    }
}

#ifndef MK_MODE
#define MK_MODE 0
#endif
extern "C" void kernel_launch(void* const* d_in, const int* in_sizes, int n_in, void* d_out, int out_size, void* d_ws, size_t ws_size, hipStream_t stream) {
    static int grid = 0;
    if (grid == 0) {
        if (n_in != 13 || in_sizes[0] != MTOK * DM || out_size != MTOK * DM || ws_size < WS_END) { fprintf(stderr, "kernel_launch: unexpected shapes (n_in %d, in0 %d, out %d, ws %zu); nothing launched\n", n_in, n_in > 0 ? in_sizes[0] : -1, out_size, ws_size); grid = -1; return; }
        int dev = 0, cus = 0;
        if (hipGetDevice(&dev) != hipSuccess || hipDeviceGetAttribute(&cus, hipDeviceAttributeMultiprocessorCount, dev) != hipSuccess) { grid = -1; return; }
        if (hipFuncSetAttribute((const void*)mega_fwd, hipFuncAttributeMaxDynamicSharedMemorySize, LDS_BYTES) != hipSuccess) { fprintf(stderr, "kernel_launch: hipFuncSetAttribute failed\n"); grid = -1; return; }
        (void)hipGetLastError();
        grid = cus;
        if (grid != 256) fprintf(stderr, "kernel_launch: %d CUs (built for 256)\n", grid);
    }
    if (grid < 0) return;
    unsigned char* ws = (unsigned char*)d_ws;
    (void)hipMemsetAsync(ws + WS_CTL, 0, CTL_ZERO_BYTES, stream);
    Args a{};
    for (int i = 0; i < 13; ++i) a.in[i] = (const float*)d_in[i];
    a.out = (float*)d_out; a.ws = ws;
#define MEGA(lo, hi, li_) do { a.ph_lo = (lo); a.ph_hi = (hi); a.li = (li_); hipLaunchKernelGGL(mega_fwd, dim3(grid), dim3(NWAVES * 64), LDS_BYTES, stream, a); } while (0)
#if MK_MODE == 0
    a.skip_mask = 0;
    MEGA(PH_PRO, PH_PRO + 1, 0);
    for (int g = 0; g < NGRP; ++g) { MEGA(PH_QKV0 + 2 * g, PH_QKV0 + 2 * g + 1, 0);
        hipLaunchKernelGGL(naive_attn, dim3(MTOK * AH / 4), dim3(256), 0, stream, (const bf16*)(ws + WS_Q), (const bf16*)(ws + WS_K), (const bf16*)(ws + WS_V), (bf16*)(ws + WS_OM), (float*)(ws + WS_LSE), g, grp_ldil(g)); }
    MEGA(PH_WO0, PH_WO0 + 1, 0); MEGA(PH_UP0, PH_UP0 + 1, 0); MEGA(PH_DN0, PH_DN0 + 1, 0); MEGA(PH_GLAP, PH_GLAP + 1, 0);
    hipLaunchKernelGGL(naive_gla, dim3(BATCH * GH), dim3(1024), 0, stream, (const bf16*)(ws + WS_GQ), (const bf16*)(ws + WS_GK), (const bf16*)(ws + WS_GV), (const bf16*)(ws + WS_GG), (const float*)(ws + WS_GB),
                       (const float*)d_in[9], (bf16*)(ws + WS_XB));
    MEGA(PH_WO1, PH_WO1 + 1, 0); MEGA(PH_UP1, PH_UP1 + 1, 0); MEGA(PH_DN1, PH_DN1 + 1, 0); MEGA(PH_FIN, PH_FIN + 1, 0);
#elif MK_MODE == 1
    a.skip_mask = 0;
    for (int p = 0; p < PH_N; ++p) MEGA(p, p + 1, 0);
#else
    a.skip_mask = 0;
    MEGA(0, PH_N, 0);
#endif
#undef MEGA
}
```

```cpp
#include <hip/hip_runtime.h>
#include <cstdio>
#include <cstdint>
#include <cmath>
#include <hip/hip_runtime.h>
#include <cstdio>
#include <cstdint>
namespace pg8 {
#define PG8_LAS __attribute__((address_space(3)))
typedef unsigned short bf16_t;
typedef short bf16x8 __attribute__((ext_vector_type(8)));
typedef _Float16 f16x8 __attribute__((ext_vector_type(8)));
typedef float f32x4 __attribute__((ext_vector_type(4)));
typedef unsigned u32x4 __attribute__((ext_vector_type(4)));
constexpr int BM = 256, BK = 64, HALF = 128, HTB = HALF * BK * 2  , STAGE_BYTES = 8 * HTB, NXCD = 8, WGM = 8;

__host__ __device__ __forceinline__ int lds_byte(int r, int c) { const int st = (r >> 4) * 2 + (c >> 5), rr = r & 15, cc = c & 31, ob = rr * 64 + cc * 2; return st * 1024 + (ob ^ (((ob >> 9) & 1) << 5)); }
__host__ __device__ __forceinline__ void stage_rc(int b, int& R, int& C) { const int st = b / 1024, sb = b % 1024, swz = sb ^ (((sb >> 9) & 1) << 5); R = (st >> 1) * 16 + swz / 64; C = (st & 1) * 32 + (swz % 64) / 2; }
__host__ __device__ __forceinline__ int perm32(int rho) { const int n = rho >> 4, i = rho & 15; return 8 * (i >> 2) + 4 * n + (i & 3); }

struct Unit { int pm, pn; };
struct Gemm { const bf16_t* A; const bf16_t* Bt; int M, N, K; };

struct StaticOrder {
    int nM, nN, nwg, G, c;
    __host__ __device__ void init(int M, int N, int G_, int c_) { nM = M / BM; nN = N / BM; nwg = nM * nN; G = G_; c = c_; }
    __host__ __device__ bool next(int i, Unit& u) const {
        const long L = (long)i * G + c; if (L >= nwg) return false;
        int wgid = (int)L; { const int q = nwg / NXCD, r = nwg % NXCD, xcd = wgid % NXCD, off = wgid / NXCD; wgid = (xcd < r ? xcd * (q + 1) : r * (q + 1) + (xcd - r) * q) + off; }
        const int nig = WGM * nN, gid = wgid / nig, fm = gid * WGM, gsz = (nM - fm) < WGM ? (nM - fm) : WGM;
        u.pm = fm + ((wgid % nig) % gsz); u.pn = (wgid % nig) / gsz; return true;
    }
    __device__ __forceinline__ void a_ready(const Unit&) const {}
    __device__ __forceinline__ void done(const Unit&) const {}
};

__device__ __forceinline__ unsigned cvt_pk_bf16(float lo, float hi) { unsigned r; asm volatile("v_cvt_pk_bf16_f32 %0, %1, %2" : "=v"(r) : "v"(lo), "v"(hi)); return r; }
typedef unsigned u32x2 __attribute__((ext_vector_type(2)));
typedef _Float16 h16x2 __attribute__((ext_vector_type(2)));
typedef float f32x2 __attribute__((ext_vector_type(2)));
__device__ __forceinline__ unsigned cvt_pk_h(float lo, float hi) { const f32x2 v = {lo, hi}; return __builtin_bit_cast(unsigned, __builtin_convertvector(v, h16x2)); }
constexpr int P_SEQ = 8192, P_DM = 1024, P_DFF = 4096, P_AH = 8, P_HD = 128;
constexpr int RSTD_LDS_OFF = 131072 + 512;
struct PlainOrder : StaticOrder { __device__ __forceinline__ void a_ready(const Unit&, int) const {} };
struct RstdOrder : StaticOrder {
    const float* ssq; PG8_LAS float* rl;
    __device__ __forceinline__ void a_ready(const Unit& u, int ui) const {
        int t = threadIdx.x; asm volatile("" : "+v"(t));
        const int row = t >> 1, hf = t & 1;
        const f32x4* p = (const f32x4*)(ssq + (size_t)(u.pm * BM + row) * 16 + hf * 8); const f32x4 a = p[0], b = p[1];
        float s = ((a[0] + a[1]) + (a[2] + a[3])) + ((b[0] + b[1]) + (b[2] + b[3])); s += __shfl_xor(s, 1);
        if (hf == 0) rl[(ui & 1) * 256 + row] = 1.0f / sqrtf(s * (1.0f / 1024.0f) + 1e-5f);
    }
};
__device__ __forceinline__ void row_rstd(const PG8_LAS float* rl, int ui, int wr, int fr, float (&rs)[2][4]) {
#pragma unroll
    for (int ai = 0; ai < 2; ++ai)
#pragma unroll
        for (int m = 0; m < 4; ++m) rs[ai][m] = rl[(ui & 1) * 256 + ai * HALF + wr * 64 + m * 16 + fr];
}
__device__ __forceinline__ u32x4 pack8h(const f32x4 a, const f32x4 b) { u32x4 w; w.x = cvt_pk_h(a[0], a[1]); w.y = cvt_pk_h(a[2], a[3]); w.z = cvt_pk_h(b[0], b[1]); w.w = cvt_pk_h(b[2], b[3]); return w; }
__device__ __forceinline__ u32x4 pack8(const f32x4 a, const f32x4 b) { u32x4 w; w.x = cvt_pk_bf16(a[0], a[1]); w.y = cvt_pk_bf16(a[2], a[3]); w.z = cvt_pk_bf16(b[0], b[1]); w.w = cvt_pk_bf16(b[2], b[3]); return w; }

struct EpiQKV {
    static constexpr bool PERM = true, AFTER_DRAIN = false;
    bf16_t* Q; bf16_t* K; bf16_t* V; const PG8_LAS float* rl; const float* cosT; const float* sinT; int ldil;
    __device__ __forceinline__ void operator()(const f32x4 (&acc)[2][2][4][2], const Unit& u, int wr, int wc, int fr, int fq, int ui) const {
        const int row0 = u.pm * BM + wr * 64 + fr;
        float rs[2][4]; row_rstd(rl, ui, wr, fr, rs);
        const int which = u.pn >> 2, hp = u.pn & 3, dmask = (1 << ldil) - 1, L = P_SEQ >> ldil;
        if (which < 2) {
            bf16_t* dst = which == 0 ? Q : K;
            const int head = 2 * hp + (wc >> 1), d0 = 32 * (wc & 1) + 8 * fq;
#pragma unroll
            for (int ai = 0; ai < 2; ++ai)
#pragma unroll
                for (int m = 0; m < 4; ++m) { const int row = row0 + ai * HALF + m * 16, b = row >> 13, t = row & (P_SEQ - 1), r = t & dmask, i = t >> ldil;
                    bf16_t* p = dst + ((size_t)((((b * P_AH + head) << ldil) + r)) * L + i) * P_HD + d0;
                    const float* ct = cosT + t * 64 + d0; const float* st = sinT + t * 64 + d0;
                    const f32x4 c0 = *(const f32x4*)ct, c1 = *(const f32x4*)(ct + 4), s0 = *(const f32x4*)st, s1 = *(const f32x4*)(st + 4);
                    const float sc = rs[ai][m];
                    const f32x4 x1a = acc[ai][0][m][0] * sc, x1b = acc[ai][0][m][1] * sc, x2a = acc[ai][1][m][0] * sc, x2b = acc[ai][1][m][1] * sc;
                    const f32x4 o1a = x1a * c0 - x2a * s0, o1b = x1b * c1 - x2b * s1, o2a = x2a * c0 + x1a * s0, o2b = x2b * c1 + x1b * s1;
                    *(u32x4*)p = pack8h(o1a, o1b); *(u32x4*)(p + 64) = pack8h(o2a, o2b);
                    if (m & 1) asm volatile("" ::: "memory"); }
        } else {
            const int dd = 32 * wc + 8 * fq;
#pragma unroll
            for (int ai = 0; ai < 2; ++ai)
#pragma unroll
                for (int m = 0; m < 4; ++m) { const int row = row0 + ai * HALF + m * 16, b = row >> 13, t = row & (P_SEQ - 1), r = t & dmask, i = t >> ldil;
                    const float sc = rs[ai][m];
#pragma unroll
                    for (int bj = 0; bj < 2; ++bj) { const int head = 2 * hp + bj;
                        bf16_t* p = V + ((size_t)((((b * P_AH + head) << ldil) + r)) * L + i) * P_HD + dd;
                        *(u32x4*)p = pack8h(acc[ai][bj][m][0] * sc, acc[ai][bj][m][1] * sc); } }
        }
    }
};
struct EpiResid {
    static constexpr bool PERM = false, AFTER_DRAIN = false;
    const float* resid; float* out; bf16_t* xb; float* ssq;
    __device__ __forceinline__ void operator()(const f32x4 (&acc)[2][2][4][2], const Unit& u, int wr, int wc, int fr, int fq, int ui) const {
        const int row0 = u.pm * BM + wr * 64 + fr, col0 = u.pn * BM + wc * 32 + 4 * fq;
#pragma unroll
        for (int ai = 0; ai < 2; ++ai)
#pragma unroll
            for (int m = 0; m < 4; ++m) { const int row = row0 + ai * HALF + m * 16; const size_t off = (size_t)row * P_DM + col0; float s = 0.f;
#pragma unroll
                for (int bj = 0; bj < 2; ++bj)
#pragma unroll
                    for (int n = 0; n < 2; ++n) { const f32x4 v = acc[ai][bj][m][n] + *(const f32x4*)(resid + off + bj * HALF + n * 16);
                        *(f32x4*)(out + off + bj * HALF + n * 16) = v; s += (v[0] * v[0] + v[1] * v[1]) + (v[2] * v[2] + v[3] * v[3]);
                        u32x2 w; w.x = cvt_pk_h(v[0], v[1]); w.y = cvt_pk_h(v[2], v[3]); *(u32x2*)(xb + off + bj * HALF + n * 16) = w; }
                s += __shfl_xor(s, 16); s += __shfl_xor(s, 32);
                if (fq == 0) ssq[(size_t)row * 16 + u.pn * 4 + wc] = s;
                asm volatile("" ::: "memory"); }
    }
};
struct EpiUp {
    static constexpr bool PERM = true, AFTER_DRAIN = false;
    bf16_t* H; const PG8_LAS float* rl;
    __device__ __forceinline__ void operator()(const f32x4 (&acc)[2][2][4][2], const Unit& u, int wr, int wc, int fr, int fq, int ui) const {
        const int row0 = u.pm * BM + wr * 64 + fr, col0 = u.pn * BM + wc * 32 + 8 * fq;
        float rs[2][4]; row_rstd(rl, ui, wr, fr, rs);
#pragma unroll
        for (int ai = 0; ai < 2; ++ai)
#pragma unroll
            for (int m = 0; m < 4; ++m) { bf16_t* rowp = H + (size_t)(row0 + ai * HALF + m * 16) * P_DFF + col0; const float sc = rs[ai][m];
#pragma unroll
                for (int bj = 0; bj < 2; ++bj) { f32x4 v0 = acc[ai][bj][m][0] * sc, v1 = acc[ai][bj][m][1] * sc;
                    v0 = __builtin_elementwise_max(v0, (f32x4){0.f, 0.f, 0.f, 0.f}); v1 = __builtin_elementwise_max(v1, (f32x4){0.f, 0.f, 0.f, 0.f});
                    const f32x4 cap = {65504.f, 65504.f, 65504.f, 65504.f};
                    *(u32x4*)(rowp + bj * HALF) = pack8h(__builtin_elementwise_min(v0 * v0, cap), __builtin_elementwise_min(v1 * v1, cap)); } }
    }
};
struct EpiGla {
    static constexpr bool PERM = true, AFTER_DRAIN = false;
    bf16_t* q; bf16_t* k; bf16_t* v; bf16_t* g; const PG8_LAS float* rl;
    __device__ __forceinline__ void operator()(const f32x4 (&acc)[2][2][4][2], const Unit& u, int wr, int wc, int fr, int fq, int ui) const {
        const int row0 = u.pm * BM + wr * 64 + fr;
        float rs[2][4]; row_rstd(rl, ui, wr, fr, rs);
        bf16_t* dst; int ld, coff;
        if (u.pn < 2) { dst = q; ld = 512; coff = u.pn * 256; } else if (u.pn < 4) { dst = k; ld = 512; coff = (u.pn - 2) * 256; }
        else if (u.pn < 8) { dst = v; ld = 1024; coff = (u.pn - 4) * 256; } else { dst = g; ld = 1024; coff = (u.pn - 8) * 256; }
        const int col0 = coff + wc * 32 + 8 * fq;
#pragma unroll
        for (int ai = 0; ai < 2; ++ai)
#pragma unroll
            for (int m = 0; m < 4; ++m) { bf16_t* rowp = dst + (size_t)(row0 + ai * HALF + m * 16) * ld + col0; const float sc = rs[ai][m];
#pragma unroll
                for (int bj = 0; bj < 2; ++bj) *(u32x4*)(rowp + bj * HALF) = pack8(acc[ai][bj][m][0] * sc, acc[ai][bj][m][1] * sc); }
    }
};
template <class Epi, class Sched, bool ALIGN_EPI = false, bool SP2 = false>
__device__ __forceinline__ void gemm_phase(PG8_LAS unsigned char* lds, const Gemm g, const Sched& S, const Epi& E) {
    int tid_ = threadIdx.x; asm volatile("" : "+v"(tid_));
    const int tid = tid_, wid = __builtin_amdgcn_readfirstlane(tid >> 6), lane = tid & 63, wr = wid >> 2, wc = wid & 3, fr = lane & 15, fq = lane >> 4;
    const int K = g.K, nt = K / BK;
    unsigned voffA[2], voffB[2];
#pragma unroll
    for (int i = 0; i < 2; ++i) { int R, C; stage_rc(tid * 16 + i * 8192, R, C); const int Rb = Epi::PERM ? ((R & ~31) + perm32(R & 31)) : R;
        voffA[i] = (unsigned)(R * K + C) * 2u; voffB[i] = (unsigned)(Rb * K + C) * 2u; }
    const size_t kstep = (size_t)(BK * 2);
    const size_t hstep = (size_t)HALF * K * 2;
    const size_t tstep = 2 * hstep;
    const unsigned ldsw = (unsigned)wid * 1024u;
    const int aoff = lds_byte(wr * 64 + fr, fq * 8), boff = lds_byte(wc * 32 + fr, fq * 8);
#define PG8_SA(b, h) (((b) * 2 + (h)) * HTB)
#define PG8_SB(b, h) ((4 + (b) * 2 + (h)) * HTB)
#define PG8_STAGE(bufoff, gbase, voff) do { _Pragma("unroll") for (int _i = 0; _i < 2; ++_i) \
        __builtin_amdgcn_global_load_lds((const unsigned*)((const char*)(gbase) + (voff)[_i]), (PG8_LAS unsigned*)(lds + (bufoff) + ldsw + _i * 8192), 16, 0, 0); } while (0)
#define PG8_LDA(dst, b, h) do { _Pragma("unroll") for (int m = 0; m < 4; ++m) _Pragma("unroll") for (int k = 0; k < 2; ++k) dst[m][k] = *(const PG8_LAS bf16x8*)(lds + PG8_SA(b, h) + aoff + m * 2048 + k * 1024); } while (0)
#define PG8_LDB(dst, b, h) do { _Pragma("unroll") for (int n = 0; n < 2; ++n) _Pragma("unroll") for (int k = 0; k < 2; ++k) dst[n][k] = *(const PG8_LAS bf16x8*)(lds + PG8_SB(b, h) + boff + n * 2048 + k * 1024); } while (0)
#define PG8_MMA(ai, bj, At, Bt) do { __builtin_amdgcn_s_setprio(1); _Pragma("unroll") for (int m = 0; m < 4; ++m) _Pragma("unroll") for (int n = 0; n < 2; ++n) _Pragma("unroll") for (int k = 0; k < 2; ++k) \
        acc[ai][bj][m][n] = __builtin_amdgcn_mfma_f32_16x16x32_f16(__builtin_bit_cast(f16x8, Bt[n][k]), __builtin_bit_cast(f16x8, At[m][k]), acc[ai][bj][m][n], 0, 0, 0); __builtin_amdgcn_s_setprio(0); } while (0)
#define PG8_WAIT_V(n) asm volatile("s_waitcnt vmcnt(" #n ")" ::: "memory")
#define PG8_WAIT_L(n) asm volatile("s_waitcnt lgkmcnt(" #n ")" ::: "memory")
#define PG8_BAR __builtin_amdgcn_s_barrier()
#define PG8_SCHED __builtin_amdgcn_sched_barrier(0)
    Unit cur, nxt; int ui = 0;
    if (!S.next(0, cur)) return;
    f32x4 acc[2][2][4][2];
#pragma unroll
    for (int a = 0; a < 2; ++a)
#pragma unroll
        for (int b = 0; b < 2; ++b)
#pragma unroll
            for (int m = 0; m < 4; ++m)
#pragma unroll
                for (int n = 0; n < 2; ++n) acc[a][b][m][n] = (f32x4){0.f, 0.f, 0.f, 0.f};
    bf16x8 At[4][2], B0[2][2], B1[2][2];
    const char* cA = (const char*)g.A + (size_t)cur.pm * tstep; const char* cB = (const char*)g.Bt + (size_t)cur.pn * tstep;
    S.a_ready(cur, 0);
    if constexpr (SP2) {
        PG8_STAGE(PG8_SB(0, 0), cB, voffB); PG8_STAGE(PG8_SB(0, 1), cB + hstep, voffB); PG8_STAGE(PG8_SA(0, 0), cA, voffA); PG8_STAGE(PG8_SA(0, 1), cA + hstep, voffA);
        if (wr == 1) PG8_BAR;
        PG8_WAIT_V(2); PG8_BAR;
        PG8_STAGE(PG8_SB(1, 0), cB + kstep, voffB); PG8_STAGE(PG8_SA(1, 0), cA + kstep, voffA); PG8_STAGE(PG8_SB(1, 1), cB + hstep + kstep, voffB);
        PG8_WAIT_V(6); PG8_BAR;
    } else {
        PG8_STAGE(PG8_SB(0, 0), cB, voffB); PG8_STAGE(PG8_SA(0, 0), cA, voffA); PG8_STAGE(PG8_SB(0, 1), cB + hstep, voffB); PG8_STAGE(PG8_SA(0, 1), cA + hstep, voffA);
        if (wr == 1) PG8_BAR;
        PG8_WAIT_V(4); PG8_BAR;
        PG8_STAGE(PG8_SB(1, 0), cB + kstep, voffB); PG8_STAGE(PG8_SA(1, 0), cA + kstep, voffA); PG8_STAGE(PG8_SB(1, 1), cB + hstep + kstep, voffB);
        PG8_WAIT_V(6); PG8_BAR;
    }
    for (;;) {
        const bool has_next = S.next(ui + 1, nxt);
        const char* nA = has_next ? (const char*)g.A + (size_t)nxt.pm * tstep : cA; const char* nB = has_next ? (const char*)g.Bt + (size_t)nxt.pn * tstep : cB;
        for (int t = 0; t < nt; t += 2) {
            const bool last = (t == nt - 2);
            const char* a1 = cA + (size_t)(t + 1) * kstep;
            const char* a2 = last ? nA : cA + (size_t)(t + 2) * kstep; const char* b2 = last ? nB : cB + (size_t)(t + 2) * kstep;
            const char* a3 = a2 + kstep; const char* b3 = b2 + kstep;
            if (last && has_next) S.a_ready(nxt, ui + 1);
            if constexpr (SP2) {
            PG8_LDB(B0, 0, 0); PG8_LDB(B1, 0, 1); PG8_SCHED; PG8_LDA(At, 0, 0); PG8_STAGE(PG8_SA(1, 1), a1 + hstep, voffA);
            PG8_WAIT_V(8); PG8_WAIT_L(0); PG8_BAR; PG8_MMA(0, 0, At, B0); PG8_MMA(0, 1, At, B1); PG8_BAR; PG8_SCHED;
            PG8_LDA(At, 0, 1); PG8_STAGE(PG8_SB(0, 0), b2, voffB); PG8_STAGE(PG8_SB(0, 1), b2 + hstep, voffB); PG8_STAGE(PG8_SA(0, 0), a2, voffA);
            PG8_WAIT_V(8); PG8_WAIT_L(0); PG8_BAR; PG8_MMA(1, 0, At, B0); PG8_MMA(1, 1, At, B1); PG8_BAR; PG8_SCHED;
            PG8_LDB(B0, 1, 0); PG8_LDB(B1, 1, 1); PG8_SCHED; PG8_LDA(At, 1, 0); PG8_STAGE(PG8_SA(0, 1), a2 + hstep, voffA);
            PG8_WAIT_V(8); PG8_WAIT_L(0); PG8_BAR; PG8_MMA(0, 0, At, B0); PG8_MMA(0, 1, At, B1); PG8_BAR; PG8_SCHED;
            PG8_LDA(At, 1, 1); PG8_STAGE(PG8_SB(1, 0), b3, voffB); PG8_STAGE(PG8_SB(1, 1), b3 + hstep, voffB); PG8_STAGE(PG8_SA(1, 0), a3, voffA);
            PG8_WAIT_V(8); PG8_WAIT_L(0); PG8_BAR; PG8_MMA(1, 0, At, B0); PG8_MMA(1, 1, At, B1); PG8_BAR; PG8_SCHED;
            } else {
            PG8_LDB(B0, 0, 0); PG8_SCHED; PG8_LDA(At, 0, 0); PG8_STAGE(PG8_SA(1, 1), a1 + hstep, voffA);
            PG8_WAIT_L(8); PG8_BAR; PG8_WAIT_L(0); PG8_MMA(0, 0, At, B0); PG8_BAR; PG8_SCHED;
            PG8_LDB(B1, 0, 1); PG8_STAGE(PG8_SB(0, 0), b2, voffB);
            PG8_BAR; PG8_WAIT_L(0); PG8_MMA(0, 1, At, B1); PG8_BAR;
            PG8_LDA(At, 0, 1); PG8_STAGE(PG8_SA(0, 0), a2, voffA);
            PG8_BAR; PG8_WAIT_L(0); PG8_MMA(1, 0, At, B0); PG8_BAR; PG8_SCHED;
            PG8_STAGE(PG8_SB(0, 1), b2 + hstep, voffB);
            PG8_WAIT_V(6); PG8_BAR; PG8_MMA(1, 1, At, B1); PG8_BAR;
            PG8_LDB(B0, 1, 0); PG8_SCHED; PG8_LDA(At, 1, 0); PG8_STAGE(PG8_SA(0, 1), a2 + hstep, voffA);
            PG8_WAIT_L(8); PG8_BAR; PG8_WAIT_L(0); PG8_MMA(0, 0, At, B0); PG8_BAR; PG8_SCHED;
            PG8_LDB(B1, 1, 1); PG8_STAGE(PG8_SB(1, 0), b3, voffB);
            PG8_BAR; PG8_WAIT_L(0); PG8_MMA(0, 1, At, B1); PG8_BAR;
            PG8_LDA(At, 1, 1); PG8_STAGE(PG8_SA(1, 0), a3, voffA);
            PG8_BAR; PG8_WAIT_L(0); PG8_MMA(1, 0, At, B0); PG8_BAR; PG8_SCHED;
            PG8_STAGE(PG8_SB(1, 1), b3 + hstep, voffB);
            PG8_WAIT_V(6); PG8_BAR; PG8_MMA(1, 1, At, B1); PG8_BAR;
            }
        }
        if constexpr (ALIGN_EPI) { if (wr == 0) PG8_BAR; }
        if constexpr (!Epi::AFTER_DRAIN) { E(acc, cur, wr, wc, fr, fq, ui); S.done(cur); }
        if (!has_next) break;
#pragma unroll
        for (int a = 0; a < 2; ++a)
#pragma unroll
            for (int b = 0; b < 2; ++b)
#pragma unroll
                for (int m = 0; m < 4; ++m)
#pragma unroll
                    for (int n = 0; n < 2; ++n) acc[a][b][m][n] = (f32x4){0.f, 0.f, 0.f, 0.f};
        cur = nxt; cA = nA; cB = nB; ++ui;
        if constexpr (ALIGN_EPI) { if (wr == 1) PG8_BAR; }
    }
    PG8_WAIT_V(0);
    if constexpr (!ALIGN_EPI) { if (wr == 0) PG8_BAR; }
    PG8_BAR;
    if constexpr (Epi::AFTER_DRAIN) { E.fused(acc, cur, wr, wc, fr, fq, lds, wid, lane); S.done(cur); }
#undef PG8_SA
#undef PG8_SB
#undef PG8_STAGE
#undef PG8_LDA
#undef PG8_LDB
#undef PG8_MMA
#undef PG8_WAIT_V
#undef PG8_WAIT_L
#undef PG8_BAR
#undef PG8_SCHED
}
}
#define GAS __attribute__((address_space(1)))
#define LAS __attribute__((address_space(3)))
typedef unsigned short bf16;
typedef unsigned v4u __attribute__((ext_vector_type(4)));
typedef float f32x4 __attribute__((ext_vector_type(4)));
typedef short bf16x8 __attribute__((ext_vector_type(8)));
typedef GAS unsigned gu32;
typedef GAS unsigned long long gu64;
#define RLX_AGENT __ATOMIC_RELAXED, __HIP_MEMORY_SCOPE_AGENT
#define LDS_WAIT() asm volatile("s_waitcnt lgkmcnt(0)" ::: "memory")
#define VM_WAIT() asm volatile("s_waitcnt vmcnt(0)" ::: "memory")
__device__ __forceinline__ unsigned long long rt() { return __builtin_amdgcn_s_memrealtime(); }
__device__ __forceinline__ unsigned f2bf(float f) { unsigned u = __builtin_bit_cast(unsigned, f); return (u + 0x7fffu + ((u >> 16) & 1u)) >> 16; }
__device__ __forceinline__ unsigned pk2(float lo, float hi) { return f2bf(lo) | (f2bf(hi) << 16); }

#define XB_TMO      128
#define XB_XCNT(j)  (256  + 64 * (j))
#define XB_XSUB(j)  (1280 + 64 * (j))
#define XB_XGEN(j)  (2304 + 64 * (j))
#define XB_TOP      3328
#define XB_TOPGEN   3392
#define XCD_BAR_WORDS 3456
#define XB_SPIN_CAP (1u << 18)

__device__ __forceinline__ unsigned xb_ld(unsigned* p)              { return __hip_atomic_load(p, __ATOMIC_RELAXED, __HIP_MEMORY_SCOPE_AGENT); }
__device__ __forceinline__ unsigned xb_add(unsigned* p, unsigned v) { return __hip_atomic_fetch_add(p, v, __ATOMIC_RELAXED, __HIP_MEMORY_SCOPE_AGENT); }
__device__ __forceinline__ unsigned xb_xcc_id() { return (unsigned)__builtin_amdgcn_s_getreg((3 << 11) | 20) & 0xFu; }
#define XB_SPIN(cond, bar) do { unsigned _sp = 0; while (cond) { __builtin_amdgcn_s_sleep(1); \
    if ((++_sp & 255u) == 0u) { if (xb_ld(&(bar)[XB_TMO])) break; if (_sp > XB_SPIN_CAP) { atomicAdd(&(bar)[XB_TMO], 1u); break; } } } } while (0)

struct XcdBarrier {
    unsigned* bar; unsigned x;
    volatile LAS unsigned* st;
};

__device__ __forceinline__ XcdBarrier xcd_barrier_post(unsigned* bar, volatile LAS unsigned* st) {
    XcdBarrier b; b.bar = bar; b.x = xb_xcc_id(); b.st = st;
    if (threadIdx.x == 0) (void)xb_add(&bar[XB_XCNT(b.x)], 1u);
    return b;
}
__device__ __forceinline__ void xcd_barrier_complete(unsigned* bar, unsigned x, unsigned& nloc, unsigned& nx) {
    const unsigned G = gridDim.x * gridDim.y * gridDim.z;
    unsigned sum, cnt, mine, sp = 0u;
    for (;;) {
        sum = 0u; cnt = 0u; mine = 0u;
#pragma unroll
        for (unsigned j = 0; j < 16; ++j) { const unsigned c = xb_ld(&bar[XB_XCNT(j)]); sum += c; cnt += (c > 0u) ? 1u : 0u; mine = (j == x) ? c : mine; }
        if (sum == G) break;
        __builtin_amdgcn_s_sleep(1);
        if ((++sp & 255u) == 0u) { if (xb_ld(&bar[XB_TMO])) break; if (sp > XB_SPIN_CAP) { atomicAdd(&bar[XB_TMO], 1u); break; } }
    }
    nloc = mine > 0u ? mine : 1u; nx = cnt > 0u ? cnt : 1u;
}

__device__ __forceinline__ void xcd_barrier(const XcdBarrier& b) {
    asm volatile("s_waitcnt vmcnt(0)" ::: "memory");
    __syncthreads();
    if (threadIdx.x == 0) {
        unsigned* bar = b.bar;
        __builtin_amdgcn_s_waitcnt(0);
        unsigned nloc = b.st[0], nx = b.st[1];
        if (nloc == 0u) { xcd_barrier_complete(bar, b.x, nloc, nx); b.st[0] = nloc; b.st[1] = nx; }
        const unsigned old = xb_add(&bar[XB_XSUB(b.x)], 1u);
        const unsigned gen = old / nloc;
        if (old + 1u == (gen + 1u) * nloc) {
            __builtin_amdgcn_fence(__ATOMIC_RELEASE, "agent");
            asm volatile("s_waitcnt vmcnt(0)" ::: "memory");
            const unsigned og = xb_add(&bar[XB_TOP], 1u);
            const unsigned tg = og / nx;
            if (og + 1u == (tg + 1u) * nx) xb_add(&bar[XB_TOPGEN], 1u);
            else XB_SPIN(xb_ld(&bar[XB_TOPGEN]) == tg, bar);
            __builtin_amdgcn_fence(__ATOMIC_ACQUIRE, "agent");
            xb_add(&bar[XB_XGEN(b.x)], 1u);
            asm volatile("s_waitcnt vmcnt(0)" ::: "memory");
        } else {
            XB_SPIN(xb_ld(&bar[XB_XGEN(b.x)]) == gen, bar);
            __builtin_amdgcn_fence(__ATOMIC_ACQUIRE, "agent");
            asm volatile("s_waitcnt vmcnt(0)" ::: "memory");
        }
    }
    __syncthreads();
}

namespace swa {
typedef unsigned short u16;
typedef short bf16x8 __attribute__((ext_vector_type(8)));
typedef _Float16 f16x8 __attribute__((ext_vector_type(8)));
typedef short s16x4 __attribute__((ext_vector_type(4)));
typedef float f32x16 __attribute__((ext_vector_type(16)));
typedef float f32x4 __attribute__((ext_vector_type(4)));
typedef unsigned u32x4 __attribute__((ext_vector_type(4)));
constexpr int D = 128, W = 129;
constexpr float THR = 8.f;
constexpr float SCALE = 0.08838834764831845f;
constexpr int NW = 8, QBLK = 32, KVBLK = 64, QB = NW * QBLK;
constexpr int SHM_V = KVBLK * D * 2, SHM_K = KVBLK * D * 2;
constexpr int LDS_BYTES = 2 * SHM_V + 2 * SHM_K + NW * 64 * 4;
#define KSWZ(row, colB) ((row) * 256 + ((colB) ^ (((row) & 7) << 4)))
#define SBAR() __builtin_amdgcn_sched_barrier(0)
__device__ __forceinline__ int v_st(int k, int c) { const int kk = (k & ~0xC) | ((k & 4) << 1) | ((k & 8) >> 1); return ((kk >> 3) * 4 + (c >> 5)) * 512 + ((kk & 7) * 32 + (c & 31)) * 2; }
__device__ __forceinline__ int v_rd_base(int lane) { return ((lane & 3) << 3) | (((lane >> 2) & 3) << 6) | (((lane >> 4) & 1) << 5) | (((lane >> 5) & 1) << 8); }
constexpr int v_rd_off(int d0, int ks, int half) { return d0 * 512 + ks * 4096 + half * 2048; }
__device__ __forceinline__ int crow(int r, int hi) { return (r & 3) + 8 * (r >> 2) + 4 * hi; }
__device__ __forceinline__ unsigned cvtpk(float lo, float hi) { return pg8::cvt_pk_h(lo, hi); }
__device__ __forceinline__ float hlo(unsigned w) { return (float)__builtin_bit_cast(pg8::h16x2, w)[0]; }
__device__ __forceinline__ float hhi(unsigned w) { return (float)__builtin_bit_cast(pg8::h16x2, w)[1]; }
__device__ __forceinline__ bf16x8 load8(const u16* p) { return *reinterpret_cast<const bf16x8*>(p); }
#define SWA_MFMA(a, b, c) __builtin_amdgcn_mfma_f32_32x32x16_f16(__builtin_bit_cast(f16x8, a), __builtin_bit_cast(f16x8, b), c, 0, 0, 0)
__device__ __forceinline__ void mask_tile(f32x16& p0, f32x16& p1, int dq, unsigned Wd) {
    const float NEG = -__builtin_inff();
#pragma unroll
    for (int r = 0; r < 16; ++r) {
        const int c = (r & 3) + 8 * (r >> 2);
        if ((unsigned)(dq - c) >= Wd) p0[r] = NEG;
        if ((unsigned)(dq - c - 32) >= Wd) p1[r] = NEG;
    }
}
__device__ __forceinline__ void partialSM(f32x16& p0, f32x16& p1, float& m_reg, float& mn, float& alpha) {
    float pmax = p0[0]; for (int r = 1; r < 16; ++r) pmax = fmaxf(pmax, p0[r]); for (int r = 0; r < 16; ++r) pmax = fmaxf(pmax, p1[r]);
    { auto rr = __builtin_amdgcn_permlane32_swap(__float_as_uint(pmax), __float_as_uint(pmax), false, false);
      pmax = fmaxf(__uint_as_float(rr[0]), __uint_as_float(rr[1])); }
    constexpr float C2 = 1.4426950408889634f * SCALE;
    if (__builtin_expect(__all((pmax - m_reg) * SCALE <= THR), 1)) { mn = m_reg; alpha = 1.f; }
    else { mn = fmaxf(m_reg, pmax); alpha = __builtin_amdgcn_exp2f((m_reg - mn) * C2); m_reg = mn; }
    const float mnL = -mn * C2;
    for (int r = 0; r < 16; ++r) p0[r] = fmaf(p0[r], C2, mnL); for (int r = 0; r < 16; ++r) p1[r] = fmaf(p1[r], C2, mnL);
    for (int r = 0; r < 16; ++r) p0[r] = __builtin_amdgcn_exp2f(p0[r]);
}
__device__ __forceinline__ void finishSM(f32x16& p0, f32x16& p1, float alpha, float& l_reg, bf16x8& pa0, bf16x8& pa1, bf16x8& pa2, bf16x8& pa3) {
    for (int r = 0; r < 16; ++r) p1[r] = __builtin_amdgcn_exp2f(p1[r]);
    float ps = 0; for (int r = 0; r < 16; ++r) ps += p0[r]; for (int r = 0; r < 16; ++r) ps += p1[r];
    { auto rr = __builtin_amdgcn_permlane32_swap(__float_as_uint(ps), __float_as_uint(ps), false, false);
      ps = __uint_as_float(rr[0]) + __uint_as_float(rr[1]); }
    l_reg = l_reg * alpha + ps;
#define PK4(P, B_, OUT) do { unsigned a0 = cvtpk(P[B_+0], P[B_+1]), a1 = cvtpk(P[B_+2], P[B_+3]);                          \
        unsigned b0 = cvtpk(P[B_+4], P[B_+5]), b1 = cvtpk(P[B_+6], P[B_+7]);                                             \
        auto r0 = __builtin_amdgcn_permlane32_swap(a0, b0, false, false); auto r1 = __builtin_amdgcn_permlane32_swap(a1, b1, false, false); \
        u32x4 w = {r0[0], r1[0], r0[1], r1[1]}; OUT = *reinterpret_cast<bf16x8*>(&w); } while (0)
    PK4(p0, 0, pa0); PK4(p0, 8, pa1); PK4(p1, 0, pa2); PK4(p1, 8, pa3);
#undef PK4
}
template <int KB>
__device__ __forceinline__ void qkt(f32x16& p0, f32x16& p1, const char* K_lds, int r32, int hi, const bf16x8* qr, bool act) {
    if (!act) { const float NEG = -__builtin_inff();
#pragma unroll
        for (int r = 0; r < 16; ++r) { p0[r] = NEG; p1[r] = NEG; } return; }
    p0 = f32x16{}; p1 = f32x16{};
    const char* kb[4];
#pragma unroll
    for (int dd = 0; dd < 4; ++dd) kb[dd] = K_lds + KB * SHM_K + KSWZ(r32, (dd * 16 + hi * 8) * 2);
#pragma unroll
    for (int d0 = 0; d0 < 8; ++d0) { const char* a = kb[d0 & 3] + (d0 >> 2) * 128;
        bf16x8 b0 = *reinterpret_cast<const bf16x8*>(a);
        bf16x8 b1 = *reinterpret_cast<const bf16x8*>(a + 32 * 256);
        p0 = SWA_MFMA(b0, qr[d0], p0);
        p1 = SWA_MFMA(b1, qr[d0], p1); }
}
template <int VB>
__device__ __forceinline__ void pv_tile(f32x16* o, int vb0, bf16x8 pa0, bf16x8 pa1, bf16x8 pa2, bf16x8 pa3, bool act) {
    if (!act) return;
#define TRRD(dst, off) asm volatile("ds_read_b64_tr_b16 %0, %1 offset:%2" : "=&v"(dst) : "v"(vb0), "i"(off) : "memory")
#define PV_D0(d0) do { s16x4 l0, l1, l2, l3, h0, h1, h2, h3; constexpr int b_ = VB * SHM_V + v_rd_off(d0, 0, 0); \
        TRRD(l0, b_); TRRD(h0, b_ + 2048); TRRD(l1, b_ + 4096); TRRD(h1, b_ + 6144); TRRD(l2, b_ + 8192); TRRD(h2, b_ + 10240); TRRD(l3, b_ + 12288); TRRD(h3, b_ + 14336); \
        asm volatile("s_waitcnt lgkmcnt(0)" ::: "memory"); SBAR();   \
        o[d0] = SWA_MFMA(pa0, ((bf16x8){l0[0], l0[1], l0[2], l0[3], h0[0], h0[1], h0[2], h0[3]}), o[d0]);   \
        o[d0] = SWA_MFMA(pa1, ((bf16x8){l1[0], l1[1], l1[2], l1[3], h1[0], h1[1], h1[2], h1[3]}), o[d0]);   \
        o[d0] = SWA_MFMA(pa2, ((bf16x8){l2[0], l2[1], l2[2], l2[3], h2[0], h2[1], h2[2], h2[3]}), o[d0]);   \
        o[d0] = SWA_MFMA(pa3, ((bf16x8){l3[0], l3[1], l3[2], l3[3], h3[0], h3[1], h3[2], h3[3]}), o[d0]); } while (0)
    PV_D0(0); PV_D0(1); PV_D0(2); PV_D0(3);
#undef PV_D0
#undef TRRD
}
struct BlockRef { const u16* Q; const u16* K; const u16* V; int P0, skv, trow0, tstep, h; };
struct Seam { bf16x8 qr[8]; bf16x8 st_v0, st_v1, st_k0, st_k1; };
__device__ __forceinline__ int swa_jlo(int P0) { const int lowk = P0 - W + 1; return lowk > 0 ? lowk / KVBLK : 0; }
#define ROW(p, k0, rr) ((p) + (size_t)((k0) + (rr)) * D + sc)
#define VMW() asm volatile("s_waitcnt vmcnt(0)" ::: "memory")
#define VMWN(n) asm volatile("s_waitcnt vmcnt(%0)" :: "i"(n) : "memory")
#define SLOAD_H(Kp, Vp, k0) do { S.st_v0 = load8(ROW(Vp, k0, sr)); S.st_v1 = load8(ROW(Vp, k0, 32 + sr));              \
                         S.st_k0 = load8(ROW(Kp, k0, sr)); S.st_k1 = load8(ROW(Kp, k0, 32 + sr)); } while (0)
#define SWRITE_HK(bf) do { *(bf16x8*)(K_lds + (bf) * SHM_K + kws) = S.st_k0; *(bf16x8*)(K_lds + (bf) * SHM_K + kws + 32 * 256) = S.st_k1; } while (0)
#define SWRITE_HV(bf) do { *(bf16x8*)(V_lds + (bf) * SHM_V + vst0) = S.st_v0; *(bf16x8*)(V_lds + (bf) * SHM_V + vst1) = S.st_v1; } while (0)
#define SWRITE_H(bf) do { SWRITE_HV(bf); SWRITE_HK(bf); } while (0)
__device__ __forceinline__ void swa_prime(const BlockRef& cur, char* lds, Seam& S) {
    int tid = threadIdx.x; asm volatile("" : "+v"(tid));
    const int wid = __builtin_amdgcn_readfirstlane(tid >> 6), lane = tid & 63, r32 = lane & 31, hi = lane >> 5;
    const int sr = tid >> 4, sc = (tid & 15) * 8, kws = KSWZ(sr, sc * 2); char* K_lds = lds + 2 * SHM_V;
    const int kb0 = swa_jlo(cur.P0) * KVBLK;
    for (int d0 = 0; d0 < 8; ++d0) S.qr[d0] = load8(cur.Q + (size_t)(cur.P0 + wid * QBLK + r32) * D + d0 * 16 + hi * 8);
    SLOAD_H(cur.K, cur.V, kb0); VMW(); SWRITE_HK(0);
    __syncthreads();
}
__device__ __forceinline__ void swa_block(const BlockRef& cur, const BlockRef& nxt, char* lds, Seam& S, u16* OM, float* LSE, int first_group) {
    int tid = threadIdx.x; asm volatile("" : "+v"(tid));
    const int wid = __builtin_amdgcn_readfirstlane(tid >> 6), lane = tid & 63, r32 = lane & 31, hi = lane >> 5;
    const int j_lo = swa_jlo(cur.P0);
    int j_hi = (cur.P0 + QB - 1) / KVBLK + 1; if (j_hi > cur.skv / KVBLK) j_hi = cur.skv / KVBLK;
    const int NT = j_hi - j_lo;
    const int kbn = swa_jlo(nxt.P0) * KVBLK;
    const int qlo = cur.P0 + wid * QBLK, qm = qlo + r32 - 4 * hi;
    char* V_lds = lds; char* K_lds = lds + 2 * SHM_V;
    float* ws = (float*)(lds + 2 * SHM_V + 2 * SHM_K) + wid * 64; float* li_l = ws, * al_l = ws + 32;
    float m_reg = -1e30f, l_reg = 0; f32x16 o[4] = {};
    const int sr = tid >> 4, sc = (tid & 15) * 8, vst0 = v_st(sr, sc), vst1 = v_st(32 + sr, sc), kws = KSWZ(sr, sc * 2);
    const int vb0 = (int)(uintptr_t)V_lds + v_rd_base(lane);
    const u16* Kh = cur.K; const u16* Vh = cur.V;
#define RESC(a) do { if (__any((a) < 1.f)) { if (hi == 0) al_l[r32] = (a); asm volatile("s_waitcnt lgkmcnt(0)" ::: "memory");              \
                     for (int d_ = 0; d_ < 4; ++d_) for (int r = 0; r < 16; ++r) o[d_][r] *= al_l[crow(r, hi)]; } } while (0)
#define KBASE(t) ((j_lo + (t)) * KVBLK)
#define ACT(t) (KBASE(t) <= qlo + QBLK - 1 && KBASE(t) + KVBLK - 1 >= qlo - W + 1)
#define MASKT(P0_, P1_, t) do { const int kb_ = KBASE(t); if (ACT(t) && (kb_ + KVBLK - 1 > qlo || kb_ <= qlo + QBLK - 1 - W)) mask_tile(P0_, P1_, qm - kb_, (unsigned)W); } while (0)
    constexpr int NQL = 8;
#define SEAM_K0() do { VMWN(NQL); SWRITE_HK(0); SBAR(); } while (0)
    f32x16 pA0, pA1, pB0, pB1; float mnA, mnB, alA, alB; bf16x8 pa0, pa1, pa2, pa3;
    SWRITE_HV(0); SBAR();
    if (NT > 1) { SLOAD_H(Kh, Vh, KBASE(1)); }
    SBAR(); qkt<0>(pA0, pA1, K_lds, r32, hi, S.qr, ACT(0));
    MASKT(pA0, pA1, 0); partialSM(pA0, pA1, m_reg, mnA, alA);
    if (NT > 1) { VMW(); SWRITE_H(1); }
    __syncthreads();
#define HALF_STEP(PX0, PX1, mnX, alX, PY0, PY1, alY, t, KB, VB, SB) do {                                                      \
        SBAR(); qkt<KB>(PX0, PX1, K_lds, r32, hi, S.qr, ACT(t));                                             \
        finishSM(PY0, PY1, alY, l_reg, pa0, pa1, pa2, pa3); SBAR();                                                           \
        if ((t) + 1 < NT) { SLOAD_H(Kh, Vh, KBASE((t) + 1)); SBAR(); }                                               \
        pv_tile<VB>(o, vb0, pa0, pa1, pa2, pa3, ACT((t) - 1)); MASKT(PX0, PX1, (t)); partialSM(PX0, PX1, m_reg, mnX, alX);                                        \
        __syncthreads();                                                                                                      \
        if ((t) + 1 < NT) { VMW(); SWRITE_H(SB); }                                                                          \
        RESC(alX); __syncthreads(); } while (0)
    for (int t = 1; t + 1 < NT; t += 2) {
        HALF_STEP(pB0, pB1, mnB, alB, pA0, pA1, alA, t, 1, 0, 0);
        HALF_STEP(pA0, pA1, mnA, alA, pB0, pB1, alB, t + 1, 0, 1, 1);
    }
    const bool even = (NT & 1) == 0;
    if (even) { SBAR(); qkt<1>(pB0, pB1, K_lds, r32, hi, S.qr, ACT(NT - 1)); SBAR(); }
    SLOAD_H(nxt.K, nxt.V, kbn); SBAR();
#pragma unroll
    for (int d0 = 0; d0 < 8; ++d0) S.qr[d0] = load8(nxt.Q + (size_t)(nxt.P0 + wid * QBLK + r32) * D + d0 * 16 + hi * 8);
    SBAR();
    finishSM(pA0, pA1, alA, l_reg, pa0, pa1, pa2, pa3); SBAR();
    pv_tile<0>(o, vb0, pa0, pa1, pa2, pa3, ACT(even ? NT - 2 : NT - 1));
    if (even) { MASKT(pB0, pB1, NT - 1); partialSM(pB0, pB1, m_reg, mnB, alB); __syncthreads(); RESC(alB);
        finishSM(pB0, pB1, alB, l_reg, pa0, pa1, pa2, pa3); SBAR(); pv_tile<1>(o, vb0, pa0, pa1, pa2, pa3, ACT(NT - 1)); }
    SBAR(); SEAM_K0();
    if (hi == 0) { const size_t li = (size_t)(cur.trow0 + cur.tstep * (wid * QBLK + r32)) * 8 + cur.h; const float lse_n = m_reg * SCALE + __logf(l_reg);
        if (first_group) { li_l[r32] = 1.0f / l_reg; al_l[r32] = 0.f; LSE[li] = lse_n; }
        else { const float lo = LSE[li], mx = fmaxf(lo, lse_n), eo = __expf(lo - mx), en = __expf(lse_n - mx), inv = 1.0f / (eo + en);
               li_l[r32] = en * inv / l_reg; al_l[r32] = eo * inv; LSE[li] = mx + __logf(eo + en); } }
    asm volatile("s_waitcnt lgkmcnt(0)" ::: "memory");
    {
        u16* Ow = OM + (size_t)(cur.trow0 + cur.tstep * (wid * QBLK)) * 1024 + cur.h * D;
        const size_t rstep = (size_t)cur.tstep * 1024;
#pragma unroll
        for (int r = 0; r < 16; ++r) { const int orow = crow(r, hi); const float wn = li_l[orow], wo = al_l[orow];
            unsigned* rowp = (unsigned*)(Ow + (size_t)orow * rstep + r32);
#pragma unroll
            for (int d0 = 0; d0 < 4; ++d0) { float v = o[d0][r] * wn; float vn = __shfl_xor(v, 1);
                if ((r32 & 1) == 0) { unsigned* p = rowp + d0 * 16;
                    if (!first_group) { const unsigned ov = *p; v += wo * hlo(ov); vn += wo * hhi(ov); }
                    *p = cvtpk(v, vn); } } }
    }
    __syncthreads();
#undef RESC
#undef KBASE
#undef ACT
#undef MASKT
#undef SEAM_K0
#undef HALF_STEP
}
#undef ROW
#undef VMW
#undef VMWN
#undef SLOAD_H
#undef SWRITE_HK
#undef SWRITE_HV
#undef SWRITE_H
#undef KSWZ
#undef SBAR
#undef SWA_MFMA
__device__ __forceinline__ BlockRef swa_ref(int item, int ldil, const u16* Q, const u16* K, const u16* V) {
    const int L = 8192 >> ldil, nqb = L / QB, qb = item % nqb, seq = item / nqb;
    const int r = seq & ((1 << ldil) - 1), bh = seq >> ldil, b = bh >> 3, h = bh & 7;
    BlockRef x; const size_t base = (size_t)seq * L * D;
    x.Q = Q + base; x.K = K + base; x.V = V + base; x.P0 = qb * QB; x.skv = L; x.trow0 = b * 8192 + r + ((qb * QB) << ldil); x.tstep = 1 << ldil; x.h = h;
    return x;
}
__device__ __forceinline__ void attn_phase(char* lds, int vcu, int G, int ldil, const u16* Q, const u16* K, const u16* V, u16* OM, float* LSE, int first_group) {
    const int total = 512;
    int it = 2 * vcu; if (it >= total) return;
    const int per = 2;
    BlockRef cur = swa_ref(it, ldil, Q, K, V);
    Seam S;
    swa_prime(cur, lds, S);
    for (int k = 0; k < per; ++k) {
        const bool last = (k == per - 1);
        const BlockRef nxt = last ? cur : swa_ref(it + k + 1, ldil, Q, K, V);
        swa_block(cur, nxt, lds, S, OM, LSE, first_group);
        cur = nxt;
    }
}
}

constexpr int NWAVES = 8;
constexpr int BATCH = 2, SEQ = 8192, DM = 1024, MTOK = BATCH * SEQ, DFF = 4096;
constexpr int NGRP = 3, AH = 8, HD = 128, AIN = 9216;
constexpr int GH = 4, GDK = 128, GDV = 256, GKD = 512, GVD = 1024, GRANK = 16, GIN = 3088, GCH = 64;
constexpr float EPS = 1e-5f;
__host__ __device__ constexpr int grp_ldil(int g) { return g == 0 ? 0 : (g == 1 ? 2 : 4); }

constexpr size_t MiB = 1u << 20;
constexpr size_t WS_CTL = 0, CTL_ZERO_BYTES = 1 * MiB;
constexpr size_t WS_SSQ = 1 * MiB;
constexpr size_t WS_LSE = 2 * MiB;
constexpr size_t WS_COS = 3 * MiB, WS_SIN = 5 * MiB;
constexpr size_t WS_WG = 7 * MiB;
constexpr size_t WS_WQKV = 8 * MiB, WS_WO0 = 26 * MiB, WS_WUP0 = 28 * MiB, WS_WDN0 = 36 * MiB;
constexpr size_t WS_WGLA = 44 * MiB, WS_WO1 = 50 * MiB, WS_WUP1 = 52 * MiB, WS_WDN1 = 60 * MiB;
constexpr size_t WS_XB = 68 * MiB;
constexpr size_t WS_Q = 100 * MiB, WS_K = 132 * MiB, WS_V = 164 * MiB;
constexpr size_t WS_OM = 196 * MiB;
constexpr size_t WS_H = 100 * MiB;
constexpr size_t WS_GQ = 100 * MiB, WS_GK = 116 * MiB, WS_GV = 132 * MiB, WS_GG = 164 * MiB;
constexpr size_t WS_GB = 196 * MiB;
constexpr size_t WS_GS = 8 * MiB;
constexpr size_t WS_XB1 = 8 * MiB;
constexpr size_t WS_GD = 228 * MiB;
constexpr size_t WS_END = 256 * MiB;
constexpr int CW_TMO = 0, CW_CODE = 1, CW_BAR = 4096;

constexpr int RING_OFF = 0, RING_BYTES = 131072;
constexpr int LDSCTL_OFF = RING_BYTES, MISC_OFF = LDSCTL_OFF + 320;
constexpr int LDS_BYTES = 147456;
constexpr int INPTR_LDS_OFF = 131072 + 512 + 2048 + 512;
constexpr int GLR_LDS_OFF = 131072 + 512 + 2048;
static_assert(MISC_OFF + 128 <= LDS_BYTES, "LDS map");

#ifndef GLA_SIMPLE
#define GLA_SIMPLE 1
#endif
enum Phase { PH_PRO = 0, PH_QKV0 = 1, PH_ATT0 = 2, PH_QKV1 = 3, PH_ATT1 = 4, PH_QKV2 = 5, PH_ATT2 = 6, PH_WO0 = 7, PH_UP0 = 8, PH_DN0 = 9,
             PH_GLAP = 10, PH_GLA1 = 11, PH_GLA2 = 12, PH_GLA3 = 13, PH_WO1 = 14, PH_UP1 = 15, PH_DN1 = 16, PH_FIN = 17, PH_N = 18 };

struct Frame {
    LAS unsigned char* lds;
    volatile LAS unsigned* MISC;
    gu32* ctl;
    int tid, lane, wave;
    int vcu, G;
};
__device__ __forceinline__ float wave_sum(float v) {
#pragma unroll
    for (int o = 1; o < 64; o <<= 1) v += __shfl_xor(v, o);
    return v;
}
__device__ __forceinline__ float bf2f(unsigned short h) { return __builtin_bit_cast(float, (unsigned)h << 16); }
__device__ __forceinline__ unsigned pkh(float lo, float hi) { return pg8::cvt_pk_h(lo, hi); }
__device__ __forceinline__ float hlo(unsigned w) { return (float)__builtin_bit_cast(pg8::h16x2, w)[0]; }
__device__ __forceinline__ float hhi(unsigned w) { return (float)__builtin_bit_cast(pg8::h16x2, w)[1]; }
__device__ __forceinline__ float h2f(unsigned short h) { return (float)__builtin_bit_cast(_Float16, h); }

__device__ __forceinline__ void xpose_item(const float* W, int ldn, int K, const float* nw, bf16* WT, int dst_row0, int k0, int n0, int nvalid, LAS float* scr, int lane) {
    const bool cv = (lane & 31) < nvalid;
#pragma unroll 8
    for (int i = 0; i < 32; ++i) { const int kk = 2 * i + (lane >> 5); float w = cv ? W[(size_t)(k0 + kk) * ldn + n0 + (lane & 31)] : 0.f; if (nw) w *= nw[k0 + kk]; scr[kk * 33 + (lane & 31)] = w; }
    LDS_WAIT(); asm volatile("" ::: "memory");
    const int c = lane & 7;
#pragma unroll
    for (int j = 0; j < 4; ++j) { const int n = (lane >> 3) + 8 * j; const LAS float* s = scr + (8 * c) * 33 + n;
        v4u o; o.x = pkh(s[0 * 33], s[1 * 33]); o.y = pkh(s[2 * 33], s[3 * 33]); o.z = pkh(s[4 * 33], s[5 * 33]); o.w = pkh(s[6 * 33], s[7 * 33]);
        if (n < nvalid) *(GAS v4u*)(WT + (size_t)(dst_row0 + n) * K + k0 + 8 * c) = o; }
    LDS_WAIT(); asm volatile("" ::: "memory");
}
__device__ __forceinline__ void sincos_f(float x, float& s, float& c) {
    const float k = __builtin_rintf(x * 0.636619772f);
    float r = __builtin_fmaf(-k, 1.5703125f, x); r = __builtin_fmaf(-k, 0.0004837512969970703f, r); r = __builtin_fmaf(-k, 7.549533620476723e-08f, r); r = __builtin_fmaf(-k, 2.5632829192545614e-12f, r);
    const float r2 = r * r;
    const float sr = r + r * r2 * (-1.6666654611e-1f + r2 * (8.3321608736e-3f + r2 * -1.9515295891e-4f));
    const float cr = 1.0f - 0.5f * r2 + r2 * r2 * (4.166664568298827e-2f + r2 * (-1.388731625493765e-3f + r2 * 2.443315711809948e-5f));
    const int q = (int)k & 3;
    s = (q == 0) ? sr : (q == 1) ? cr : (q == 2) ? -sr : -cr;
    c = (q == 0) ? cr : (q == 1) ? -sr : (q == 2) ? -cr : sr;
}
__device__ const float ROPE_INVF[64] = {1.000000000e+00f, 8.659643531e-01f, 7.498942614e-01f, 6.493816376e-01f, 5.623413324e-01f, 4.869675338e-01f, 4.216965139e-01f, 3.651741147e-01f, 3.162277639e-01f, 2.738419771e-01f, 2.371373773e-01f, 2.053525001e-01f, 1.778279394e-01f, 1.539926529e-01f, 1.333521307e-01f, 1.154782027e-01f, 1.000000015e-01f, 8.659642935e-02f, 7.498941571e-02f, 6.493816525e-02f, 5.623413250e-02f, 4.869675264e-02f, 4.216965288e-02f, 3.651741147e-02f, 3.162277490e-02f, 2.738419734e-02f, 2.371373773e-02f, 2.053525113e-02f, 1.778279431e-02f, 1.539926510e-02f, 1.333521493e-02f, 1.154782064e-02f, 9.999999776e-03f, 8.659643121e-03f, 7.498941850e-03f, 6.493816152e-03f, 5.623413250e-03f, 4.869675264e-03f, 4.216964822e-03f, 3.651741194e-03f, 3.162277630e-03f, 2.738419687e-03f, 2.371373586e-03f, 2.053524833e-03f, 1.778279431e-03f, 1.539926510e-03f, 1.333521446e-03f, 1.154781901e-03f, 1.000000047e-03f, 8.659643354e-04f, 7.498942432e-04f, 6.493816618e-04f, 5.623413017e-04f, 4.869675322e-04f, 4.216965172e-04f, 3.651741426e-04f, 3.162277571e-04f, 2.738419571e-04f, 2.371373703e-04f, 2.053525095e-04f, 1.778279402e-04f, 1.539926452e-04f, 1.333521504e-04f, 1.154782003e-04f};

__device__ __forceinline__ const float* in_ptr(LAS unsigned char* lds, int k) {
    const unsigned long long v = ((volatile LAS unsigned long long*)(lds + INPTR_LDS_OFF))[k];
    const unsigned lo = __builtin_amdgcn_readfirstlane((unsigned)v), hi = __builtin_amdgcn_readfirstlane((unsigned)(v >> 32));
    return (const float*)(((unsigned long long)hi << 32) | lo);
}

__device__ __forceinline__ void gla_simple_phase(LAS unsigned char* ldsb, int vcu, const bf16* q, const bf16* k, const bf16* v, const bf16* g, const float* Bc, const float* normw, bf16* GO) {
    if (vcu >= BATCH * GH) return;
    int tid = threadIdx.x; asm volatile("" : "+v"(tid));
    LAS float* as_ = (LAS float*)ldsb; LAS float* ks_ = as_ + 256; LAS float* qs_ = ks_ + 256; LAS float* red = qs_ + 256;
    const int vp = tid >> 2, qt = tid & 3, wv = tid >> 6, lane = tid & 63;
    const int b = vcu >> 2, h = vcu & 3;
    float S0[32], S1[32];
#pragma unroll
    for (int j = 0; j < 32; ++j) { S0[j] = 0.f; S1[j] = 0.f; }
    const float nw0 = normw[vp], nw1 = normw[vp + 128];
    for (int t = 0; t < SEQ; ++t) { const size_t row = (size_t)b * SEQ + t; const int bf = t & 1;
        if (tid < 128) { const float* bp = Bc + row * GKD + h * GDK + tid; const float la = bp[0] - ((t & 63) ? bp[-GKD] : 0.f);
            as_[bf * 128 + tid] = expf(la); ks_[bf * 128 + tid] = bf2f(k[row * GKD + h * GDK + tid]); qs_[bf * 128 + tid] = bf2f(q[row * GKD + h * GDK + tid]) * 0.08838834764831845f; }
        const float v0 = bf2f(v[row * GVD + h * GDV + vp]), v1 = bf2f(v[row * GVD + h * GDV + vp + 128]);
        __syncthreads();
        float o0 = 0.f, o1 = 0.f;
#pragma unroll
        for (int c = 0; c < 8; ++c) { const f32x4 a4 = *(const LAS f32x4*)&as_[bf * 128 + qt * 32 + 4 * c], k4 = *(const LAS f32x4*)&ks_[bf * 128 + qt * 32 + 4 * c], q4 = *(const LAS f32x4*)&qs_[bf * 128 + qt * 32 + 4 * c];
#pragma unroll
            for (int e = 0; e < 4; ++e) { const int j = 4 * c + e; S0[j] = a4[e] * S0[j] + k4[e] * v0; o0 += q4[e] * S0[j]; S1[j] = a4[e] * S1[j] + k4[e] * v1; o1 += q4[e] * S1[j]; } }
        o0 += __shfl_xor(o0, 1); o0 += __shfl_xor(o0, 2); o1 += __shfl_xor(o1, 1); o1 += __shfl_xor(o1, 2);
        float sq = qt == 0 ? o0 * o0 + o1 * o1 : 0.f; sq = wave_sum(sq);
        if (lane == 0) red[bf * 8 + wv] = sq;
        __syncthreads();
        float tot = 0.f;
#pragma unroll
        for (int w = 0; w < 8; ++w) tot += red[bf * 8 + w];
        const float rstd = 1.0f / sqrtf(tot * (1.0f / GDV) + EPS);
        if (qt == 0) { const float g0 = bf2f(g[row * GVD + h * GDV + vp]), g1 = bf2f(g[row * GVD + h * GDV + vp + 128]);
            GO[row * GVD + h * GDV + vp] = __builtin_bit_cast(unsigned short, (_Float16)(o0 * rstd * nw0 * (g0 / (1.0f + expf(-g0)))));
            GO[row * GVD + h * GDV + vp + 128] = __builtin_bit_cast(unsigned short, (_Float16)(o1 * rstd * nw1 * (g1 / (1.0f + expf(-g1))))); }
    }
}

struct Args { const float* in[13]; float* out; unsigned char* ws; int ph_lo, ph_hi, li, skip_mask; };

__global__ void __launch_bounds__(NWAVES * 64, 2) mega_fwd(Args args) {
    extern __shared__ __attribute__((aligned(16))) unsigned char lds[];
    Frame F;
    F.lds = (LAS unsigned char*)lds;
    F.MISC = (volatile LAS unsigned*)(F.lds + MISC_OFF);
    F.tid = threadIdx.x; F.lane = F.tid & 63; F.wave = __builtin_amdgcn_readfirstlane(F.tid >> 6);
    F.G = gridDim.x; { const int bx = blockIdx.x; F.vcu = (F.G % 8 == 0) ? (bx % 8) * (F.G / 8) + bx / 8 : bx; }
    unsigned char* ws = args.ws;
    F.ctl = (gu32*)(ws + WS_CTL);
    for (int u = F.tid; u < (LDS_BYTES - LDSCTL_OFF) / 4; u += NWAVES * 64) ((LAS unsigned*)(F.lds + LDSCTL_OFF))[u] = 0u;
    __syncthreads();
    const bool multi = (args.ph_hi - args.ph_lo) > 1;
    XcdBarrier bar; bar.bar = (unsigned*)(F.ctl + CW_BAR) + args.li * XCD_BAR_WORDS; bar.x = 0; bar.st = nullptr;
    if (multi) bar = xcd_barrier_post((unsigned*)(F.ctl + CW_BAR) + args.li * XCD_BAR_WORDS, F.MISC + 8);

    if (F.tid == 0) {
#pragma unroll
        for (int k = 0; k < 13; ++k) ((LAS unsigned long long*)(F.lds + INPTR_LDS_OFF))[k] = (unsigned long long)args.in[k]; }
    __syncthreads();
#define INP(k) in_ptr(F.lds, (k))
    float* const xres = args.out;
    float* const ssq = (float*)(ws + WS_SSQ);
    bf16* const XB = (bf16*)(ws + WS_XB);
    const int gw = F.vcu * NWAVES + F.wave, NGW = F.G * NWAVES;
    LAS float* const rl = (LAS float*)(F.lds + pg8::RSTD_LDS_OFF);

    for (int ph = args.ph_lo; ph < args.ph_hi; ++ph) {
      if (!((args.skip_mask >> ph) & 1)) {
        if (ph == PH_PRO) {
#ifndef NO_PRO
            int tid = threadIdx.x; asm volatile("" : "+v"(tid)); const int lane = tid & 63;
            LAS float* scr = (LAS float*)(F.lds + RING_OFF + F.wave * 16384);
            constexpr int I_QKV = 16 * 288, I_O = 16 * 32, I_UP = 16 * 128, I_DN = 64 * 32, I_GLA = 16 * 97;
            constexpr int NITEMS = I_QKV + 2 * I_O + 2 * I_UP + 2 * I_DN + I_GLA;
            for (int it = gw; it < NITEMS; it += NGW) {
                int r = it; const float* W; int ldn, K = DM, nvalid = 32, dst_row0, k0, n0; const float* nw = nullptr; bf16* WT;
                if (r < I_QKV) { const int kb = r / 288, nb = r % 288; n0 = nb * 32; const int nin = n0 % 3072, which = nin / 1024, j = nin % 1024;
                    const int jd = which < 2 ? ((j & ~0xC0) | ((j & 0x40) << 1) | ((j & 0x80) >> 1)) : j;
                    W = INP(4); ldn = AIN; nw = INP(1); WT = (bf16*)(ws + WS_WQKV); dst_row0 = n0 - j + jd; k0 = kb * 64; }
                else if ((r -= I_QKV) < I_O) { W = INP(5); ldn = DM; WT = (bf16*)(ws + WS_WO0); n0 = dst_row0 = (r % 32) * 32; k0 = (r / 32) * 64; }
                else if ((r -= I_O) < I_O) { W = INP(10); ldn = DM; WT = (bf16*)(ws + WS_WO1); n0 = dst_row0 = (r % 32) * 32; k0 = (r / 32) * 64; }
                else if ((r -= I_O) < I_UP) { W = INP(11); ldn = DFF; nw = INP(2); WT = (bf16*)(ws + WS_WUP0); n0 = dst_row0 = (r % 128) * 32; k0 = (r / 128) * 64; }
                else if ((r -= I_UP) < I_UP) { W = INP(11) + (size_t)DM * DFF; ldn = DFF; nw = INP(2) + DM; WT = (bf16*)(ws + WS_WUP1); n0 = dst_row0 = (r % 128) * 32; k0 = (r / 128) * 64; }
                else if ((r -= I_UP) < I_DN) { W = INP(12); ldn = DM; K = DFF; WT = (bf16*)(ws + WS_WDN0); n0 = dst_row0 = (r % 32) * 32; k0 = (r / 32) * 64; }
                else if ((r -= I_DN) < I_DN) { W = INP(12) + (size_t)DFF * DM; ldn = DM; K = DFF; WT = (bf16*)(ws + WS_WDN1); n0 = dst_row0 = (r % 32) * 32; k0 = (r / 32) * 64; }
                else { r -= I_DN; const int kb = r / 97, nb = r % 97; W = INP(6); ldn = GIN; nw = INP(1) + DM; k0 = kb * 64; n0 = nb * 32;
                    if (nb < 96) { WT = (bf16*)(ws + WS_WGLA); dst_row0 = n0; } else { WT = (bf16*)(ws + WS_WG); dst_row0 = 0; nvalid = 16; } }
                xpose_item(W, ldn, K, nw, WT, dst_row0, k0, n0, nvalid, scr, lane);
            }
            { float* cosT = (float*)(ws + WS_COS); float* sinT = (float*)(ws + WS_SIN);
              for (int e = blockIdx.x * (NWAVES * 64) + tid; e < SEQ * 64; e += F.G * NWAVES * 64) { const int pos = e >> 6, i = e & 63;
                  const float ang = (float)pos * ROPE_INVF[i]; float sn, cs; sincos_f(ang, sn, cs); cosT[e] = cs; sinT[e] = sn; } }
            const float* x_in = INP(0);
            for (int m = gw; m < MTOK; m += NGW) { const GAS f32x4* xr = (const GAS f32x4*)(x_in + (size_t)m * DM) + lane; float s = 0.f;
                GAS unsigned long long* o8 = (GAS unsigned long long*)(XB + (size_t)m * DM) + lane;
#pragma unroll
                for (int j = 0; j < 4; ++j) { const f32x4 v = xr[64 * j]; s += (v.x * v.x + v.y * v.y) + (v.z * v.z + v.w * v.w);
                    o8[64 * j] = (unsigned long long)pkh(v.x, v.y) | ((unsigned long long)pkh(v.z, v.w) << 32); }
                s = wave_sum(s); if (lane < 16) ssq[(size_t)m * 16 + lane] = lane == 0 ? s : 0.f; }
#endif
        }
        else if (ph == PH_QKV0 || ph == PH_QKV1 || ph == PH_QKV2) {
            const int g = (ph - PH_QKV0) >> 1;
            pg8::Gemm gm{XB, (const bf16*)(ws + WS_WQKV) + (size_t)g * 3072 * DM, MTOK, 3072, DM}; pg8::RstdOrder S; S.init(MTOK, 3072, F.G, (int)blockIdx.x); S.ssq = ssq; S.rl = rl;
            pg8::EpiQKV E{(bf16*)(ws + WS_Q), (bf16*)(ws + WS_K), (bf16*)(ws + WS_V), rl, (const float*)(ws + WS_COS), (const float*)(ws + WS_SIN), g == 0 ? 0 : (g == 1 ? 2 : 4)};
#ifndef NO_QKV
            pg8::gemm_phase<pg8::EpiQKV, pg8::RstdOrder, true, true>(F.lds + RING_OFF, gm, S, E);
#endif
        }
        else if (ph == PH_ATT0 || ph == PH_ATT1 || ph == PH_ATT2) {
            const int g = (ph - PH_ATT0) >> 1;
            swa::attn_phase((char*)lds, F.vcu, F.G, g == 0 ? 0 : (g == 1 ? 2 : 4), (const swa::u16*)(ws + WS_Q), (const swa::u16*)(ws + WS_K), (const swa::u16*)(ws + WS_V), (swa::u16*)(ws + WS_OM), (float*)(ws + WS_LSE), g == 0);
        }
        else if (ph == PH_WO0 || ph == PH_DN0 || ph == PH_WO1 || ph == PH_DN1) {
            const bf16* A; const bf16* Bt; int K; const float* resid = xres; bf16* xbo = XB;
            if (ph == PH_WO0) { A = (const bf16*)(ws + WS_OM); Bt = (const bf16*)(ws + WS_WO0); K = DM; resid = INP(0); }
            else if (ph == PH_DN0) { A = (const bf16*)(ws + WS_H); Bt = (const bf16*)(ws + WS_WDN0); K = DFF; }
            else if (ph == PH_WO1) { A = XB; Bt = (const bf16*)(ws + WS_WO1); K = DM; xbo = (bf16*)(ws + WS_XB1); }
            else { A = (const bf16*)(ws + WS_H); Bt = (const bf16*)(ws + WS_WDN1); K = DFF; }
            pg8::Gemm gm{A, Bt, MTOK, DM, K}; pg8::PlainOrder S; S.init(MTOK, DM, F.G, (int)blockIdx.x);
            pg8::EpiResid E{resid, xres, xbo, ssq};
#ifndef NO_RES
            pg8::gemm_phase<pg8::EpiResid, pg8::PlainOrder, false, true>(F.lds + RING_OFF, gm, S, E);
#endif
        }
        else if (ph == PH_UP0 || ph == PH_UP1) {
            const bf16* A = ph == PH_UP0 ? XB : (const bf16*)(ws + WS_XB1);
            pg8::Gemm gm{A, (const bf16*)(ws + (ph == PH_UP0 ? WS_WUP0 : WS_WUP1)), MTOK, DFF, DM}; pg8::RstdOrder S; S.init(MTOK, DFF, F.G, (int)blockIdx.x); S.ssq = ssq; S.rl = rl;
            pg8::EpiUp E{(bf16*)(ws + WS_H), rl};
#ifndef NO_UP
            pg8::gemm_phase<pg8::EpiUp, pg8::RstdOrder, true, true>(F.lds + RING_OFF, gm, S, E);
#endif
        }
        else if (ph == PH_GLAP) {
            { pg8::Gemm gm{XB, (const bf16*)(ws + WS_WGLA), MTOK, 3072, DM}; pg8::RstdOrder S; S.init(MTOK, 3072, F.G, (int)blockIdx.x); S.ssq = ssq; S.rl = rl;
              pg8::EpiGla E{(bf16*)(ws + WS_GQ), (bf16*)(ws + WS_GK), (bf16*)(ws + WS_GV), (bf16*)(ws + WS_GG), rl};
#ifndef NO_GLAP
              pg8::gemm_phase<pg8::EpiGla, pg8::RstdOrder, true, true>(F.lds + RING_OFF, gm, S, E);
#endif
 }
#ifndef NO_GATE
            __syncthreads();
            int tid = threadIdx.x; asm volatile("" : "+v"(tid)); const int lane = tid & 63;
            { LAS float* la = (LAS float*)(F.lds + RING_OFF);
              LAS float* gl = (LAS float*)(F.lds + GLR_LDS_OFF) + F.wave * GRANK;
              const bf16* WG = (const bf16*)(ws + WS_WG); const float* wgu = INP(7); const float* bg = INP(8); float* GB = (float*)(ws + WS_GB);
              for (int ch = F.vcu; ch < MTOK / GCH; ch += F.G) {
#pragma unroll 1
                  for (int tt = F.wave; tt < GCH; tt += NWAVES) { const int row = ch * GCH + tt;
                      const GAS v4u* xr = (const GAS v4u*)(XB + (size_t)row * DM) + 2 * lane; const v4u xa = xr[0], xc = xr[1];
                      float sq = lane < 16 ? ssq[(size_t)row * 16 + lane] : 0.f; sq = wave_sum(sq); const float rstd = 1.0f / sqrtf(sq * (1.0f / DM) + EPS);
#pragma unroll 1
                      for (int j = 0; j < GRANK; ++j) { const GAS v4u* wr_ = (const GAS v4u*)(WG + (size_t)j * DM) + 2 * lane; const v4u wa = wr_[0], wc_ = wr_[1]; float d = 0.f;
#pragma unroll
                          for (int e = 0; e < 4; ++e) { d += hlo(xa[e]) * hlo(wa[e]) + hhi(xa[e]) * hhi(wa[e]); d += hlo(xc[e]) * hlo(wc_[e]) + hhi(xc[e]) * hhi(wc_[e]); }
                          d = wave_sum(d) * rstd; if (lane == 0) gl[j] = d; }
                      LDS_WAIT(); asm volatile("" ::: "memory");
#pragma unroll 1
                      for (int i = 0; i < 8; ++i) { const int c = lane + 64 * i; float gk = bg[c];
#pragma unroll
                          for (int j = 0; j < GRANK; ++j) gk += gl[j] * wgu[j * GKD + c];
                          const float ls = fminf(gk, 0.f) - log1pf(expf(-fabsf(gk)));
                          la[tt * GKD + c] = ls * (1.0f / 16.0f); }
                      LDS_WAIT(); asm volatile("" ::: "memory"); }
                  __syncthreads();
                  { const int c = tid; float run = 0.f;
#pragma unroll 4
                    for (int tt = 0; tt < GCH; ++tt) { run += la[tt * GKD + c]; GB[(size_t)(ch * GCH + tt) * GKD + c] = run; } }
                  __syncthreads();
              } }
#endif
        }
        else if (ph == PH_GLA1 || ph == PH_GLA2 || ph == PH_GLA3) {
#if GLA_SIMPLE
            if (ph == PH_GLA3) gla_simple_phase(F.lds + RING_OFF, F.vcu, (const bf16*)(ws + WS_GQ), (const bf16*)(ws + WS_GK), (const bf16*)(ws + WS_GV), (const bf16*)(ws + WS_GG), (const float*)(ws + WS_GB), INP(9), XB);
#endif
        }
        else if (ph == PH_FIN) {
            int tid = threadIdx.x; asm volatile("" : "+v"(tid)); const int lane = tid & 63;
            const float* final_w = INP(3);
            for (int m = gw; m < MTOK; m += NGW) { GAS f32x4* xr = (GAS f32x4*)(xres + (size_t)m * DM) + lane; f32x4 v[4]; float s = 0.f;
#pragma unroll
                for (int j = 0; j < 4; ++j) { v[j] = xr[64 * j]; s += (v[j].x * v[j].x + v[j].y * v[j].y) + (v[j].z * v[j].z + v[j].w * v[j].w); }
                const float rstd = 1.0f / sqrtf(wave_sum(s) * (1.0f / DM) + EPS);
#pragma unroll
                for (int j = 0; j < 4; ++j) { const f32x4 w = *((const f32x4*)final_w + lane + 64 * j); xr[64 * j] = v[j] * rstd * w; } }
        }
      }
      if (ph + 1 < args.ph_hi) xcd_barrier(bar);
    }
}

__global__ void __launch_bounds__(256) naive_attn(const bf16* __restrict__ Q, const bf16* __restrict__ K, const bf16* __restrict__ V, bf16* OM, float* LSE, int g, int ldil) {
    __shared__ float qs[4][128];
    const int lane = threadIdx.x & 63, wv = threadIdx.x >> 6;
    const int item = blockIdx.x * 4 + wv, row = item >> 3, h = item & 7;
    const int b = row >> 13, t = row & (SEQ - 1), r = t & ((1 << ldil) - 1), i = t >> ldil, L = SEQ >> ldil;
    const size_t base = (size_t)((((b * AH + h) << ldil) + r)) * L;
    const bf16* Qr = Q + (base + i) * HD; const bf16* Ks = K + base * HD; const bf16* Vs = V + base * HD;
    qs[wv][lane] = h2f(Qr[lane]); qs[wv][lane + 64] = h2f(Qr[lane + 64]);
    __syncthreads();
    float sc[3];
#pragma unroll
    for (int sl = 0; sl < 3; ++sl) { const int jj = lane + 64 * sl; float s = -INFINITY;
        if (jj <= 128 && i - jj >= 0) { const v4u* kp = (const v4u*)(Ks + (size_t)(i - jj) * HD); s = 0.f;
            for (int c = 0; c < 16; ++c) { const v4u kv = kp[c];
#pragma unroll
                for (int e = 0; e < 4; ++e) s += qs[wv][8 * c + 2 * e] * hlo(kv[e]) + qs[wv][8 * c + 2 * e + 1] * hhi(kv[e]); }
            s *= 0.08838834764831845f; }
        sc[sl] = s; }
    float m = fmaxf(fmaxf(sc[0], sc[1]), sc[2]);
#pragma unroll
    for (int o = 1; o < 64; o <<= 1) m = fmaxf(m, __shfl_xor(m, o));
    float p[3], l = 0.f;
#pragma unroll
    for (int sl = 0; sl < 3; ++sl) { p[sl] = expf(sc[sl] - m); l += p[sl]; }
    l = wave_sum(l);
    float o0 = 0.f, o1 = 0.f;
#pragma unroll
    for (int sl = 0; sl < 3; ++sl)
        for (int ll = 0; ll < 64; ++ll) { const int jj = sl * 64 + ll; if (jj > 128 || i - jj < 0) break;
            const float pj = __shfl(p[sl], ll); const unsigned vv = ((const unsigned*)(Vs + (size_t)(i - jj) * HD))[lane];
            o0 += pj * hlo(vv); o1 += pj * hhi(vv); }
    o0 /= l; o1 /= l; float lse = m + logf(l);
    unsigned* op = (unsigned*)(OM + (size_t)row * DM + h * HD) + lane;
    if (g > 0) { const float lo = LSE[(size_t)row * 8 + h]; const unsigned ov = *op; const float mx = fmaxf(lo, lse), wo = expf(lo - mx), wn = expf(lse - mx), inv = 1.0f / (wo + wn);
        o0 = (wo * hlo(ov) + wn * o0) * inv; o1 = (wo * hhi(ov) + wn * o1) * inv; lse = mx + logf(wo + wn); }
    *op = pkh(o0, o1);
    if (lane == 0) LSE[(size_t)row * 8 + h] = lse;
}
__global__ void __launch_bounds__(1024) naive_gla(const bf16* __restrict__ q, const bf16* __restrict__ k, const bf16* __restrict__ v, const bf16* __restrict__ g, const float* __restrict__ Bc,
                                                    const float* __restrict__ normw, bf16* GO) {
    __shared__ float red[2][16];
    __shared__ __attribute__((aligned(16))) float as_[2][128], ks_[2][128], qs_[2][128];
    const int tid = threadIdx.x, vloc = tid >> 2, qt = tid & 3, wv = tid >> 6, lane = tid & 63;
    const int b = blockIdx.x >> 2, h = blockIdx.x & 3;
    float S[32];
#pragma unroll
    for (int j = 0; j < 32; ++j) S[j] = 0.f;
    const float nw = normw[vloc];
    for (int t = 0; t < SEQ; ++t) { const size_t row = (size_t)b * SEQ + t; const int bf = t & 1;
        if (tid < 128) { const float* bp = Bc + row * GKD + h * GDK + tid; const float la = bp[0] - ((t & 63) ? bp[-GKD] : 0.f);
            as_[bf][tid] = expf(la); ks_[bf][tid] = bf2f(k[row * GKD + h * GDK + tid]); qs_[bf][tid] = bf2f(q[row * GKD + h * GDK + tid]) * 0.08838834764831845f; }
        const float vv = bf2f(v[row * GVD + h * GDV + vloc]);
        __syncthreads();
        float o = 0.f;
#pragma unroll
        for (int c = 0; c < 8; ++c) { const f32x4 a4 = *(const f32x4*)&as_[bf][qt * 32 + 4 * c], k4 = *(const f32x4*)&ks_[bf][qt * 32 + 4 * c], q4 = *(const f32x4*)&qs_[bf][qt * 32 + 4 * c];
#pragma unroll
            for (int e = 0; e < 4; ++e) { const int j = 4 * c + e; S[j] = a4[e] * S[j] + k4[e] * vv; o += q4[e] * S[j]; } }
        o += __shfl_xor(o, 1); o += __shfl_xor(o, 2);
        float sq = qt == 0 ? o * o : 0.f; sq = wave_sum(sq);
        if (lane == 0) red[bf][wv] = sq;
        __syncthreads();
        float tot = 0.f;
#pragma unroll
        for (int w = 0; w < 16; ++w) tot += red[bf][w];
        const float rstd = 1.0f / sqrtf(tot * (1.0f / GDV) + EPS);
        if (qt == 0) { const float gg = bf2f(g[row * GVD + h * GDV + vloc]); const float y = o * rstd * nw * (gg / (1.0f + expf(-gg))); GO[row * GVD + h * GDV + vloc] = __builtin_bit_cast(unsigned short, (_Float16)y); }
    }
}


__global__ void __launch_bounds__(256) probe_maxdiff_h(const unsigned short* a, const unsigned short* b, size_t n, unsigned* slot) {
    float m = 0.f;
    for (size_t i = (size_t)blockIdx.x * 256 + threadIdx.x; i < n; i += (size_t)gridDim.x * 256) { const float d = fabsf(h2f(a[i]) - h2f(b[i])); m = (d > m || d != d) ? (d != d ? 1e30f : d) : m; }
#pragma unroll
    for (int o = 1; o < 64; o <<= 1) m = fmaxf(m, __shfl_xor(m, o));
    if ((threadIdx.x & 63) == 0) atomicMax(slot, __float_as_uint(m));
}
__global__ void __launch_bounds__(256) probe_maxdiff_f(const float* a, const float* b, size_t n, unsigned* slot) {
    float m = 0.f;
    for (size_t i = (size_t)blockIdx.x * 256 + threadIdx.x; i < n; i += (size_t)gridDim.x * 256) { const float d = fabsf(a[i] - b[i]); m = (d > m || d != d) ? (d != d ? 1e30f : d) : m; }
#pragma unroll
    for (int o = 1; o < 64; o <<= 1) m = fmaxf(m, __shfl_xor(m, o));
    if ((threadIdx.x & 63) == 0) atomicMax(slot, __float_as_uint(m));
}
__global__ void __launch_bounds__(256) probe_encode(float* out, size_t n, const unsigned* slot, float scale) {
    const float d = sqrtf(scale * __uint_as_float(*slot));
    for (size_t i = (size_t)blockIdx.x * 256 + threadIdx.x; i < n; i += (size_t)gridDim.x * 256) out[i] += d;
}

#ifndef MK_MODE
#define MK_MODE 2
#endif
extern "C" void kernel_launch(void* const* d_in, const int* in_sizes, int n_in, void* d_out, int out_size, void* d_ws, size_t ws_size, hipStream_t stream) {
    static int grid = 0;
    if (grid == 0) {
        if (n_in != 13 || in_sizes[0] != MTOK * DM || out_size != MTOK * DM || ws_size < WS_END) { fprintf(stderr, "kernel_launch: unexpected shapes (n_in %d, in0 %d, out %d, ws %zu); nothing launched\n", n_in, n_in > 0 ? in_sizes[0] : -1, out_size, ws_size); grid = -1; return; }
        int dev = 0, cus = 0;
        if (hipGetDevice(&dev) != hipSuccess || hipDeviceGetAttribute(&cus, hipDeviceAttributeMultiprocessorCount, dev) != hipSuccess) { grid = -1; return; }
        if (hipFuncSetAttribute((const void*)mega_fwd, hipFuncAttributeMaxDynamicSharedMemorySize, LDS_BYTES) != hipSuccess) { fprintf(stderr, "kernel_launch: hipFuncSetAttribute failed\n"); grid = -1; return; }
        (void)hipGetLastError();
        grid = cus;
        if (grid != 256) fprintf(stderr, "kernel_launch: %d CUs (built for 256)\n", grid);
    }
    if (grid < 0) return;
    unsigned char* ws = (unsigned char*)d_ws;
    (void)hipMemsetAsync(ws + WS_CTL, 0, CTL_ZERO_BYTES, stream);
    Args a{};
    for (int i = 0; i < 13; ++i) a.in[i] = (const float*)d_in[i];
    a.out = (float*)d_out; a.ws = ws;
#define MEGA(lo, hi, li_) do { a.ph_lo = (lo); a.ph_hi = (hi); a.li = (li_); hipLaunchKernelGGL(mega_fwd, dim3(grid), dim3(NWAVES * 64), LDS_BYTES, stream, a); } while (0)
#if MK_MODE == 0 || MK_MODE == 1
    a.skip_mask = 0;
    MEGA(PH_PRO, PH_PRO + 1, 0);
    for (int g = 0; g < NGRP; ++g) { MEGA(PH_QKV0 + 2 * g, PH_QKV0 + 2 * g + 1, 0);
#if MK_MODE == 0
        hipLaunchKernelGGL(naive_attn, dim3(MTOK * AH / 4), dim3(256), 0, stream, (const bf16*)(ws + WS_Q), (const bf16*)(ws + WS_K), (const bf16*)(ws + WS_V), (bf16*)(ws + WS_OM), (float*)(ws + WS_LSE), g, grp_ldil(g));
#else
        MEGA(PH_ATT0 + 2 * g, PH_ATT0 + 2 * g + 1, 0);
#endif
    }
    MEGA(PH_WO0, PH_WO0 + 1, 0); MEGA(PH_UP0, PH_UP0 + 1, 0); MEGA(PH_DN0, PH_DN0 + 1, 0); MEGA(PH_GLAP, PH_GLAP + 1, 0);
    hipLaunchKernelGGL(naive_gla, dim3(BATCH * GH), dim3(1024), 0, stream, (const bf16*)(ws + WS_GQ), (const bf16*)(ws + WS_GK), (const bf16*)(ws + WS_GV), (const bf16*)(ws + WS_GG), (const float*)(ws + WS_GB),
                       (const float*)d_in[9], (bf16*)(ws + WS_XB));
    MEGA(PH_WO1, PH_WO1 + 1, 0); MEGA(PH_UP1, PH_UP1 + 1, 0); MEGA(PH_DN1, PH_DN1 + 1, 0); MEGA(PH_FIN, PH_FIN + 1, 0);
#elif MK_MODE == 3
    a.skip_mask = 0;
    unsigned* slot = (unsigned*)(ws + WS_CTL) + 2048; unsigned* slot2 = slot + 64;
    unsigned short* OM2 = (unsigned short*)d_out; float* LSE2 = (float*)((char*)d_out + 48 * MiB);
    MEGA(PH_PRO, PH_PRO + 1, 0);
    for (int g = 0; g < NGRP; ++g) { MEGA(PH_QKV0 + 2 * g, PH_QKV0 + 2 * g + 1, 0);
        hipLaunchKernelGGL(naive_attn, dim3(MTOK * AH / 4), dim3(256), 0, stream, (const bf16*)(ws + WS_Q), (const bf16*)(ws + WS_K), (const bf16*)(ws + WS_V), (bf16*)OM2, LSE2, g, grp_ldil(g));
        MEGA(PH_ATT0 + 2 * g, PH_ATT0 + 2 * g + 1, 0); }
    hipLaunchKernelGGL(probe_maxdiff_h, dim3(2048), dim3(256), 0, stream, (const unsigned short*)(ws + WS_OM), (const unsigned short*)OM2, (size_t)MTOK * DM, slot);
    hipLaunchKernelGGL(probe_maxdiff_f, dim3(256), dim3(256), 0, stream, (const float*)(ws + WS_LSE), (const float*)LSE2, (size_t)MTOK * 8, slot2);
    MEGA(PH_WO0, PH_WO0 + 1, 0); MEGA(PH_UP0, PH_UP0 + 1, 0); MEGA(PH_DN0, PH_DN0 + 1, 0); MEGA(PH_GLAP, PH_GLAP + 1, 0);
    hipLaunchKernelGGL(naive_gla, dim3(BATCH * GH), dim3(1024), 0, stream, (const bf16*)(ws + WS_GQ), (const bf16*)(ws + WS_GK), (const bf16*)(ws + WS_GV), (const bf16*)(ws + WS_GG), (const float*)(ws + WS_GB),
                       (const float*)d_in[9], (bf16*)(ws + WS_XB));
    MEGA(PH_WO1, PH_WO1 + 1, 0); MEGA(PH_UP1, PH_UP1 + 1, 0); MEGA(PH_DN1, PH_DN1 + 1, 0); MEGA(PH_FIN, PH_FIN + 1, 0);
    hipLaunchKernelGGL(probe_encode, dim3(2048), dim3(256), 0, stream, (float*)d_out, (size_t)MTOK * DM, slot, 1.0f);
    hipLaunchKernelGGL(probe_encode, dim3(2048), dim3(256), 0, stream, (float*)d_out, (size_t)MTOK * DM, slot2, 1e-3f);
#else
    a.skip_mask = 0;
    MEGA(0, PH_N, 0);
#endif
#undef MEGA
}
```

```cpp
#include <hip/hip_runtime.h>
#include <cstdio>
#include <cstdint>
#include <cmath>
#include <hip/hip_runtime.h>
#include <cstdio>
#include <cstdint>
namespace pg8 {
#define PG8_LAS __attribute__((address_space(3)))
typedef unsigned short bf16_t;
typedef short bf16x8 __attribute__((ext_vector_type(8)));
typedef _Float16 f16x8 __attribute__((ext_vector_type(8)));
typedef float f32x4 __attribute__((ext_vector_type(4)));
typedef unsigned u32x4 __attribute__((ext_vector_type(4)));
constexpr int BM = 256, BK = 64, HALF = 128, HTB = HALF * BK * 2  , STAGE_BYTES = 8 * HTB, NXCD = 8, WGM = 8;

__host__ __device__ __forceinline__ int lds_byte(int r, int c) { const int st = (r >> 4) * 2 + (c >> 5), rr = r & 15, cc = c & 31, ob = rr * 64 + cc * 2; return st * 1024 + (ob ^ (((ob >> 9) & 1) << 5)); }
__host__ __device__ __forceinline__ void stage_rc(int b, int& R, int& C) { const int st = b / 1024, sb = b % 1024, swz = sb ^ (((sb >> 9) & 1) << 5); R = (st >> 1) * 16 + swz / 64; C = (st & 1) * 32 + (swz % 64) / 2; }
__host__ __device__ __forceinline__ int perm32(int rho) { const int n = rho >> 4, i = rho & 15; return 8 * (i >> 2) + 4 * n + (i & 3); }

struct Unit { int pm, pn; };
struct Gemm { const bf16_t* A; const bf16_t* Bt; int M, N, K; };

struct StaticOrder {
    int nM, nN, nwg, G, c;
    __host__ __device__ void init(int M, int N, int G_, int c_) { nM = M / BM; nN = N / BM; nwg = nM * nN; G = G_; c = c_; }
    __host__ __device__ bool next(int i, Unit& u) const {
        const long L = (long)i * G + c; if (L >= nwg) return false;
        int wgid = (int)L; { const int q = nwg / NXCD, r = nwg % NXCD, xcd = wgid % NXCD, off = wgid / NXCD; wgid = (xcd < r ? xcd * (q + 1) : r * (q + 1) + (xcd - r) * q) + off; }
        const int nig = WGM * nN, gid = wgid / nig, fm = gid * WGM, gsz = (nM - fm) < WGM ? (nM - fm) : WGM;
        u.pm = fm + ((wgid % nig) % gsz); u.pn = (wgid % nig) / gsz; return true;
    }
    __device__ __forceinline__ void a_ready(const Unit&) const {}
    __device__ __forceinline__ void done(const Unit&) const {}
};

typedef __bf16 bf16x2_t __attribute__((ext_vector_type(2))); typedef float f32x2_t __attribute__((ext_vector_type(2)));
__device__ __forceinline__ unsigned cvt_pk_bf16(float lo, float hi) { const f32x2_t v = {lo, hi}; return __builtin_bit_cast(unsigned, __builtin_convertvector(v, bf16x2_t)); }
typedef unsigned u32x2 __attribute__((ext_vector_type(2)));
typedef _Float16 h16x2 __attribute__((ext_vector_type(2)));
typedef float f32x2 __attribute__((ext_vector_type(2)));
__device__ __forceinline__ unsigned cvt_pk_h(float lo, float hi) { const f32x2 v = {lo, hi}; return __builtin_bit_cast(unsigned, __builtin_convertvector(v, h16x2)); }
constexpr int P_SEQ = 8192, P_DM = 1024, P_DFF = 4096, P_AH = 8, P_HD = 128;
constexpr int RSTD_LDS_OFF = 131072 + 512;
struct PlainOrder : StaticOrder { __device__ __forceinline__ void a_ready(const Unit&, int) const {} };
struct RstdOrder : StaticOrder {
    const float* ssq; PG8_LAS float* rl;
    __device__ __forceinline__ void a_ready(const Unit& u, int ui) const {
        int t = threadIdx.x; asm volatile("" : "+v"(t));
        const int row = t >> 1, hf = t & 1;
        const f32x4* p = (const f32x4*)(ssq + (size_t)(u.pm * BM + row) * 16 + hf * 8); const f32x4 a = p[0], b = p[1];
        float s = ((a[0] + a[1]) + (a[2] + a[3])) + ((b[0] + b[1]) + (b[2] + b[3])); s += __shfl_xor(s, 1);
        if (hf == 0) rl[(ui & 1) * 256 + row] = 1.0f / sqrtf(s * (1.0f / 1024.0f) + 1e-5f);
    }
};
__device__ __forceinline__ void row_rstd(const PG8_LAS float* rl, int ui, int wr, int fr, float (&rs)[2][4]) {
#pragma unroll
    for (int ai = 0; ai < 2; ++ai)
#pragma unroll
        for (int m = 0; m < 4; ++m) rs[ai][m] = rl[(ui & 1) * 256 + ai * HALF + wr * 64 + m * 16 + fr];
}
__device__ __forceinline__ u32x4 pack8h(const f32x4 a, const f32x4 b) { u32x4 w; w.x = cvt_pk_h(a[0], a[1]); w.y = cvt_pk_h(a[2], a[3]); w.z = cvt_pk_h(b[0], b[1]); w.w = cvt_pk_h(b[2], b[3]); return w; }
__device__ __forceinline__ u32x4 pack8(const f32x4 a, const f32x4 b) { u32x4 w; w.x = cvt_pk_bf16(a[0], a[1]); w.y = cvt_pk_bf16(a[2], a[3]); w.z = cvt_pk_bf16(b[0], b[1]); w.w = cvt_pk_bf16(b[2], b[3]); return w; }

struct EpiQKV {
    static constexpr bool PERM = true, AFTER_DRAIN = false;
    bf16_t* Q; bf16_t* K; bf16_t* V; const PG8_LAS float* rl; const float* cosT; const float* sinT; int ldil;
    __device__ __forceinline__ void operator()(const f32x4 (&acc)[2][2][4][2], const Unit& u, int wr, int wc, int fr, int fq, int ui) const {
        const int row0 = u.pm * BM + wr * 64 + fr;
        float rs[2][4]; row_rstd(rl, ui, wr, fr, rs);
        const int which = u.pn >> 2, hp = u.pn & 3, dmask = (1 << ldil) - 1, L = P_SEQ >> ldil;
        if (which < 2) {
            bf16_t* dst = which == 0 ? Q : K;
            const int head = 2 * hp + (wc >> 1), d0 = 32 * (wc & 1) + 8 * fq;
#pragma unroll
            for (int ai = 0; ai < 2; ++ai)
#pragma unroll
                for (int m = 0; m < 4; ++m) { const int row = row0 + ai * HALF + m * 16, b = row >> 13, t = row & (P_SEQ - 1), r = t & dmask, i = t >> ldil;
                    bf16_t* p = dst + ((size_t)((((b * P_AH + head) << ldil) + r)) * L + i) * P_HD + d0;
                    const float* ct = cosT + t * 64 + d0; const float* st = sinT + t * 64 + d0;
                    const f32x4 c0 = *(const f32x4*)ct, c1 = *(const f32x4*)(ct + 4), s0 = *(const f32x4*)st, s1 = *(const f32x4*)(st + 4);
                    const float sc = rs[ai][m];
                    const f32x4 x1a = acc[ai][0][m][0] * sc, x1b = acc[ai][0][m][1] * sc, x2a = acc[ai][1][m][0] * sc, x2b = acc[ai][1][m][1] * sc;
                    const f32x4 o1a = x1a * c0 - x2a * s0, o1b = x1b * c1 - x2b * s1, o2a = x2a * c0 + x1a * s0, o2b = x2b * c1 + x1b * s1;
                    *(u32x4*)p = pack8h(o1a, o1b); *(u32x4*)(p + 64) = pack8h(o2a, o2b);
                    if (m & 1) asm volatile("" ::: "memory"); }
        } else {
            const int dd = 32 * wc + 8 * fq;
#pragma unroll
            for (int ai = 0; ai < 2; ++ai)
#pragma unroll
                for (int m = 0; m < 4; ++m) { const int row = row0 + ai * HALF + m * 16, b = row >> 13, t = row & (P_SEQ - 1), r = t & dmask, i = t >> ldil;
                    const float sc = rs[ai][m];
#pragma unroll
                    for (int bj = 0; bj < 2; ++bj) { const int head = 2 * hp + bj;
                        bf16_t* p = V + ((size_t)((((b * P_AH + head) << ldil) + r)) * L + i) * P_HD + dd;
                        *(u32x4*)p = pack8h(acc[ai][bj][m][0] * sc, acc[ai][bj][m][1] * sc); } }
        }
    }
};
struct EpiResid {
    static constexpr bool PERM = false, AFTER_DRAIN = false;
    const float* resid; float* out; bf16_t* xb; float* ssq;
    __device__ __forceinline__ void operator()(const f32x4 (&acc)[2][2][4][2], const Unit& u, int wr, int wc, int fr, int fq, int ui) const {
        const int row0 = u.pm * BM + wr * 64 + fr, col0 = u.pn * BM + wc * 32 + 4 * fq;
#pragma unroll
        for (int ai = 0; ai < 2; ++ai)
#pragma unroll
            for (int m = 0; m < 4; ++m) { const int row = row0 + ai * HALF + m * 16; const size_t off = (size_t)row * P_DM + col0; float s = 0.f;
#pragma unroll
                for (int bj = 0; bj < 2; ++bj)
#pragma unroll
                    for (int n = 0; n < 2; ++n) { const f32x4 v = acc[ai][bj][m][n] + *(const f32x4*)(resid + off + bj * HALF + n * 16);
                        *(f32x4*)(out + off + bj * HALF + n * 16) = v; s += (v[0] * v[0] + v[1] * v[1]) + (v[2] * v[2] + v[3] * v[3]);
                        u32x2 w; w.x = cvt_pk_h(v[0], v[1]); w.y = cvt_pk_h(v[2], v[3]); *(u32x2*)(xb + off + bj * HALF + n * 16) = w; }
                s += __shfl_xor(s, 16); s += __shfl_xor(s, 32);
                if (fq == 0) ssq[(size_t)row * 16 + u.pn * 4 + wc] = s;
                asm volatile("" ::: "memory"); }
    }
};
struct EpiUp {
    static constexpr bool PERM = true, AFTER_DRAIN = false;
    bf16_t* H; const PG8_LAS float* rl;
    __device__ __forceinline__ void operator()(const f32x4 (&acc)[2][2][4][2], const Unit& u, int wr, int wc, int fr, int fq, int ui) const {
        const int row0 = u.pm * BM + wr * 64 + fr, col0 = u.pn * BM + wc * 32 + 8 * fq;
        float rs[2][4]; row_rstd(rl, ui, wr, fr, rs);
#pragma unroll
        for (int ai = 0; ai < 2; ++ai)
#pragma unroll
            for (int m = 0; m < 4; ++m) { bf16_t* rowp = H + (size_t)(row0 + ai * HALF + m * 16) * P_DFF + col0; const float sc = rs[ai][m];
#pragma unroll
                for (int bj = 0; bj < 2; ++bj) { f32x4 v0 = acc[ai][bj][m][0] * sc, v1 = acc[ai][bj][m][1] * sc;
                    v0 = __builtin_elementwise_max(v0, (f32x4){0.f, 0.f, 0.f, 0.f}); v1 = __builtin_elementwise_max(v1, (f32x4){0.f, 0.f, 0.f, 0.f});
                    const f32x4 cap = {65504.f, 65504.f, 65504.f, 65504.f};
                    *(u32x4*)(rowp + bj * HALF) = pack8h(__builtin_elementwise_min(v0 * v0, cap), __builtin_elementwise_min(v1 * v1, cap)); } }
    }
};
struct EpiGla {
    static constexpr bool PERM = true, AFTER_DRAIN = false;
    bf16_t* q; bf16_t* k; bf16_t* v; bf16_t* g; const PG8_LAS float* rl;
    __device__ __forceinline__ void operator()(const f32x4 (&acc)[2][2][4][2], const Unit& u, int wr, int wc, int fr, int fq, int ui) const {
        const int row0 = u.pm * BM + wr * 64 + fr;
        float rs[2][4]; row_rstd(rl, ui, wr, fr, rs);
        bf16_t* dst; int ld, coff;
        if (u.pn < 2) { dst = q; ld = 512; coff = u.pn * 256; } else if (u.pn < 4) { dst = k; ld = 512; coff = (u.pn - 2) * 256; }
        else if (u.pn < 8) { dst = v; ld = 1024; coff = (u.pn - 4) * 256; } else { dst = g; ld = 1024; coff = (u.pn - 8) * 256; }
        const int col0 = coff + wc * 32 + 8 * fq;
#pragma unroll
        for (int ai = 0; ai < 2; ++ai)
#pragma unroll
            for (int m = 0; m < 4; ++m) { bf16_t* rowp = dst + (size_t)(row0 + ai * HALF + m * 16) * ld + col0; const float sc = rs[ai][m];
#pragma unroll
                for (int bj = 0; bj < 2; ++bj) *(u32x4*)(rowp + bj * HALF) = pack8(acc[ai][bj][m][0] * sc, acc[ai][bj][m][1] * sc); }
    }
};
template <class Epi, class Sched, bool ALIGN_EPI = false, bool SP2 = false>
__device__ __forceinline__ void gemm_phase(PG8_LAS unsigned char* lds, const Gemm g, const Sched& S, const Epi& E) {
    int tid_ = threadIdx.x; asm volatile("" : "+v"(tid_));
    const int tid = tid_, wid = __builtin_amdgcn_readfirstlane(tid >> 6), lane = tid & 63, wr = wid >> 2, wc = wid & 3, fr = lane & 15, fq = lane >> 4;
    const int K = g.K, nt = K / BK;
    unsigned voffA[2], voffB[2];
#pragma unroll
    for (int i = 0; i < 2; ++i) { int R, C; stage_rc(tid * 16 + i * 8192, R, C); const int Rb = Epi::PERM ? ((R & ~31) + perm32(R & 31)) : R;
        voffA[i] = (unsigned)(R * K + C) * 2u; voffB[i] = (unsigned)(Rb * K + C) * 2u; }
    const size_t kstep = (size_t)(BK * 2);
    const size_t hstep = (size_t)HALF * K * 2;
    const size_t tstep = 2 * hstep;
    const unsigned ldsw = (unsigned)wid * 1024u;
    const int aoff = lds_byte(wr * 64 + fr, fq * 8), boff = lds_byte(wc * 32 + fr, fq * 8);
#define PG8_SA(b, h) (((b) * 2 + (h)) * HTB)
#define PG8_SB(b, h) ((4 + (b) * 2 + (h)) * HTB)
#define PG8_STAGE(bufoff, gbase, voff) do { _Pragma("unroll") for (int _i = 0; _i < 2; ++_i) \
        __builtin_amdgcn_global_load_lds((const unsigned*)((const char*)(gbase) + (voff)[_i]), (PG8_LAS unsigned*)(lds + (bufoff) + ldsw + _i * 8192), 16, 0, 0); } while (0)
#define PG8_LDA(dst, b, h) do { _Pragma("unroll") for (int m = 0; m < 4; ++m) _Pragma("unroll") for (int k = 0; k < 2; ++k) dst[m][k] = *(const PG8_LAS bf16x8*)(lds + PG8_SA(b, h) + aoff + m * 2048 + k * 1024); } while (0)
#define PG8_LDB(dst, b, h) do { _Pragma("unroll") for (int n = 0; n < 2; ++n) _Pragma("unroll") for (int k = 0; k < 2; ++k) dst[n][k] = *(const PG8_LAS bf16x8*)(lds + PG8_SB(b, h) + boff + n * 2048 + k * 1024); } while (0)
#define PG8_MMA(ai, bj, At, Bt) do { __builtin_amdgcn_s_setprio(1); _Pragma("unroll") for (int m = 0; m < 4; ++m) _Pragma("unroll") for (int n = 0; n < 2; ++n) _Pragma("unroll") for (int k = 0; k < 2; ++k) \
        acc[ai][bj][m][n] = __builtin_amdgcn_mfma_f32_16x16x32_f16(__builtin_bit_cast(f16x8, Bt[n][k]), __builtin_bit_cast(f16x8, At[m][k]), acc[ai][bj][m][n], 0, 0, 0); __builtin_amdgcn_s_setprio(0); } while (0)
#define PG8_WAIT_V(n) asm volatile("s_waitcnt vmcnt(" #n ")" ::: "memory")
#define PG8_WAIT_L(n) asm volatile("s_waitcnt lgkmcnt(" #n ")" ::: "memory")
#define PG8_BAR __builtin_amdgcn_s_barrier()
#define PG8_SCHED __builtin_amdgcn_sched_barrier(0)
    Unit cur, nxt; int ui = 0;
    if (!S.next(0, cur)) return;
    f32x4 acc[2][2][4][2];
#pragma unroll
    for (int a = 0; a < 2; ++a)
#pragma unroll
        for (int b = 0; b < 2; ++b)
#pragma unroll
            for (int m = 0; m < 4; ++m)
#pragma unroll
                for (int n = 0; n < 2; ++n) acc[a][b][m][n] = (f32x4){0.f, 0.f, 0.f, 0.f};
    bf16x8 At[4][2], B0[2][2], B1[2][2];
    const char* cA = (const char*)g.A + (size_t)cur.pm * tstep; const char* cB = (const char*)g.Bt + (size_t)cur.pn * tstep;
    S.a_ready(cur, 0);
    if constexpr (SP2) {
        PG8_STAGE(PG8_SB(0, 0), cB, voffB); PG8_STAGE(PG8_SB(0, 1), cB + hstep, voffB); PG8_STAGE(PG8_SA(0, 0), cA, voffA); PG8_STAGE(PG8_SA(0, 1), cA + hstep, voffA);
        if (wr == 1) PG8_BAR;
        PG8_WAIT_V(2); PG8_BAR;
        PG8_STAGE(PG8_SB(1, 0), cB + kstep, voffB); PG8_STAGE(PG8_SA(1, 0), cA + kstep, voffA); PG8_STAGE(PG8_SB(1, 1), cB + hstep + kstep, voffB);
        PG8_WAIT_V(6); PG8_BAR;
    } else {
        PG8_STAGE(PG8_SB(0, 0), cB, voffB); PG8_STAGE(PG8_SA(0, 0), cA, voffA); PG8_STAGE(PG8_SB(0, 1), cB + hstep, voffB); PG8_STAGE(PG8_SA(0, 1), cA + hstep, voffA);
        if (wr == 1) PG8_BAR;
        PG8_WAIT_V(4); PG8_BAR;
        PG8_STAGE(PG8_SB(1, 0), cB + kstep, voffB); PG8_STAGE(PG8_SA(1, 0), cA + kstep, voffA); PG8_STAGE(PG8_SB(1, 1), cB + hstep + kstep, voffB);
        PG8_WAIT_V(6); PG8_BAR;
    }
    for (;;) {
        const bool has_next = S.next(ui + 1, nxt);
        const char* nA = has_next ? (const char*)g.A + (size_t)nxt.pm * tstep : cA; const char* nB = has_next ? (const char*)g.Bt + (size_t)nxt.pn * tstep : cB;
        for (int t = 0; t < nt; t += 2) {
            const bool last = (t == nt - 2);
            const char* a1 = cA + (size_t)(t + 1) * kstep;
            const char* a2 = last ? nA : cA + (size_t)(t + 2) * kstep; const char* b2 = last ? nB : cB + (size_t)(t + 2) * kstep;
            const char* a3 = a2 + kstep; const char* b3 = b2 + kstep;
            if (last && has_next) S.a_ready(nxt, ui + 1);
            if constexpr (SP2) {
            PG8_LDB(B0, 0, 0); PG8_LDB(B1, 0, 1); PG8_SCHED; PG8_LDA(At, 0, 0); PG8_STAGE(PG8_SA(1, 1), a1 + hstep, voffA);
            PG8_WAIT_V(8); PG8_WAIT_L(0); PG8_BAR; PG8_MMA(0, 0, At, B0); PG8_MMA(0, 1, At, B1); PG8_BAR; PG8_SCHED;
            PG8_LDA(At, 0, 1); PG8_STAGE(PG8_SB(0, 0), b2, voffB); PG8_STAGE(PG8_SB(0, 1), b2 + hstep, voffB); PG8_STAGE(PG8_SA(0, 0), a2, voffA);
            PG8_WAIT_V(8); PG8_WAIT_L(0); PG8_BAR; PG8_MMA(1, 0, At, B0); PG8_MMA(1, 1, At, B1); PG8_BAR; PG8_SCHED;
            PG8_LDB(B0, 1, 0); PG8_LDB(B1, 1, 1); PG8_SCHED; PG8_LDA(At, 1, 0); PG8_STAGE(PG8_SA(0, 1), a2 + hstep, voffA);
            PG8_WAIT_V(8); PG8_WAIT_L(0); PG8_BAR; PG8_MMA(0, 0, At, B0); PG8_MMA(0, 1, At, B1); PG8_BAR; PG8_SCHED;
            PG8_LDA(At, 1, 1); PG8_STAGE(PG8_SB(1, 0), b3, voffB); PG8_STAGE(PG8_SB(1, 1), b3 + hstep, voffB); PG8_STAGE(PG8_SA(1, 0), a3, voffA);
            PG8_WAIT_V(8); PG8_WAIT_L(0); PG8_BAR; PG8_MMA(1, 0, At, B0); PG8_MMA(1, 1, At, B1); PG8_BAR; PG8_SCHED;
            } else {
            PG8_LDB(B0, 0, 0); PG8_SCHED; PG8_LDA(At, 0, 0); PG8_STAGE(PG8_SA(1, 1), a1 + hstep, voffA);
            PG8_WAIT_L(8); PG8_BAR; PG8_WAIT_L(0); PG8_MMA(0, 0, At, B0); PG8_BAR; PG8_SCHED;
            PG8_LDB(B1, 0, 1); PG8_STAGE(PG8_SB(0, 0), b2, voffB);
            PG8_BAR; PG8_WAIT_L(0); PG8_MMA(0, 1, At, B1); PG8_BAR;
            PG8_LDA(At, 0, 1); PG8_STAGE(PG8_SA(0, 0), a2, voffA);
            PG8_BAR; PG8_WAIT_L(0); PG8_MMA(1, 0, At, B0); PG8_BAR; PG8_SCHED;
            PG8_STAGE(PG8_SB(0, 1), b2 + hstep, voffB);
            PG8_WAIT_V(6); PG8_BAR; PG8_MMA(1, 1, At, B1); PG8_BAR;
            PG8_LDB(B0, 1, 0); PG8_SCHED; PG8_LDA(At, 1, 0); PG8_STAGE(PG8_SA(0, 1), a2 + hstep, voffA);
            PG8_WAIT_L(8); PG8_BAR; PG8_WAIT_L(0); PG8_MMA(0, 0, At, B0); PG8_BAR; PG8_SCHED;
            PG8_LDB(B1, 1, 1); PG8_STAGE(PG8_SB(1, 0), b3, voffB);
            PG8_BAR; PG8_WAIT_L(0); PG8_MMA(0, 1, At, B1); PG8_BAR;
            PG8_LDA(At, 1, 1); PG8_STAGE(PG8_SA(1, 0), a3, voffA);
            PG8_BAR; PG8_WAIT_L(0); PG8_MMA(1, 0, At, B0); PG8_BAR; PG8_SCHED;
            PG8_STAGE(PG8_SB(1, 1), b3 + hstep, voffB);
            PG8_WAIT_V(6); PG8_BAR; PG8_MMA(1, 1, At, B1); PG8_BAR;
            }
        }
        if constexpr (ALIGN_EPI) { if (wr == 0) PG8_BAR; }
        if constexpr (!Epi::AFTER_DRAIN) { E(acc, cur, wr, wc, fr, fq, ui); S.done(cur); }
        if (!has_next) break;
#pragma unroll
        for (int a = 0; a < 2; ++a)
#pragma unroll
            for (int b = 0; b < 2; ++b)
#pragma unroll
                for (int m = 0; m < 4; ++m)
#pragma unroll
                    for (int n = 0; n < 2; ++n) acc[a][b][m][n] = (f32x4){0.f, 0.f, 0.f, 0.f};
        cur = nxt; cA = nA; cB = nB; ++ui;
        if constexpr (ALIGN_EPI) { if (wr == 1) PG8_BAR; }
    }
    PG8_WAIT_V(0);
    if constexpr (!ALIGN_EPI) { if (wr == 0) PG8_BAR; }
    PG8_BAR;
    if constexpr (Epi::AFTER_DRAIN) { E.fused(acc, cur, wr, wc, fr, fq, lds, wid, lane); S.done(cur); }
#undef PG8_SA
#undef PG8_SB
#undef PG8_STAGE
#undef PG8_LDA
#undef PG8_LDB
#undef PG8_MMA
#undef PG8_WAIT_V
#undef PG8_WAIT_L
#undef PG8_BAR
#undef PG8_SCHED
}
}
#define GAS __attribute__((address_space(1)))
#define LAS __attribute__((address_space(3)))
typedef unsigned short bf16;
typedef unsigned v4u __attribute__((ext_vector_type(4)));
typedef float f32x4 __attribute__((ext_vector_type(4)));
typedef short bf16x8 __attribute__((ext_vector_type(8)));
typedef GAS unsigned gu32;
typedef GAS unsigned long long gu64;
#define RLX_AGENT __ATOMIC_RELAXED, __HIP_MEMORY_SCOPE_AGENT
#define LDS_WAIT() asm volatile("s_waitcnt lgkmcnt(0)" ::: "memory")
#define VM_WAIT() asm volatile("s_waitcnt vmcnt(0)" ::: "memory")
__device__ __forceinline__ unsigned long long rt() { return __builtin_amdgcn_s_memrealtime(); }
__device__ __forceinline__ unsigned f2bf(float f) { unsigned u = __builtin_bit_cast(unsigned, f); return (u + 0x7fffu + ((u >> 16) & 1u)) >> 16; }
__device__ __forceinline__ unsigned pk2(float lo, float hi) { return f2bf(lo) | (f2bf(hi) << 16); }

#define XB_TMO      128
#define XB_XCNT(j)  (256  + 64 * (j))
#define XB_XSUB(j)  (1280 + 64 * (j))
#define XB_XGEN(j)  (2304 + 64 * (j))
#define XB_TOP      3328
#define XB_TOPGEN   3392
#define XCD_BAR_WORDS 3456
#define XB_SPIN_CAP (1u << 18)

__device__ __forceinline__ unsigned xb_ld(unsigned* p)              { return __hip_atomic_load(p, __ATOMIC_RELAXED, __HIP_MEMORY_SCOPE_AGENT); }
__device__ __forceinline__ unsigned xb_add(unsigned* p, unsigned v) { return __hip_atomic_fetch_add(p, v, __ATOMIC_RELAXED, __HIP_MEMORY_SCOPE_AGENT); }
__device__ __forceinline__ unsigned xb_xcc_id() { return (unsigned)__builtin_amdgcn_s_getreg((3 << 11) | 20) & 0xFu; }
#define XB_SPIN(cond, bar) do { unsigned _sp = 0; while (cond) { __builtin_amdgcn_s_sleep(1); \
    if ((++_sp & 255u) == 0u) { if (xb_ld(&(bar)[XB_TMO])) break; if (_sp > XB_SPIN_CAP) { atomicAdd(&(bar)[XB_TMO], 1u); break; } } } } while (0)

struct XcdBarrier {
    unsigned* bar; unsigned x;
    volatile LAS unsigned* st;
};

__device__ __forceinline__ XcdBarrier xcd_barrier_post(unsigned* bar, volatile LAS unsigned* st) {
    XcdBarrier b; b.bar = bar; b.x = xb_xcc_id(); b.st = st;
    if (threadIdx.x == 0) (void)xb_add(&bar[XB_XCNT(b.x)], 1u);
    return b;
}
__device__ __forceinline__ void xcd_barrier_complete(unsigned* bar, unsigned x, unsigned& nloc, unsigned& nx) {
    const unsigned G = gridDim.x * gridDim.y * gridDim.z;
    unsigned sum, cnt, mine, sp = 0u;
    for (;;) {
        sum = 0u; cnt = 0u; mine = 0u;
#pragma unroll
        for (unsigned j = 0; j < 16; ++j) { const unsigned c = xb_ld(&bar[XB_XCNT(j)]); sum += c; cnt += (c > 0u) ? 1u : 0u; mine = (j == x) ? c : mine; }
        if (sum == G) break;
        __builtin_amdgcn_s_sleep(1);
        if ((++sp & 255u) == 0u) { if (xb_ld(&bar[XB_TMO])) break; if (sp > XB_SPIN_CAP) { atomicAdd(&bar[XB_TMO], 1u); break; } }
    }
    nloc = mine > 0u ? mine : 1u; nx = cnt > 0u ? cnt : 1u;
}

__device__ __forceinline__ void xcd_barrier(const XcdBarrier& b) {
    asm volatile("s_waitcnt vmcnt(0)" ::: "memory");
    __syncthreads();
    if (threadIdx.x == 0) {
        unsigned* bar = b.bar;
        __builtin_amdgcn_s_waitcnt(0);
        unsigned nloc = b.st[0], nx = b.st[1];
        if (nloc == 0u) { xcd_barrier_complete(bar, b.x, nloc, nx); b.st[0] = nloc; b.st[1] = nx; }
        const unsigned old = xb_add(&bar[XB_XSUB(b.x)], 1u);
        const unsigned gen = old / nloc;
        if (old + 1u == (gen + 1u) * nloc) {
            __builtin_amdgcn_fence(__ATOMIC_RELEASE, "agent");
            asm volatile("s_waitcnt vmcnt(0)" ::: "memory");
            const unsigned og = xb_add(&bar[XB_TOP], 1u);
            const unsigned tg = og / nx;
            if (og + 1u == (tg + 1u) * nx) xb_add(&bar[XB_TOPGEN], 1u);
            else XB_SPIN(xb_ld(&bar[XB_TOPGEN]) == tg, bar);
            __builtin_amdgcn_fence(__ATOMIC_ACQUIRE, "agent");
            xb_add(&bar[XB_XGEN(b.x)], 1u);
            asm volatile("s_waitcnt vmcnt(0)" ::: "memory");
        } else {
            XB_SPIN(xb_ld(&bar[XB_XGEN(b.x)]) == gen, bar);
            __builtin_amdgcn_fence(__ATOMIC_ACQUIRE, "agent");
            asm volatile("s_waitcnt vmcnt(0)" ::: "memory");
        }
    }
    __syncthreads();
}

namespace swa {
typedef unsigned short u16;
typedef short bf16x8 __attribute__((ext_vector_type(8)));
typedef _Float16 f16x8 __attribute__((ext_vector_type(8)));
typedef short s16x4 __attribute__((ext_vector_type(4)));
typedef float f32x16 __attribute__((ext_vector_type(16)));
typedef float f32x4 __attribute__((ext_vector_type(4)));
typedef unsigned u32x4 __attribute__((ext_vector_type(4)));
constexpr int D = 128, W = 129;
constexpr float THR = 8.f;
constexpr float SCALE = 0.08838834764831845f;
constexpr int NW = 8, QBLK = 32, KVBLK = 64, QB = NW * QBLK;
constexpr int SHM_V = KVBLK * D * 2, SHM_K = KVBLK * D * 2;
constexpr int LDS_BYTES = 2 * SHM_V + 2 * SHM_K + NW * 64 * 4;
#define KSWZ(row, colB) ((row) * 256 + ((colB) ^ (((row) & 7) << 4)))
#define SBAR() __builtin_amdgcn_sched_barrier(0)
__device__ __forceinline__ int v_st(int k, int c) { const int kk = (k & ~0xC) | ((k & 4) << 1) | ((k & 8) >> 1); return ((kk >> 3) * 4 + (c >> 5)) * 512 + ((kk & 7) * 32 + (c & 31)) * 2; }
__device__ __forceinline__ int v_rd_base(int lane) { return ((lane & 3) << 3) | (((lane >> 2) & 3) << 6) | (((lane >> 4) & 1) << 5) | (((lane >> 5) & 1) << 8); }
constexpr int v_rd_off(int d0, int ks, int half) { return d0 * 512 + ks * 4096 + half * 2048; }
__device__ __forceinline__ int crow(int r, int hi) { return (r & 3) + 8 * (r >> 2) + 4 * hi; }
__device__ __forceinline__ unsigned cvtpk(float lo, float hi) { return pg8::cvt_pk_h(lo, hi); }
__device__ __forceinline__ float hlo(unsigned w) { return (float)__builtin_bit_cast(pg8::h16x2, w)[0]; }
__device__ __forceinline__ float hhi(unsigned w) { return (float)__builtin_bit_cast(pg8::h16x2, w)[1]; }
__device__ __forceinline__ bf16x8 load8(const u16* p) { return *reinterpret_cast<const bf16x8*>(p); }
#define SWA_MFMA(a, b, c) __builtin_amdgcn_mfma_f32_32x32x16_f16(__builtin_bit_cast(f16x8, a), __builtin_bit_cast(f16x8, b), c, 0, 0, 0)
__device__ __forceinline__ void mask_tile(f32x16& p0, f32x16& p1, int dq, unsigned Wd) {
    const float NEG = -__builtin_inff();
#pragma unroll
    for (int r = 0; r < 16; ++r) {
        const int c = (r & 3) + 8 * (r >> 2);
        if ((unsigned)(dq - c) >= Wd) p0[r] = NEG;
        if ((unsigned)(dq - c - 32) >= Wd) p1[r] = NEG;
    }
}
__device__ __forceinline__ void partialSM(f32x16& p0, f32x16& p1, float& m_reg, float& mn, float& alpha) {
    float pmax = p0[0]; for (int r = 1; r < 16; ++r) pmax = fmaxf(pmax, p0[r]); for (int r = 0; r < 16; ++r) pmax = fmaxf(pmax, p1[r]);
    { auto rr = __builtin_amdgcn_permlane32_swap(__float_as_uint(pmax), __float_as_uint(pmax), false, false);
      pmax = fmaxf(__uint_as_float(rr[0]), __uint_as_float(rr[1])); }
    constexpr float C2 = 1.4426950408889634f * SCALE;
    if (__builtin_expect(__all((pmax - m_reg) * SCALE <= THR), 1)) { mn = m_reg; alpha = 1.f; }
    else { mn = fmaxf(m_reg, pmax); alpha = __builtin_amdgcn_exp2f((m_reg - mn) * C2); m_reg = mn; }
    const float mnL = -mn * C2;
    for (int r = 0; r < 16; ++r) p0[r] = fmaf(p0[r], C2, mnL); for (int r = 0; r < 16; ++r) p1[r] = fmaf(p1[r], C2, mnL);
    for (int r = 0; r < 16; ++r) p0[r] = __builtin_amdgcn_exp2f(p0[r]);
}
__device__ __forceinline__ void finishSM(f32x16& p0, f32x16& p1, float alpha, float& l_reg, bf16x8& pa0, bf16x8& pa1, bf16x8& pa2, bf16x8& pa3) {
    for (int r = 0; r < 16; ++r) p1[r] = __builtin_amdgcn_exp2f(p1[r]);
    float ps = 0; for (int r = 0; r < 16; ++r) ps += p0[r]; for (int r = 0; r < 16; ++r) ps += p1[r];
    { auto rr = __builtin_amdgcn_permlane32_swap(__float_as_uint(ps), __float_as_uint(ps), false, false);
      ps = __uint_as_float(rr[0]) + __uint_as_float(rr[1]); }
    l_reg = l_reg * alpha + ps;
#define PK4(P, B_, OUT) do { unsigned a0 = cvtpk(P[B_+0], P[B_+1]), a1 = cvtpk(P[B_+2], P[B_+3]);                          \
        unsigned b0 = cvtpk(P[B_+4], P[B_+5]), b1 = cvtpk(P[B_+6], P[B_+7]);                                             \
        auto r0 = __builtin_amdgcn_permlane32_swap(a0, b0, false, false); auto r1 = __builtin_amdgcn_permlane32_swap(a1, b1, false, false); \
        u32x4 w = {r0[0], r1[0], r0[1], r1[1]}; OUT = *reinterpret_cast<bf16x8*>(&w); } while (0)
    PK4(p0, 0, pa0); PK4(p0, 8, pa1); PK4(p1, 0, pa2); PK4(p1, 8, pa3);
#undef PK4
}
template <int KB>
__device__ __forceinline__ void qkt(f32x16& p0, f32x16& p1, const char* K_lds, int r32, int hi, const bf16x8* qr, bool act) {
    if (!act) { const float NEG = -__builtin_inff();
#pragma unroll
        for (int r = 0; r < 16; ++r) { p0[r] = NEG; p1[r] = NEG; } return; }
    p0 = f32x16{}; p1 = f32x16{};
    const char* kb[4];
#pragma unroll
    for (int dd = 0; dd < 4; ++dd) kb[dd] = K_lds + KB * SHM_K + KSWZ(r32, (dd * 16 + hi * 8) * 2);
#pragma unroll
    for (int d0 = 0; d0 < 8; ++d0) { const char* a = kb[d0 & 3] + (d0 >> 2) * 128;
        bf16x8 b0 = *reinterpret_cast<const bf16x8*>(a);
        bf16x8 b1 = *reinterpret_cast<const bf16x8*>(a + 32 * 256);
        p0 = SWA_MFMA(b0, qr[d0], p0);
        p1 = SWA_MFMA(b1, qr[d0], p1); }
}
template <int VB>
__device__ __forceinline__ void pv_tile(f32x16* o, int vb0, bf16x8 pa0, bf16x8 pa1, bf16x8 pa2, bf16x8 pa3, bool act) {
    if (!act) return;
#define TRRD(dst, off) asm volatile("ds_read_b64_tr_b16 %0, %1 offset:%2" : "=&v"(dst) : "v"(vb0), "i"(off) : "memory")
#define PV_D0(d0) do { s16x4 l0, l1, l2, l3, h0, h1, h2, h3; constexpr int b_ = VB * SHM_V + v_rd_off(d0, 0, 0); \
        TRRD(l0, b_); TRRD(h0, b_ + 2048); TRRD(l1, b_ + 4096); TRRD(h1, b_ + 6144); TRRD(l2, b_ + 8192); TRRD(h2, b_ + 10240); TRRD(l3, b_ + 12288); TRRD(h3, b_ + 14336); \
        asm volatile("s_waitcnt lgkmcnt(0)" ::: "memory"); SBAR();   \
        o[d0] = SWA_MFMA(pa0, ((bf16x8){l0[0], l0[1], l0[2], l0[3], h0[0], h0[1], h0[2], h0[3]}), o[d0]);   \
        o[d0] = SWA_MFMA(pa1, ((bf16x8){l1[0], l1[1], l1[2], l1[3], h1[0], h1[1], h1[2], h1[3]}), o[d0]);   \
        o[d0] = SWA_MFMA(pa2, ((bf16x8){l2[0], l2[1], l2[2], l2[3], h2[0], h2[1], h2[2], h2[3]}), o[d0]);   \
        o[d0] = SWA_MFMA(pa3, ((bf16x8){l3[0], l3[1], l3[2], l3[3], h3[0], h3[1], h3[2], h3[3]}), o[d0]); } while (0)
    PV_D0(0); PV_D0(1); PV_D0(2); PV_D0(3);
#undef PV_D0
#undef TRRD
}
struct BlockRef { const u16* Q; const u16* K; const u16* V; int P0, skv, trow0, tstep, h; };
struct Seam { bf16x8 qr[8]; bf16x8 st_v0, st_v1, st_k0, st_k1; };
__device__ __forceinline__ int swa_jlo(int P0) { const int lowk = P0 - W + 1; return lowk > 0 ? lowk / KVBLK : 0; }
#define ROW(p, k0, rr) ((p) + (size_t)((k0) + (rr)) * D + sc)
#define VMW() asm volatile("s_waitcnt vmcnt(0)" ::: "memory")
#define VMWN(n) asm volatile("s_waitcnt vmcnt(%0)" :: "i"(n) : "memory")
#define SLOAD_H(Kp, Vp, k0) do { S.st_v0 = load8(ROW(Vp, k0, sr)); S.st_v1 = load8(ROW(Vp, k0, 32 + sr));              \
                         S.st_k0 = load8(ROW(Kp, k0, sr)); S.st_k1 = load8(ROW(Kp, k0, 32 + sr)); } while (0)
#define SWRITE_HK(bf) do { *(bf16x8*)(K_lds + (bf) * SHM_K + kws) = S.st_k0; *(bf16x8*)(K_lds + (bf) * SHM_K + kws + 32 * 256) = S.st_k1; } while (0)
#define SWRITE_HV(bf) do { *(bf16x8*)(V_lds + (bf) * SHM_V + vst0) = S.st_v0; *(bf16x8*)(V_lds + (bf) * SHM_V + vst1) = S.st_v1; } while (0)
#define SWRITE_H(bf) do { SWRITE_HV(bf); SWRITE_HK(bf); } while (0)
__device__ __forceinline__ void swa_prime(const BlockRef& cur, char* lds, Seam& S) {
    int tid = threadIdx.x; asm volatile("" : "+v"(tid));
    const int wid = __builtin_amdgcn_readfirstlane(tid >> 6), lane = tid & 63, r32 = lane & 31, hi = lane >> 5;
    const int sr = tid >> 4, sc = (tid & 15) * 8, kws = KSWZ(sr, sc * 2); char* K_lds = lds + 2 * SHM_V;
    const int kb0 = swa_jlo(cur.P0) * KVBLK;
    for (int d0 = 0; d0 < 8; ++d0) S.qr[d0] = load8(cur.Q + (size_t)(cur.P0 + wid * QBLK + r32) * D + d0 * 16 + hi * 8);
    SLOAD_H(cur.K, cur.V, kb0); VMW(); SWRITE_HK(0);
    __syncthreads();
}
__device__ __forceinline__ void swa_block(const BlockRef& cur, const BlockRef& nxt, char* lds, Seam& S, u16* OM, float* LSE, int first_group) {
    int tid = threadIdx.x; asm volatile("" : "+v"(tid));
    const int wid = __builtin_amdgcn_readfirstlane(tid >> 6), lane = tid & 63, r32 = lane & 31, hi = lane >> 5;
    const int j_lo = swa_jlo(cur.P0);
    int j_hi = (cur.P0 + QB - 1) / KVBLK + 1; if (j_hi > cur.skv / KVBLK) j_hi = cur.skv / KVBLK;
    const int NT = j_hi - j_lo;
    const int kbn = swa_jlo(nxt.P0) * KVBLK;
    const int qlo = cur.P0 + wid * QBLK, qm = qlo + r32 - 4 * hi;
    char* V_lds = lds; char* K_lds = lds + 2 * SHM_V;
    float* ws = (float*)(lds + 2 * SHM_V + 2 * SHM_K) + wid * 64; float* li_l = ws, * al_l = ws + 32;
    float m_reg = -1e30f, l_reg = 0; f32x16 o[4] = {};
    const int sr = tid >> 4, sc = (tid & 15) * 8, vst0 = v_st(sr, sc), vst1 = v_st(32 + sr, sc), kws = KSWZ(sr, sc * 2);
    const int vb0 = (int)(uintptr_t)V_lds + v_rd_base(lane);
    const u16* Kh = cur.K; const u16* Vh = cur.V;
#define RESC(a) do { if (__any((a) < 1.f)) { if (hi == 0) al_l[r32] = (a); asm volatile("s_waitcnt lgkmcnt(0)" ::: "memory");              \
                     for (int d_ = 0; d_ < 4; ++d_) for (int r = 0; r < 16; ++r) o[d_][r] *= al_l[crow(r, hi)]; } } while (0)
#define KBASE(t) ((j_lo + (t)) * KVBLK)
#define ACT(t) (KBASE(t) <= qlo + QBLK - 1 && KBASE(t) + KVBLK - 1 >= qlo - W + 1)
#define MASKT(P0_, P1_, t) do { const int kb_ = KBASE(t); if (ACT(t) && (kb_ + KVBLK - 1 > qlo || kb_ <= qlo + QBLK - 1 - W)) mask_tile(P0_, P1_, qm - kb_, (unsigned)W); } while (0)
    constexpr int NQL = 8;
#define SEAM_K0() do { VMWN(NQL); SWRITE_HK(0); SBAR(); } while (0)
    f32x16 pA0, pA1, pB0, pB1; float mnA, mnB, alA, alB; bf16x8 pa0, pa1, pa2, pa3;
    SWRITE_HV(0); SBAR();
    if (NT > 1) { SLOAD_H(Kh, Vh, KBASE(1)); }
    SBAR(); qkt<0>(pA0, pA1, K_lds, r32, hi, S.qr, ACT(0));
    MASKT(pA0, pA1, 0); partialSM(pA0, pA1, m_reg, mnA, alA);
    if (NT > 1) { VMW(); SWRITE_H(1); }
    __syncthreads();
#define HALF_STEP(PX0, PX1, mnX, alX, PY0, PY1, alY, t, KB, VB, SB) do {                                                      \
        SBAR(); qkt<KB>(PX0, PX1, K_lds, r32, hi, S.qr, ACT(t));                                             \
        finishSM(PY0, PY1, alY, l_reg, pa0, pa1, pa2, pa3); SBAR();                                                           \
        if ((t) + 1 < NT) { SLOAD_H(Kh, Vh, KBASE((t) + 1)); SBAR(); }                                               \
        pv_tile<VB>(o, vb0, pa0, pa1, pa2, pa3, ACT((t) - 1)); MASKT(PX0, PX1, (t)); partialSM(PX0, PX1, m_reg, mnX, alX);                                        \
        __syncthreads();                                                                                                      \
        if ((t) + 1 < NT) { VMW(); SWRITE_H(SB); }                                                                          \
        RESC(alX); __syncthreads(); } while (0)
    for (int t = 1; t + 1 < NT; t += 2) {
        HALF_STEP(pB0, pB1, mnB, alB, pA0, pA1, alA, t, 1, 0, 0);
        HALF_STEP(pA0, pA1, mnA, alA, pB0, pB1, alB, t + 1, 0, 1, 1);
    }
    const bool even = (NT & 1) == 0;
    if (even) { SBAR(); qkt<1>(pB0, pB1, K_lds, r32, hi, S.qr, ACT(NT - 1)); SBAR(); }
    SLOAD_H(nxt.K, nxt.V, kbn); SBAR();
#pragma unroll
    for (int d0 = 0; d0 < 8; ++d0) S.qr[d0] = load8(nxt.Q + (size_t)(nxt.P0 + wid * QBLK + r32) * D + d0 * 16 + hi * 8);
    SBAR();
    finishSM(pA0, pA1, alA, l_reg, pa0, pa1, pa2, pa3); SBAR();
    pv_tile<0>(o, vb0, pa0, pa1, pa2, pa3, ACT(even ? NT - 2 : NT - 1));
    if (even) { MASKT(pB0, pB1, NT - 1); partialSM(pB0, pB1, m_reg, mnB, alB); __syncthreads(); RESC(alB);
        finishSM(pB0, pB1, alB, l_reg, pa0, pa1, pa2, pa3); SBAR(); pv_tile<1>(o, vb0, pa0, pa1, pa2, pa3, ACT(NT - 1)); }
    SBAR(); SEAM_K0();
    if (hi == 0) { const size_t li = (size_t)(cur.trow0 + cur.tstep * (wid * QBLK + r32)) * 8 + cur.h; const float lse_n = m_reg * SCALE + __logf(l_reg);
        if (first_group) { li_l[r32] = 1.0f / l_reg; al_l[r32] = 0.f; LSE[li] = lse_n; }
        else { const float lo = LSE[li], mx = fmaxf(lo, lse_n), eo = __expf(lo - mx), en = __expf(lse_n - mx), inv = 1.0f / (eo + en);
               li_l[r32] = en * inv / l_reg; al_l[r32] = eo * inv; LSE[li] = mx + __logf(eo + en); } }
    asm volatile("s_waitcnt lgkmcnt(0)" ::: "memory");
    {
        u16* Ow = OM + (size_t)(cur.trow0 + cur.tstep * (wid * QBLK)) * 1024 + cur.h * D;
        const size_t rstep = (size_t)cur.tstep * 1024;
#pragma unroll
        for (int r = 0; r < 16; ++r) { const int orow = crow(r, hi); const float wn = li_l[orow], wo = al_l[orow];
            unsigned* rowp = (unsigned*)(Ow + (size_t)orow * rstep + r32);
#pragma unroll
            for (int d0 = 0; d0 < 4; ++d0) { float v = o[d0][r] * wn; float vn = __shfl_xor(v, 1);
                if ((r32 & 1) == 0) { unsigned* p = rowp + d0 * 16;
                    if (!first_group) { const unsigned ov = *p; v += wo * hlo(ov); vn += wo * hhi(ov); }
                    *p = cvtpk(v, vn); } } }
    }
    __syncthreads();
#undef RESC
#undef KBASE
#undef ACT
#undef MASKT
#undef SEAM_K0
#undef HALF_STEP
}
#undef ROW
#undef VMW
#undef VMWN
#undef SLOAD_H
#undef SWRITE_HK
#undef SWRITE_HV
#undef SWRITE_H
#undef KSWZ
#undef SBAR
#undef SWA_MFMA
__device__ __forceinline__ BlockRef swa_ref(int item, int ldil, const u16* Q, const u16* K, const u16* V) {
    const int L = 8192 >> ldil, nqb = L / QB, qb = item % nqb, seq = item / nqb;
    const int r = seq & ((1 << ldil) - 1), bh = seq >> ldil, b = bh >> 3, h = bh & 7;
    BlockRef x; const size_t base = (size_t)seq * L * D;
    x.Q = Q + base; x.K = K + base; x.V = V + base; x.P0 = qb * QB; x.skv = L; x.trow0 = b * 8192 + r + ((qb * QB) << ldil); x.tstep = 1 << ldil; x.h = h;
    return x;
}
__device__ __forceinline__ void attn_phase(char* lds, int vcu, int G, int ldil, const u16* Q, const u16* K, const u16* V, u16* OM, float* LSE, int first_group) {
    const int total = 512;
    int it = 2 * vcu; if (it >= total) return;
    const int per = 2;
    BlockRef cur = swa_ref(it, ldil, Q, K, V);
    Seam S;
    swa_prime(cur, lds, S);
    for (int k = 0; k < per; ++k) {
        const bool last = (k == per - 1);
        const BlockRef nxt = last ? cur : swa_ref(it + k + 1, ldil, Q, K, V);
        swa_block(cur, nxt, lds, S, OM, LSE, first_group);
        cur = nxt;
    }
}
}

namespace gla {
typedef unsigned short u16;
typedef short bf16x8 __attribute__((ext_vector_type(8)));
typedef short s16x4 __attribute__((ext_vector_type(4)));
typedef float f32x16 __attribute__((ext_vector_type(16)));
typedef float f32x4 __attribute__((ext_vector_type(4)));
typedef unsigned u32x4 __attribute__((ext_vector_type(4)));
typedef unsigned u32x2 __attribute__((ext_vector_type(2)));
#define GLAS __attribute__((address_space(3)))
constexpr int RQ = 320, RV = 576;
constexpr int O_QT = 0, O_KT = 64 * RQ, O_KD = 2 * 64 * RQ, O_V = 3 * 64 * RQ, O_DEC = O_V + 64 * RV, O_BL = O_DEC + 512, O_END = O_BL + 512;
constexpr int O_OS = 0;
constexpr int NSEG = 32, SEGC = 4;
typedef float f32x2_t __attribute__((ext_vector_type(2))); typedef __bf16 bf16x2_t __attribute__((ext_vector_type(2)));
__device__ __forceinline__ unsigned cvtpk_bf(float lo, float hi) { const f32x2_t v = {lo, hi}; return __builtin_bit_cast(unsigned, __builtin_convertvector(v, bf16x2_t)); }
__device__ __forceinline__ int crow(int r, int hi) { return (r & 3) + 8 * (r >> 2) + 4 * hi; }
__device__ __forceinline__ float bf_lo(unsigned w) { return __builtin_bit_cast(float, w << 16); }
__device__ __forceinline__ float bf_hi(unsigned w) { return __builtin_bit_cast(float, w & 0xffff0000u); }
__device__ __forceinline__ s16x4 trrd(GLAS const unsigned char* p) { typedef short v4i16_t __attribute__((ext_vector_type(4))); return __builtin_bit_cast(s16x4, __builtin_amdgcn_ds_read_tr16_b64_v4i16((GLAS v4i16_t*)p)); }
template <int PITCH> __device__ __forceinline__ int tr_lane_off(int lane) { const int g = lane >> 4, q = (lane >> 2) & 3, p = lane & 3; return (8 * (g >> 1) + q) * PITCH + (16 * (g & 1) + 4 * p) * 2; }
template <int PITCH> __device__ __forceinline__ bf16x8 tr_frag(GLAS const unsigned char* base, int off) {
    const s16x4 lo = trrd(base + off), hi = trrd(base + off + 4 * PITCH);
    return (bf16x8){lo[0], lo[1], lo[2], lo[3], hi[0], hi[1], hi[2], hi[3]};
}
#define GLA_MFMA(a, b, c) __builtin_amdgcn_mfma_f32_32x32x16_bf16(a, b, c, 0, 0, 0)

struct Tensors { const u16* q; const u16* k; const u16* v; const u16* g; const float* Bc; const float* normw; float* GS; float* GD; u16* GO; };

template <bool FULL>
__device__ __forceinline__ void stage_chunk(GLAS unsigned char* L, const Tensors& T, int b, int h, int tok0, int tid) {
    const int s = tid >> 3, d0 = (tid & 7) * 16; const size_t row = (size_t)b * 8192 + tok0 + s, rowl = (size_t)b * 8192 + tok0 + 63;
    const float* bp = T.Bc + row * 512 + h * 128 + d0; const float* blp = T.Bc + rowl * 512 + h * 128 + d0;
    const u32x4* kp = (const u32x4*)(T.k + row * 512 + h * 128 + d0);
    const u32x4 k0 = kp[0], k1 = kp[1];
    u32x4 q0 = {0, 0, 0, 0}, q1 = {0, 0, 0, 0}; if (FULL) { const u32x4* qp = (const u32x4*)(T.q + row * 512 + h * 128 + d0); q0 = qp[0]; q1 = qp[1]; }
    f32x4 bv[4], bl[4];
#pragma unroll
    for (int i = 0; i < 4; ++i) { bv[i] = *(const f32x4*)(bp + 4 * i); bl[i] = *(const f32x4*)(blp + 4 * i); }
    const u32x4* vp = (const u32x4*)(T.v + row * 1024 + h * 256 + (tid & 7) * 32);
    const u32x4 v0 = vp[0], v1 = vp[1], v2 = vp[2], v3 = vp[3];
    unsigned qt[8], kt[8], kd[8];
#pragma unroll
    for (int i = 0; i < 8; ++i) { const unsigned kw = i < 4 ? k0[i] : k1[i - 4], qw = i < 4 ? q0[i] : q1[i - 4];
        const float b0 = bv[i >> 1][(2 * i) & 3], b1 = bv[i >> 1][(2 * i + 1) & 3], l0 = bl[i >> 1][(2 * i) & 3], l1 = bl[i >> 1][(2 * i + 1) & 3];
        const float kf0 = bf_lo(kw), kf1 = bf_hi(kw);
        kd[i] = cvtpk_bf(kf0 * __expf(l0 - b0), kf1 * __expf(l1 - b1));
        if (FULL) { const float e0 = __expf(b0), e1 = __expf(b1);
            qt[i] = cvtpk_bf(bf_lo(qw) * (0.08838834764831845f * e0), bf_hi(qw) * (0.08838834764831845f * e1));
            kt[i] = cvtpk_bf(kf0 * __builtin_amdgcn_rcpf(e0), kf1 * __builtin_amdgcn_rcpf(e1)); } }
    GLAS unsigned char* r = L + s * RQ + d0 * 2;
    *(GLAS u32x4*)(r + O_KD) = (u32x4){kd[0], kd[1], kd[2], kd[3]}; *(GLAS u32x4*)(r + O_KD + 16) = (u32x4){kd[4], kd[5], kd[6], kd[7]};
    if (FULL) { *(GLAS u32x4*)(r + O_QT) = (u32x4){qt[0], qt[1], qt[2], qt[3]}; *(GLAS u32x4*)(r + O_QT + 16) = (u32x4){qt[4], qt[5], qt[6], qt[7]};
                *(GLAS u32x4*)(r + O_KT) = (u32x4){kt[0], kt[1], kt[2], kt[3]}; *(GLAS u32x4*)(r + O_KT + 16) = (u32x4){kt[4], kt[5], kt[6], kt[7]}; }
    GLAS unsigned char* rv = L + O_V + s * RV + (tid & 7) * 64;
    *(GLAS u32x4*)(rv) = v0; *(GLAS u32x4*)(rv + 16) = v1; *(GLAS u32x4*)(rv + 32) = v2; *(GLAS u32x4*)(rv + 48) = v3;
    if (tid < 128) { const float bl_ = T.Bc[rowl * 512 + h * 128 + tid]; ((GLAS float*)(L + O_BL))[tid] = bl_; ((GLAS float*)(L + O_DEC))[tid] = __expf(bl_); }
}
__device__ __forceinline__ void state_update(GLAS const unsigned char* Ltq, GLAS const unsigned char* Ld, f32x16 (&S)[4], const bf16x8 (&vf)[4]) {
#pragma unroll
    for (int T = 0; T < 4; ++T) {
#pragma unroll
        for (int i = 0; i < 4; ++i) { const f32x4 dc = *(GLAS const f32x4*)(Ld + O_DEC + 128 * T + 32 * i);
#pragma unroll
            for (int e = 0; e < 4; ++e) S[T][4 * i + e] *= dc[e]; }
#pragma unroll
        for (int kk = 0; kk < 4; ++kk) { const bf16x8 a = tr_frag<RQ>(Ltq, O_KD + 16 * kk * RQ + 64 * T); S[T] = GLA_MFMA(a, vf[kk], S[T]); }
    }
}
__device__ __forceinline__ void load_vfrags(GLAS const unsigned char* Ltv, bf16x8 (&vf)[4]) {
#pragma unroll
    for (int kk = 0; kk < 4; ++kk) vf[kk] = tr_frag<RV>(Ltv, 16 * kk * RV);
}
#define GLA_OPAQUE(p) asm volatile("" : "+v"(p))
__device__ __forceinline__ void gla1_phase(GLAS unsigned char* L, int unit, const Tensors& T) {
    int tid = threadIdx.x; asm volatile("" : "+v"(tid));
    const int wid = __builtin_amdgcn_readfirstlane(tid >> 6), lane = tid & 63, hi = lane >> 5, n = lane & 31;
    const int bh = unit / NSEG, seg = unit % NSEG, b = bh >> 2, h = bh & 3;
    f32x16 S[4] = {};
    float dsum = 0.f;
    for (int c = 0; c < SEGC; ++c) {
        stage_chunk<false>(L, T, b, h, seg * 256 + c * 64, tid);
        asm volatile("s_waitcnt lgkmcnt(0)" ::: "memory"); __syncthreads();
        if (tid < 128) dsum += ((GLAS const float*)(L + O_BL))[tid];
        GLAS const unsigned char* Ltq = L + tr_lane_off<RQ>(lane); GLAS const unsigned char* Ltv = L + O_V + tr_lane_off<RV>(lane) + 64 * wid; GLAS const unsigned char* Ld = L + 16 * hi;
        GLA_OPAQUE(Ltq); GLA_OPAQUE(Ltv); GLA_OPAQUE(Ld);
        bf16x8 vf[4]; load_vfrags(Ltv, vf);
        state_update(Ltq, Ld, S, vf);
        __syncthreads();
    }
    float* gs = T.GS + (size_t)unit * (128 * 256);
#pragma unroll
    for (int Tt = 0; Tt < 4; ++Tt)
#pragma unroll
        for (int r = 0; r < 16; ++r) gs[(size_t)(32 * Tt + crow(r, hi)) * 256 + 32 * wid + n] = S[Tt][r];
    if (tid < 128) T.GD[(size_t)unit * 128 + tid] = __expf(dsum);
}
__device__ __forceinline__ void gla2_phase(int vcu, int G, const Tensors& T) {
    int tid = threadIdx.x; asm volatile("" : "+v"(tid));
    for (int e = vcu * 512 + tid; e < 8 * 128 * 256; e += G * 512) { const int bh = e >> 15, dv = e & 32767, d = dv >> 8;
        float run = 0.f;
        for (int seg = 0; seg < NSEG; ++seg) { float* p = T.GS + ((size_t)(bh * NSEG + seg) << 15) + dv; const float loc = *p, dec = T.GD[(size_t)(bh * NSEG + seg) * 128 + d];
            *p = run; run = dec * run + loc; } }
}
__device__ __forceinline__ void gla3_phase(GLAS unsigned char* L, int unit, const Tensors& T) {
    int tid = threadIdx.x; asm volatile("" : "+v"(tid));
    const int wid = __builtin_amdgcn_readfirstlane(tid >> 6), lane = tid & 63, hi = lane >> 5, n = lane & 31;
    const int bh = unit / NSEG, seg = unit % NSEG, b = bh >> 2, h = bh & 3;
    f32x16 S[4];
    { const float* gs = T.GS + (size_t)unit * (128 * 256);
#pragma unroll
      for (int Tt = 0; Tt < 4; ++Tt)
#pragma unroll
          for (int r = 0; r < 16; ++r) S[Tt][r] = gs[(size_t)(32 * Tt + crow(r, hi)) * 256 + 32 * wid + n]; }
    const f32x4 nw4 = *(const f32x4*)(T.normw + 4 * lane);
    for (int c = 0; c < SEGC; ++c) { const int tok0 = seg * 256 + c * 64;
        stage_chunk<true>(L, T, b, h, tok0, tid);
        asm volatile("s_waitcnt lgkmcnt(0)" ::: "memory"); __syncthreads();
        GLAS const unsigned char* Ltq = L + tr_lane_off<RQ>(lane); GLAS const unsigned char* Ltv = L + O_V + tr_lane_off<RV>(lane) + 64 * wid; GLAS const unsigned char* Ld = L + 16 * hi;
        GLAS const unsigned char* Lq = L + n * RQ + 16 * hi; GLAS const unsigned char* Lp = L + n * RQ + 8 * hi;
        GLAS unsigned char* Lo = L + O_OS + 4096 * hi + (32 * wid + n) * 4; GLAS const unsigned char* Lr = L + O_OS + 8192 * wid + 16 * lane;
        GLA_OPAQUE(Ltq); GLA_OPAQUE(Ltv); GLA_OPAQUE(Ld); GLA_OPAQUE(Lq); GLA_OPAQUE(Lp); GLA_OPAQUE(Lo); GLA_OPAQUE(Lr);
        bf16x8 vf[4]; load_vfrags(Ltv, vf);
        f32x16 o[2] = {};
#pragma unroll
        for (int bq = 0; bq < 2; ++bq)
#pragma unroll
            for (int a = 0; a <= bq; ++a) {
                f32x16 x = {};
#pragma unroll
                for (int kk = 0; kk < 8; ++kk) { const bf16x8 ka = *(GLAS const bf16x8*)(Lq + O_KT + 32 * a * RQ + 32 * kk);
                                                 const bf16x8 qb = *(GLAS const bf16x8*)(Lq + O_QT + 32 * bq * RQ + 32 * kk);
                                                 x = GLA_MFMA(ka, qb, x); }
                if (a == bq) {
#pragma unroll
                    for (int r = 0; r < 16; ++r) if (crow(r, hi) > n) x[r] = 0.f; }
                bf16x8 pa0, pa1;
#define PK4(P, B_, OUT) do { unsigned a0 = cvtpk_bf(P[B_+0], P[B_+1]), a1 = cvtpk_bf(P[B_+2], P[B_+3]), b0 = cvtpk_bf(P[B_+4], P[B_+5]), b1 = cvtpk_bf(P[B_+6], P[B_+7]); \
        auto r0 = __builtin_amdgcn_permlane32_swap(a0, b0, false, false); auto r1 = __builtin_amdgcn_permlane32_swap(a1, b1, false, false); \
        u32x4 w = {r0[0], r1[0], r0[1], r1[1]}; OUT = __builtin_bit_cast(bf16x8, w); } while (0)
                PK4(x, 0, pa0); PK4(x, 8, pa1);
#undef PK4
                o[bq] = GLA_MFMA(pa0, vf[2 * a], o[bq]); o[bq] = GLA_MFMA(pa1, vf[2 * a + 1], o[bq]);
            }
#pragma unroll
        for (int Tt = 0; Tt < 4; ++Tt)
#pragma unroll
            for (int s2 = 0; s2 < 2; ++s2) {
                u32x4 sw; sw.x = cvtpk_bf(S[Tt][8 * s2 + 0], S[Tt][8 * s2 + 1]); sw.y = cvtpk_bf(S[Tt][8 * s2 + 2], S[Tt][8 * s2 + 3]); sw.z = cvtpk_bf(S[Tt][8 * s2 + 4], S[Tt][8 * s2 + 5]); sw.w = cvtpk_bf(S[Tt][8 * s2 + 6], S[Tt][8 * s2 + 7]);
                const bf16x8 sb = __builtin_bit_cast(bf16x8, sw);
#pragma unroll
                for (int bq = 0; bq < 2; ++bq) { GLAS const unsigned char* qp = Lp + O_QT + 32 * bq * RQ + 64 * Tt + 32 * s2;
                    const u32x2 lo = *(GLAS const u32x2*)qp, hi2 = *(GLAS const u32x2*)(qp + 16);
                    const bf16x8 qa = __builtin_bit_cast(bf16x8, (u32x4){lo.x, lo.y, hi2.x, hi2.y});
                    o[bq] = GLA_MFMA(qa, sb, o[bq]); }
            }
        state_update(Ltq, Ld, S, vf);
        __syncthreads();
        {
#pragma unroll
          for (int bq = 0; bq < 2; ++bq)
#pragma unroll
              for (int r = 0; r < 16; ++r) *(GLAS float*)(Lo + (32 * bq + (r & 3) + 8 * (r >> 2)) * 1024) = o[bq][r]; }
        asm volatile("s_waitcnt lgkmcnt(0)" ::: "memory"); __syncthreads();
#pragma unroll
        for (int t8 = 0; t8 < 8; ++t8) { const int tk = 8 * wid + t8; const size_t row = (size_t)b * 8192 + tok0 + tk;
            const f32x4 ov = *(GLAS const f32x4*)(Lr + t8 * 1024);
            const u32x2 gw = *(const u32x2*)(T.g + row * 1024 + h * 256 + 4 * lane);
            float sq = (ov[0] * ov[0] + ov[1] * ov[1]) + (ov[2] * ov[2] + ov[3] * ov[3]);
#pragma unroll
            for (int of = 1; of < 64; of <<= 1) sq += __shfl_xor(sq, of);
            const float rstd = 1.0f / sqrtf(sq * (1.0f / 256.0f) + 1e-5f);
            const float g0 = bf_lo(gw.x), g1 = bf_hi(gw.x), g2 = bf_lo(gw.y), g3 = bf_hi(gw.y);
            const float y0 = ov[0] * rstd * nw4[0] * (g0 / (1.0f + __expf(-g0))), y1 = ov[1] * rstd * nw4[1] * (g1 / (1.0f + __expf(-g1)));
            const float y2 = ov[2] * rstd * nw4[2] * (g2 / (1.0f + __expf(-g2))), y3 = ov[3] * rstd * nw4[3] * (g3 / (1.0f + __expf(-g3)));
            u32x2 w; w.x = pg8::cvt_pk_h(y0, y1); w.y = pg8::cvt_pk_h(y2, y3);
            *(u32x2*)(T.GO + row * 1024 + h * 256 + 4 * lane) = w; }
        __syncthreads();
    }
}
#undef GLA_MFMA
#undef GLA_OPAQUE
#undef GLAS
}

constexpr int NWAVES = 8;
constexpr int BATCH = 2, SEQ = 8192, DM = 1024, MTOK = BATCH * SEQ, DFF = 4096;
constexpr int NGRP = 3, AH = 8, HD = 128, AIN = 9216;
constexpr int GH = 4, GDK = 128, GDV = 256, GKD = 512, GVD = 1024, GRANK = 16, GIN = 3088, GCH = 64;
constexpr float EPS = 1e-5f;
__host__ __device__ constexpr int grp_ldil(int g) { return g == 0 ? 0 : (g == 1 ? 2 : 4); }

constexpr size_t MiB = 1u << 20;
constexpr size_t WS_CTL = 0, CTL_ZERO_BYTES = 1 * MiB;
constexpr size_t WS_SSQ = 1 * MiB;
constexpr size_t WS_LSE = 2 * MiB;
constexpr size_t WS_COS = 3 * MiB, WS_SIN = 5 * MiB;
constexpr size_t WS_WG = 7 * MiB;
constexpr size_t WS_WQKV = 8 * MiB, WS_WO0 = 26 * MiB, WS_WUP0 = 28 * MiB, WS_WDN0 = 36 * MiB;
constexpr size_t WS_WGLA = 44 * MiB, WS_WO1 = 50 * MiB, WS_WUP1 = 52 * MiB, WS_WDN1 = 60 * MiB;
constexpr size_t WS_XB = 68 * MiB;
constexpr size_t WS_Q = 100 * MiB, WS_K = 132 * MiB, WS_V = 164 * MiB;
constexpr size_t WS_OM = 196 * MiB;
constexpr size_t WS_H = 100 * MiB;
constexpr size_t WS_GQ = 100 * MiB, WS_GK = 116 * MiB, WS_GV = 132 * MiB, WS_GG = 164 * MiB;
constexpr size_t WS_GB = 196 * MiB;
constexpr size_t WS_GS = 8 * MiB;
constexpr size_t WS_XB1 = 8 * MiB;
constexpr size_t WS_GD = 228 * MiB;
constexpr size_t WS_END = 256 * MiB;
constexpr int CW_TMO = 0, CW_CODE = 1, CW_BAR = 4096;

constexpr int RING_OFF = 0, RING_BYTES = 131072;
constexpr int LDSCTL_OFF = RING_BYTES, MISC_OFF = LDSCTL_OFF + 320;
constexpr int LDS_BYTES = 147456;
constexpr int INPTR_LDS_OFF = 131072 + 512 + 2048 + 512;
constexpr int GLR_LDS_OFF = 131072 + 512 + 2048;
static_assert(MISC_OFF + 128 <= LDS_BYTES, "LDS map");

#ifndef GLA_SIMPLE
#define GLA_SIMPLE 0
#endif
enum Phase { PH_PRO = 0, PH_QKV0 = 1, PH_ATT0 = 2, PH_QKV1 = 3, PH_ATT1 = 4, PH_QKV2 = 5, PH_ATT2 = 6, PH_WO0 = 7, PH_UP0 = 8, PH_DN0 = 9,
             PH_GLAP = 10, PH_GLA1 = 11, PH_GLA2 = 12, PH_GLA3 = 13, PH_WO1 = 14, PH_UP1 = 15, PH_DN1 = 16, PH_FIN = 17, PH_N = 18 };

struct Frame {
    LAS unsigned char* lds;
    volatile LAS unsigned* MISC;
    gu32* ctl;
    int tid, lane, wave;
    int vcu, G;
};
__device__ __forceinline__ float wave_sum(float v) {
#pragma unroll
    for (int o = 1; o < 64; o <<= 1) v += __shfl_xor(v, o);
    return v;
}
__device__ __forceinline__ float bf2f(unsigned short h) { return __builtin_bit_cast(float, (unsigned)h << 16); }
__device__ __forceinline__ unsigned pkh(float lo, float hi) { return pg8::cvt_pk_h(lo, hi); }
__device__ __forceinline__ float hlo(unsigned w) { return (float)__builtin_bit_cast(pg8::h16x2, w)[0]; }
__device__ __forceinline__ float hhi(unsigned w) { return (float)__builtin_bit_cast(pg8::h16x2, w)[1]; }
__device__ __forceinline__ float h2f(unsigned short h) { return (float)__builtin_bit_cast(_Float16, h); }

__device__ __forceinline__ void xpose_item(const float* W, int ldn, int K, const float* nw, bf16* WT, int dst_row0, int k0, int n0, int nvalid, LAS float* scr, int lane) {
    const bool cv = (lane & 31) < nvalid;
#pragma unroll 8
    for (int i = 0; i < 32; ++i) { const int kk = 2 * i + (lane >> 5); float w = cv ? W[(size_t)(k0 + kk) * ldn + n0 + (lane & 31)] : 0.f; if (nw) w *= nw[k0 + kk]; scr[kk * 33 + (lane & 31)] = w; }
    LDS_WAIT(); asm volatile("" ::: "memory");
    const int c = lane & 7;
#pragma unroll
    for (int j = 0; j < 4; ++j) { const int n = (lane >> 3) + 8 * j; const LAS float* s = scr + (8 * c) * 33 + n;
        v4u o; o.x = pkh(s[0 * 33], s[1 * 33]); o.y = pkh(s[2 * 33], s[3 * 33]); o.z = pkh(s[4 * 33], s[5 * 33]); o.w = pkh(s[6 * 33], s[7 * 33]);
        if (n < nvalid) *(GAS v4u*)(WT + (size_t)(dst_row0 + n) * K + k0 + 8 * c) = o; }
    LDS_WAIT(); asm volatile("" ::: "memory");
}
__device__ __forceinline__ void sincos_f(float x, float& s, float& c) {
    const float k = __builtin_rintf(x * 0.636619772f);
    float r = __builtin_fmaf(-k, 1.5703125f, x); r = __builtin_fmaf(-k, 0.0004837512969970703f, r); r = __builtin_fmaf(-k, 7.549533620476723e-08f, r); r = __builtin_fmaf(-k, 2.5632829192545614e-12f, r);
    const float r2 = r * r;
    const float sr = r + r * r2 * (-1.6666654611e-1f + r2 * (8.3321608736e-3f + r2 * -1.9515295891e-4f));
    const float cr = 1.0f - 0.5f * r2 + r2 * r2 * (4.166664568298827e-2f + r2 * (-1.388731625493765e-3f + r2 * 2.443315711809948e-5f));
    const int q = (int)k & 3;
    s = (q == 0) ? sr : (q == 1) ? cr : (q == 2) ? -sr : -cr;
    c = (q == 0) ? cr : (q == 1) ? -sr : (q == 2) ? -cr : sr;
}
__device__ const float ROPE_INVF[64] = {1.000000000e+00f, 8.659643531e-01f, 7.498942614e-01f, 6.493816376e-01f, 5.623413324e-01f, 4.869675338e-01f, 4.216965139e-01f, 3.651741147e-01f, 3.162277639e-01f, 2.738419771e-01f, 2.371373773e-01f, 2.053525001e-01f, 1.778279394e-01f, 1.539926529e-01f, 1.333521307e-01f, 1.154782027e-01f, 1.000000015e-01f, 8.659642935e-02f, 7.498941571e-02f, 6.493816525e-02f, 5.623413250e-02f, 4.869675264e-02f, 4.216965288e-02f, 3.651741147e-02f, 3.162277490e-02f, 2.738419734e-02f, 2.371373773e-02f, 2.053525113e-02f, 1.778279431e-02f, 1.539926510e-02f, 1.333521493e-02f, 1.154782064e-02f, 9.999999776e-03f, 8.659643121e-03f, 7.498941850e-03f, 6.493816152e-03f, 5.623413250e-03f, 4.869675264e-03f, 4.216964822e-03f, 3.651741194e-03f, 3.162277630e-03f, 2.738419687e-03f, 2.371373586e-03f, 2.053524833e-03f, 1.778279431e-03f, 1.539926510e-03f, 1.333521446e-03f, 1.154781901e-03f, 1.000000047e-03f, 8.659643354e-04f, 7.498942432e-04f, 6.493816618e-04f, 5.623413017e-04f, 4.869675322e-04f, 4.216965172e-04f, 3.651741426e-04f, 3.162277571e-04f, 2.738419571e-04f, 2.371373703e-04f, 2.053525095e-04f, 1.778279402e-04f, 1.539926452e-04f, 1.333521504e-04f, 1.154782003e-04f};

__device__ __forceinline__ const float* in_ptr(LAS unsigned char* lds, int k) {
    const unsigned long long v = ((volatile LAS unsigned long long*)(lds + INPTR_LDS_OFF))[k];
    const unsigned lo = __builtin_amdgcn_readfirstlane((unsigned)v), hi = __builtin_amdgcn_readfirstlane((unsigned)(v >> 32));
    return (const float*)(((unsigned long long)hi << 32) | lo);
}

__device__ __forceinline__ void gla_simple_phase(LAS unsigned char* ldsb, int vcu, const bf16* q, const bf16* k, const bf16* v, const bf16* g, const float* Bc, const float* normw, bf16* GO) {
    if (vcu >= BATCH * GH) return;
    int tid = threadIdx.x; asm volatile("" : "+v"(tid));
    LAS float* as_ = (LAS float*)ldsb; LAS float* ks_ = as_ + 256; LAS float* qs_ = ks_ + 256; LAS float* red = qs_ + 256;
    const int vp = tid >> 2, qt = tid & 3, wv = tid >> 6, lane = tid & 63;
    const int b = vcu >> 2, h = vcu & 3;
    float S0[32], S1[32];
#pragma unroll
    for (int j = 0; j < 32; ++j) { S0[j] = 0.f; S1[j] = 0.f; }
    const float nw0 = normw[vp], nw1 = normw[vp + 128];
    for (int t = 0; t < SEQ; ++t) { const size_t row = (size_t)b * SEQ + t; const int bf = t & 1;
        if (tid < 128) { const float* bp = Bc + row * GKD + h * GDK + tid; const float la = bp[0] - ((t & 63) ? bp[-GKD] : 0.f);
            as_[bf * 128 + tid] = expf(la); ks_[bf * 128 + tid] = bf2f(k[row * GKD + h * GDK + tid]); qs_[bf * 128 + tid] = bf2f(q[row * GKD + h * GDK + tid]) * 0.08838834764831845f; }
        const float v0 = bf2f(v[row * GVD + h * GDV + vp]), v1 = bf2f(v[row * GVD + h * GDV + vp + 128]);
        __syncthreads();
        float o0 = 0.f, o1 = 0.f;
#pragma unroll
        for (int c = 0; c < 8; ++c) { const f32x4 a4 = *(const LAS f32x4*)&as_[bf * 128 + qt * 32 + 4 * c], k4 = *(const LAS f32x4*)&ks_[bf * 128 + qt * 32 + 4 * c], q4 = *(const LAS f32x4*)&qs_[bf * 128 + qt * 32 + 4 * c];
#pragma unroll
            for (int e = 0; e < 4; ++e) { const int j = 4 * c + e; S0[j] = a4[e] * S0[j] + k4[e] * v0; o0 += q4[e] * S0[j]; S1[j] = a4[e] * S1[j] + k4[e] * v1; o1 += q4[e] * S1[j]; } }
        o0 += __shfl_xor(o0, 1); o0 += __shfl_xor(o0, 2); o1 += __shfl_xor(o1, 1); o1 += __shfl_xor(o1, 2);
        float sq = qt == 0 ? o0 * o0 + o1 * o1 : 0.f; sq = wave_sum(sq);
        if (lane == 0) red[bf * 8 + wv] = sq;
        __syncthreads();
        float tot = 0.f;
#pragma unroll
        for (int w = 0; w < 8; ++w) tot += red[bf * 8 + w];
        const float rstd = 1.0f / sqrtf(tot * (1.0f / GDV) + EPS);
        if (qt == 0) { const float g0 = bf2f(g[row * GVD + h * GDV + vp]), g1 = bf2f(g[row * GVD + h * GDV + vp + 128]);
            GO[row * GVD + h * GDV + vp] = __builtin_bit_cast(unsigned short, (_Float16)(o0 * rstd * nw0 * (g0 / (1.0f + expf(-g0)))));
            GO[row * GVD + h * GDV + vp + 128] = __builtin_bit_cast(unsigned short, (_Float16)(o1 * rstd * nw1 * (g1 / (1.0f + expf(-g1))))); }
    }
}

struct Args { const float* in[13]; float* out; unsigned char* ws; int ph_lo, ph_hi, li, skip_mask; };

__global__ void __launch_bounds__(NWAVES * 64, 2) mega_fwd(Args args) {
    extern __shared__ __attribute__((aligned(16))) unsigned char lds[];
    Frame F;
    F.lds = (LAS unsigned char*)lds;
    F.MISC = (volatile LAS unsigned*)(F.lds + MISC_OFF);
    F.tid = threadIdx.x; F.lane = F.tid & 63; F.wave = __builtin_amdgcn_readfirstlane(F.tid >> 6);
    F.G = gridDim.x; { const int bx = blockIdx.x; F.vcu = (F.G % 8 == 0) ? (bx % 8) * (F.G / 8) + bx / 8 : bx; }
    unsigned char* ws = args.ws;
    F.ctl = (gu32*)(ws + WS_CTL);
    for (int u = F.tid; u < (LDS_BYTES - LDSCTL_OFF) / 4; u += NWAVES * 64) ((LAS unsigned*)(F.lds + LDSCTL_OFF))[u] = 0u;
    __syncthreads();
    const bool multi = (args.ph_hi - args.ph_lo) > 1;
    XcdBarrier bar; bar.bar = (unsigned*)(F.ctl + CW_BAR) + args.li * XCD_BAR_WORDS; bar.x = 0; bar.st = nullptr;
    if (multi) bar = xcd_barrier_post((unsigned*)(F.ctl + CW_BAR) + args.li * XCD_BAR_WORDS, F.MISC + 8);

    if (F.tid == 0) {
#pragma unroll
        for (int k = 0; k < 13; ++k) ((LAS unsigned long long*)(F.lds + INPTR_LDS_OFF))[k] = (unsigned long long)args.in[k]; }
    __syncthreads();
#define INP(k) in_ptr(F.lds, (k))
    float* const xres = args.out;
    float* const ssq = (float*)(ws + WS_SSQ);
    bf16* const XB = (bf16*)(ws + WS_XB);
    const int gw = F.vcu * NWAVES + F.wave, NGW = F.G * NWAVES;
    LAS float* const rl = (LAS float*)(F.lds + pg8::RSTD_LDS_OFF);

    for (int ph = args.ph_lo; ph < args.ph_hi; ++ph) {
      if (!((args.skip_mask >> ph) & 1)) {
        if (ph == PH_PRO) {
#ifndef NO_PRO
            int tid = threadIdx.x; asm volatile("" : "+v"(tid)); const int lane = tid & 63;
            LAS float* scr = (LAS float*)(F.lds + RING_OFF + F.wave * 16384);
            constexpr int I_QKV = 16 * 288, I_O = 16 * 32, I_UP = 16 * 128, I_DN = 64 * 32, I_GLA = 16 * 97;
            constexpr int NITEMS = I_QKV + 2 * I_O + 2 * I_UP + 2 * I_DN + I_GLA;
            for (int it = gw; it < NITEMS; it += NGW) {
                int r = it; const float* W; int ldn, K = DM, nvalid = 32, dst_row0, k0, n0; const float* nw = nullptr; bf16* WT;
                if (r < I_QKV) { const int kb = r / 288, nb = r % 288; n0 = nb * 32; const int nin = n0 % 3072, which = nin / 1024, j = nin % 1024;
                    const int jd = which < 2 ? ((j & ~0xC0) | ((j & 0x40) << 1) | ((j & 0x80) >> 1)) : j;
                    W = INP(4); ldn = AIN; nw = INP(1); WT = (bf16*)(ws + WS_WQKV); dst_row0 = n0 - j + jd; k0 = kb * 64; }
                else if ((r -= I_QKV) < I_O) { W = INP(5); ldn = DM; WT = (bf16*)(ws + WS_WO0); n0 = dst_row0 = (r % 32) * 32; k0 = (r / 32) * 64; }
                else if ((r -= I_O) < I_O) { W = INP(10); ldn = DM; WT = (bf16*)(ws + WS_WO1); n0 = dst_row0 = (r % 32) * 32; k0 = (r / 32) * 64; }
                else if ((r -= I_O) < I_UP) { W = INP(11); ldn = DFF; nw = INP(2); WT = (bf16*)(ws + WS_WUP0); n0 = dst_row0 = (r % 128) * 32; k0 = (r / 128) * 64; }
                else if ((r -= I_UP) < I_UP) { W = INP(11) + (size_t)DM * DFF; ldn = DFF; nw = INP(2) + DM; WT = (bf16*)(ws + WS_WUP1); n0 = dst_row0 = (r % 128) * 32; k0 = (r / 128) * 64; }
                else if ((r -= I_UP) < I_DN) { W = INP(12); ldn = DM; K = DFF; WT = (bf16*)(ws + WS_WDN0); n0 = dst_row0 = (r % 32) * 32; k0 = (r / 32) * 64; }
                else if ((r -= I_DN) < I_DN) { W = INP(12) + (size_t)DFF * DM; ldn = DM; K = DFF; WT = (bf16*)(ws + WS_WDN1); n0 = dst_row0 = (r % 32) * 32; k0 = (r / 32) * 64; }
                else { r -= I_DN; const int kb = r / 97, nb = r % 97; W = INP(6); ldn = GIN; nw = INP(1) + DM; k0 = kb * 64; n0 = nb * 32;
                    if (nb < 96) { WT = (bf16*)(ws + WS_WGLA); dst_row0 = n0; } else { WT = (bf16*)(ws + WS_WG); dst_row0 = 0; nvalid = 16; } }
                xpose_item(W, ldn, K, nw, WT, dst_row0, k0, n0, nvalid, scr, lane);
            }
            { float* cosT = (float*)(ws + WS_COS); float* sinT = (float*)(ws + WS_SIN);
              for (int e = blockIdx.x * (NWAVES * 64) + tid; e < SEQ * 64; e += F.G * NWAVES * 64) { const int pos = e >> 6, i = e & 63;
                  const float ang = (float)pos * ROPE_INVF[i]; float sn, cs; sincos_f(ang, sn, cs); cosT[e] = cs; sinT[e] = sn; } }
            const float* x_in = INP(0);
            for (int m = gw; m < MTOK; m += NGW) { const GAS f32x4* xr = (const GAS f32x4*)(x_in + (size_t)m * DM) + lane; float s = 0.f;
                GAS unsigned long long* o8 = (GAS unsigned long long*)(XB + (size_t)m * DM) + lane;
#pragma unroll
                for (int j = 0; j < 4; ++j) { const f32x4 v = xr[64 * j]; s += (v.x * v.x + v.y * v.y) + (v.z * v.z + v.w * v.w);
                    o8[64 * j] = (unsigned long long)pkh(v.x, v.y) | ((unsigned long long)pkh(v.z, v.w) << 32); }
                s = wave_sum(s); if (lane < 16) ssq[(size_t)m * 16 + lane] = lane == 0 ? s : 0.f; }
#endif
        }
        else if (ph == PH_QKV0 || ph == PH_QKV1 || ph == PH_QKV2) {
            const int g = (ph - PH_QKV0) >> 1;
            pg8::Gemm gm{XB, (const bf16*)(ws + WS_WQKV) + (size_t)g * 3072 * DM, MTOK, 3072, DM}; pg8::RstdOrder S; S.init(MTOK, 3072, F.G, (int)blockIdx.x); S.ssq = ssq; S.rl = rl;
            pg8::EpiQKV E{(bf16*)(ws + WS_Q), (bf16*)(ws + WS_K), (bf16*)(ws + WS_V), rl, (const float*)(ws + WS_COS), (const float*)(ws + WS_SIN), g == 0 ? 0 : (g == 1 ? 2 : 4)};
#ifndef NO_QKV
            pg8::gemm_phase<pg8::EpiQKV, pg8::RstdOrder, true, true>(F.lds + RING_OFF, gm, S, E);
#endif
        }
        else if (ph == PH_ATT0 || ph == PH_ATT1 || ph == PH_ATT2) {
            const int g = (ph - PH_ATT0) >> 1;
            swa::attn_phase((char*)lds, F.vcu, F.G, g == 0 ? 0 : (g == 1 ? 2 : 4), (const swa::u16*)(ws + WS_Q), (const swa::u16*)(ws + WS_K), (const swa::u16*)(ws + WS_V), (swa::u16*)(ws + WS_OM), (float*)(ws + WS_LSE), g == 0);
        }
        else if (ph == PH_WO0 || ph == PH_DN0 || ph == PH_WO1 || ph == PH_DN1) {
            const bf16* A; const bf16* Bt; int K; const float* resid = xres; bf16* xbo = XB;
            if (ph == PH_WO0) { A = (const bf16*)(ws + WS_OM); Bt = (const bf16*)(ws + WS_WO0); K = DM; resid = INP(0); }
            else if (ph == PH_DN0) { A = (const bf16*)(ws + WS_H); Bt = (const bf16*)(ws + WS_WDN0); K = DFF; }
            else if (ph == PH_WO1) { A = XB; Bt = (const bf16*)(ws + WS_WO1); K = DM; xbo = (bf16*)(ws + WS_XB1); }
            else { A = (const bf16*)(ws + WS_H); Bt = (const bf16*)(ws + WS_WDN1); K = DFF; }
            pg8::Gemm gm{A, Bt, MTOK, DM, K}; pg8::PlainOrder S; S.init(MTOK, DM, F.G, (int)blockIdx.x);
            pg8::EpiResid E{resid, xres, xbo, ssq};
#ifndef NO_RES
            pg8::gemm_phase<pg8::EpiResid, pg8::PlainOrder, false, true>(F.lds + RING_OFF, gm, S, E);
#endif
        }
        else if (ph == PH_UP0 || ph == PH_UP1) {
            const bf16* A = ph == PH_UP0 ? XB : (const bf16*)(ws + WS_XB1);
            pg8::Gemm gm{A, (const bf16*)(ws + (ph == PH_UP0 ? WS_WUP0 : WS_WUP1)), MTOK, DFF, DM}; pg8::RstdOrder S; S.init(MTOK, DFF, F.G, (int)blockIdx.x); S.ssq = ssq; S.rl = rl;
            pg8::EpiUp E{(bf16*)(ws + WS_H), rl};
#ifndef NO_UP
            pg8::gemm_phase<pg8::EpiUp, pg8::RstdOrder, true, true>(F.lds + RING_OFF, gm, S, E);
#endif
        }
        else if (ph == PH_GLAP) {
            { pg8::Gemm gm{XB, (const bf16*)(ws + WS_WGLA), MTOK, 3072, DM}; pg8::RstdOrder S; S.init(MTOK, 3072, F.G, (int)blockIdx.x); S.ssq = ssq; S.rl = rl;
              pg8::EpiGla E{(bf16*)(ws + WS_GQ), (bf16*)(ws + WS_GK), (bf16*)(ws + WS_GV), (bf16*)(ws + WS_GG), rl};
#ifndef NO_GLAP
              pg8::gemm_phase<pg8::EpiGla, pg8::RstdOrder, true, true>(F.lds + RING_OFF, gm, S, E);
#endif
 }
#ifndef NO_GATE
            __syncthreads();
            int tid = threadIdx.x; asm volatile("" : "+v"(tid)); const int lane = tid & 63;
            { LAS float* la = (LAS float*)(F.lds + RING_OFF);
              LAS float* gl = (LAS float*)(F.lds + GLR_LDS_OFF) + F.wave * GRANK;
              const bf16* WG = (const bf16*)(ws + WS_WG); const float* wgu = INP(7); const float* bg = INP(8); float* GB = (float*)(ws + WS_GB);
              for (int ch = F.vcu; ch < MTOK / GCH; ch += F.G) {
#pragma unroll 1
                  for (int tt = F.wave; tt < GCH; tt += NWAVES) { const int row = ch * GCH + tt;
                      const GAS v4u* xr = (const GAS v4u*)(XB + (size_t)row * DM) + 2 * lane; const v4u xa = xr[0], xc = xr[1];
                      float sq = lane < 16 ? ssq[(size_t)row * 16 + lane] : 0.f; sq = wave_sum(sq); const float rstd = 1.0f / sqrtf(sq * (1.0f / DM) + EPS);
#pragma unroll 1
                      for (int j = 0; j < GRANK; ++j) { const GAS v4u* wr_ = (const GAS v4u*)(WG + (size_t)j * DM) + 2 * lane; const v4u wa = wr_[0], wc_ = wr_[1]; float d = 0.f;
#pragma unroll
                          for (int e = 0; e < 4; ++e) { d += hlo(xa[e]) * hlo(wa[e]) + hhi(xa[e]) * hhi(wa[e]); d += hlo(xc[e]) * hlo(wc_[e]) + hhi(xc[e]) * hhi(wc_[e]); }
                          d = wave_sum(d) * rstd; if (lane == 0) gl[j] = d; }
                      LDS_WAIT(); asm volatile("" ::: "memory");
#pragma unroll 1
                      for (int i = 0; i < 8; ++i) { const int c = lane + 64 * i; float gk = bg[c];
#pragma unroll
                          for (int j = 0; j < GRANK; ++j) gk += gl[j] * wgu[j * GKD + c];
                          const float ls = fminf(gk, 0.f) - log1pf(expf(-fabsf(gk)));
                          la[tt * GKD + c] = ls * (1.0f / 16.0f); }
                      LDS_WAIT(); asm volatile("" ::: "memory"); }
                  __syncthreads();
                  { const int c = tid; float run = 0.f;
#pragma unroll 4
                    for (int tt = 0; tt < GCH; ++tt) { run += la[tt * GKD + c]; GB[(size_t)(ch * GCH + tt) * GKD + c] = run; } }
                  __syncthreads();
              } }
#endif
        }
        else if (ph == PH_GLA1 || ph == PH_GLA2 || ph == PH_GLA3) {
#if GLA_SIMPLE
            if (ph == PH_GLA3) gla_simple_phase(F.lds + RING_OFF, F.vcu, (const bf16*)(ws + WS_GQ), (const bf16*)(ws + WS_GK), (const bf16*)(ws + WS_GV), (const bf16*)(ws + WS_GG), (const float*)(ws + WS_GB), INP(9), XB);
#else
            const gla::Tensors T{(const bf16*)(ws + WS_GQ), (const bf16*)(ws + WS_GK), (const bf16*)(ws + WS_GV), (const bf16*)(ws + WS_GG), (const float*)(ws + WS_GB), INP(9), (float*)(ws + WS_GS), (float*)(ws + WS_GD), XB};
            if (ph == PH_GLA1) gla::gla1_phase(F.lds + RING_OFF, F.vcu, T);
            else if (ph == PH_GLA2) gla::gla2_phase(F.vcu, F.G, T);
            else gla::gla3_phase(F.lds + RING_OFF, F.vcu, T);
#endif
        }
        else if (ph == PH_FIN) {
            int tid = threadIdx.x; asm volatile("" : "+v"(tid)); const int lane = tid & 63;
            const float* final_w = INP(3);
            for (int m = gw; m < MTOK; m += NGW) { GAS f32x4* xr = (GAS f32x4*)(xres + (size_t)m * DM) + lane; f32x4 v[4]; float s = 0.f;
#pragma unroll
                for (int j = 0; j < 4; ++j) { v[j] = xr[64 * j]; s += (v[j].x * v[j].x + v[j].y * v[j].y) + (v[j].z * v[j].z + v[j].w * v[j].w); }
                const float rstd = 1.0f / sqrtf(wave_sum(s) * (1.0f / DM) + EPS);
#pragma unroll
                for (int j = 0; j < 4; ++j) { const f32x4 w = *((const f32x4*)final_w + lane + 64 * j); xr[64 * j] = v[j] * rstd * w; } }
        }
      }
      if (ph + 1 < args.ph_hi) xcd_barrier(bar);
    }
}

__global__ void __launch_bounds__(256) naive_attn(const bf16* __restrict__ Q, const bf16* __restrict__ K, const bf16* __restrict__ V, bf16* OM, float* LSE, int g, int ldil) {
    __shared__ float qs[4][128];
    const int lane = threadIdx.x & 63, wv = threadIdx.x >> 6;
    const int item = blockIdx.x * 4 + wv, row = item >> 3, h = item & 7;
    const int b = row >> 13, t = row & (SEQ - 1), r = t & ((1 << ldil) - 1), i = t >> ldil, L = SEQ >> ldil;
    const size_t base = (size_t)((((b * AH + h) << ldil) + r)) * L;
    const bf16* Qr = Q + (base + i) * HD; const bf16* Ks = K + base * HD; const bf16* Vs = V + base * HD;
    qs[wv][lane] = h2f(Qr[lane]); qs[wv][lane + 64] = h2f(Qr[lane + 64]);
    __syncthreads();
    float sc[3];
#pragma unroll
    for (int sl = 0; sl < 3; ++sl) { const int jj = lane + 64 * sl; float s = -INFINITY;
        if (jj <= 128 && i - jj >= 0) { const v4u* kp = (const v4u*)(Ks + (size_t)(i - jj) * HD); s = 0.f;
            for (int c = 0; c < 16; ++c) { const v4u kv = kp[c];
#pragma unroll
                for (int e = 0; e < 4; ++e) s += qs[wv][8 * c + 2 * e] * hlo(kv[e]) + qs[wv][8 * c + 2 * e + 1] * hhi(kv[e]); }
            s *= 0.08838834764831845f; }
        sc[sl] = s; }
    float m = fmaxf(fmaxf(sc[0], sc[1]), sc[2]);
#pragma unroll
    for (int o = 1; o < 64; o <<= 1) m = fmaxf(m, __shfl_xor(m, o));
    float p[3], l = 0.f;
#pragma unroll
    for (int sl = 0; sl < 3; ++sl) { p[sl] = expf(sc[sl] - m); l += p[sl]; }
    l = wave_sum(l);
    float o0 = 0.f, o1 = 0.f;
#pragma unroll
    for (int sl = 0; sl < 3; ++sl)
        for (int ll = 0; ll < 64; ++ll) { const int jj = sl * 64 + ll; if (jj > 128 || i - jj < 0) break;
            const float pj = __shfl(p[sl], ll); const unsigned vv = ((const unsigned*)(Vs + (size_t)(i - jj) * HD))[lane];
            o0 += pj * hlo(vv); o1 += pj * hhi(vv); }
    o0 /= l; o1 /= l; float lse = m + logf(l);
    unsigned* op = (unsigned*)(OM + (size_t)row * DM + h * HD) + lane;
    if (g > 0) { const float lo = LSE[(size_t)row * 8 + h]; const unsigned ov = *op; const float mx = fmaxf(lo, lse), wo = expf(lo - mx), wn = expf(lse - mx), inv = 1.0f / (wo + wn);
        o0 = (wo * hlo(ov) + wn * o0) * inv; o1 = (wo * hhi(ov) + wn * o1) * inv; lse = mx + logf(wo + wn); }
    *op = pkh(o0, o1);
    if (lane == 0) LSE[(size_t)row * 8 + h] = lse;
}
__global__ void __launch_bounds__(1024) naive_gla(const bf16* __restrict__ q, const bf16* __restrict__ k, const bf16* __restrict__ v, const bf16* __restrict__ g, const float* __restrict__ Bc,
                                                    const float* __restrict__ normw, bf16* GO) {
    __shared__ float red[2][16];
    __shared__ __attribute__((aligned(16))) float as_[2][128], ks_[2][128], qs_[2][128];
    const int tid = threadIdx.x, vloc = tid >> 2, qt = tid & 3, wv = tid >> 6, lane = tid & 63;
    const int b = blockIdx.x >> 2, h = blockIdx.x & 3;
    float S[32];
#pragma unroll
    for (int j = 0; j < 32; ++j) S[j] = 0.f;
    const float nw = normw[vloc];
    for (int t = 0; t < SEQ; ++t) { const size_t row = (size_t)b * SEQ + t; const int bf = t & 1;
        if (tid < 128) { const float* bp = Bc + row * GKD + h * GDK + tid; const float la = bp[0] - ((t & 63) ? bp[-GKD] : 0.f);
            as_[bf][tid] = expf(la); ks_[bf][tid] = bf2f(k[row * GKD + h * GDK + tid]); qs_[bf][tid] = bf2f(q[row * GKD + h * GDK + tid]) * 0.08838834764831845f; }
        const float vv = bf2f(v[row * GVD + h * GDV + vloc]);
        __syncthreads();
        float o = 0.f;
#pragma unroll
        for (int c = 0; c < 8; ++c) { const f32x4 a4 = *(const f32x4*)&as_[bf][qt * 32 + 4 * c], k4 = *(const f32x4*)&ks_[bf][qt * 32 + 4 * c], q4 = *(const f32x4*)&qs_[bf][qt * 32 + 4 * c];
#pragma unroll
            for (int e = 0; e < 4; ++e) { const int j = 4 * c + e; S[j] = a4[e] * S[j] + k4[e] * vv; o += q4[e] * S[j]; } }
        o += __shfl_xor(o, 1); o += __shfl_xor(o, 2);
        float sq = qt == 0 ? o * o : 0.f; sq = wave_sum(sq);
        if (lane == 0) red[bf][wv] = sq;
        __syncthreads();
        float tot = 0.f;
#pragma unroll
        for (int w = 0; w < 16; ++w) tot += red[bf][w];
        const float rstd = 1.0f / sqrtf(tot * (1.0f / GDV) + EPS);
        if (qt == 0) { const float gg = bf2f(g[row * GVD + h * GDV + vloc]); const float y = o * rstd * nw * (gg / (1.0f + expf(-gg))); GO[row * GVD + h * GDV + vloc] = __builtin_bit_cast(unsigned short, (_Float16)y); }
    }
}


__global__ void __launch_bounds__(256) probe_maxdiff_h(const unsigned short* a, const unsigned short* b, size_t n, unsigned* slot) {
    float m = 0.f;
    for (size_t i = (size_t)blockIdx.x * 256 + threadIdx.x; i < n; i += (size_t)gridDim.x * 256) { const float d = fabsf(h2f(a[i]) - h2f(b[i])); m = (d > m || d != d) ? (d != d ? 1e30f : d) : m; }
#pragma unroll
    for (int o = 1; o < 64; o <<= 1) m = fmaxf(m, __shfl_xor(m, o));
    if ((threadIdx.x & 63) == 0) atomicMax(slot, __float_as_uint(m));
}
__global__ void __launch_bounds__(256) probe_maxdiff_f(const float* a, const float* b, size_t n, unsigned* slot) {
    float m = 0.f;
    for (size_t i = (size_t)blockIdx.x * 256 + threadIdx.x; i < n; i += (size_t)gridDim.x * 256) { const float d = fabsf(a[i] - b[i]); m = (d > m || d != d) ? (d != d ? 1e30f : d) : m; }
#pragma unroll
    for (int o = 1; o < 64; o <<= 1) m = fmaxf(m, __shfl_xor(m, o));
    if ((threadIdx.x & 63) == 0) atomicMax(slot, __float_as_uint(m));
}
__global__ void __launch_bounds__(256) probe_encode(float* out, size_t n, const unsigned* slot, float scale) {
    const float d = sqrtf(scale * __uint_as_float(*slot));
    for (size_t i = (size_t)blockIdx.x * 256 + threadIdx.x; i < n; i += (size_t)gridDim.x * 256) out[i] += d;
}

#ifndef MK_MODE
#define MK_MODE 2
#endif
extern "C" void kernel_launch(void* const* d_in, const int* in_sizes, int n_in, void* d_out, int out_size, void* d_ws, size_t ws_size, hipStream_t stream) {
    static int grid = 0;
    if (grid == 0) {
        if (n_in != 13 || in_sizes[0] != MTOK * DM || out_size != MTOK * DM || ws_size < WS_END) { fprintf(stderr, "kernel_launch: unexpected shapes (n_in %d, in0 %d, out %d, ws %zu); nothing launched\n", n_in, n_in > 0 ? in_sizes[0] : -1, out_size, ws_size); grid = -1; return; }
        int dev = 0, cus = 0;
        if (hipGetDevice(&dev) != hipSuccess || hipDeviceGetAttribute(&cus, hipDeviceAttributeMultiprocessorCount, dev) != hipSuccess) { grid = -1; return; }
        if (hipFuncSetAttribute((const void*)mega_fwd, hipFuncAttributeMaxDynamicSharedMemorySize, LDS_BYTES) != hipSuccess) { fprintf(stderr, "kernel_launch: hipFuncSetAttribute failed\n"); grid = -1; return; }
        (void)hipGetLastError();
        grid = cus;
        if (grid != 256) fprintf(stderr, "kernel_launch: %d CUs (built for 256)\n", grid);
    }
    if (grid < 0) return;
    unsigned char* ws = (unsigned char*)d_ws;
    (void)hipMemsetAsync(ws + WS_CTL, 0, CTL_ZERO_BYTES, stream);
    Args a{};
    for (int i = 0; i < 13; ++i) a.in[i] = (const float*)d_in[i];
    a.out = (float*)d_out; a.ws = ws;
#define MEGA(lo, hi, li_) do { a.ph_lo = (lo); a.ph_hi = (hi); a.li = (li_); hipLaunchKernelGGL(mega_fwd, dim3(grid), dim3(NWAVES * 64), LDS_BYTES, stream, a); } while (0)
#if MK_MODE == 0 || MK_MODE == 1
    a.skip_mask = 0;
    MEGA(PH_PRO, PH_PRO + 1, 0);
    for (int g = 0; g < NGRP; ++g) { MEGA(PH_QKV0 + 2 * g, PH_QKV0 + 2 * g + 1, 0);
#if MK_MODE == 0
        hipLaunchKernelGGL(naive_attn, dim3(MTOK * AH / 4), dim3(256), 0, stream, (const bf16*)(ws + WS_Q), (const bf16*)(ws + WS_K), (const bf16*)(ws + WS_V), (bf16*)(ws + WS_OM), (float*)(ws + WS_LSE), g, grp_ldil(g));
#else
        MEGA(PH_ATT0 + 2 * g, PH_ATT0 + 2 * g + 1, 0);
#endif
    }
    MEGA(PH_WO0, PH_WO0 + 1, 0); MEGA(PH_UP0, PH_UP0 + 1, 0); MEGA(PH_DN0, PH_DN0 + 1, 0); MEGA(PH_GLAP, PH_GLAP + 1, 0);
    hipLaunchKernelGGL(naive_gla, dim3(BATCH * GH), dim3(1024), 0, stream, (const bf16*)(ws + WS_GQ), (const bf16*)(ws + WS_GK), (const bf16*)(ws + WS_GV), (const bf16*)(ws + WS_GG), (const float*)(ws + WS_GB),
                       (const float*)d_in[9], (bf16*)(ws + WS_XB));
    MEGA(PH_WO1, PH_WO1 + 1, 0); MEGA(PH_UP1, PH_UP1 + 1, 0); MEGA(PH_DN1, PH_DN1 + 1, 0); MEGA(PH_FIN, PH_FIN + 1, 0);
#elif MK_MODE == 3
    a.skip_mask = 0;
    unsigned* slot = (unsigned*)(ws + WS_CTL) + 2048; unsigned* slot2 = slot + 64;
    unsigned short* OM2 = (unsigned short*)d_out; float* LSE2 = (float*)((char*)d_out + 48 * MiB);
    MEGA(PH_PRO, PH_PRO + 1, 0);
    for (int g = 0; g < NGRP; ++g) { MEGA(PH_QKV0 + 2 * g, PH_QKV0 + 2 * g + 1, 0);
        hipLaunchKernelGGL(naive_attn, dim3(MTOK * AH / 4), dim3(256), 0, stream, (const bf16*)(ws + WS_Q), (const bf16*)(ws + WS_K), (const bf16*)(ws + WS_V), (bf16*)OM2, LSE2, g, grp_ldil(g));
        MEGA(PH_ATT0 + 2 * g, PH_ATT0 + 2 * g + 1, 0); }
    hipLaunchKernelGGL(probe_maxdiff_h, dim3(2048), dim3(256), 0, stream, (const unsigned short*)(ws + WS_OM), (const unsigned short*)OM2, (size_t)MTOK * DM, slot);
    hipLaunchKernelGGL(probe_maxdiff_f, dim3(256), dim3(256), 0, stream, (const float*)(ws + WS_LSE), (const float*)LSE2, (size_t)MTOK * 8, slot2);
    MEGA(PH_WO0, PH_WO0 + 1, 0); MEGA(PH_UP0, PH_UP0 + 1, 0); MEGA(PH_DN0, PH_DN0 + 1, 0); MEGA(PH_GLAP, PH_GLAP + 1, 0);
    hipLaunchKernelGGL(naive_gla, dim3(BATCH * GH), dim3(1024), 0, stream, (const bf16*)(ws + WS_GQ), (const bf16*)(ws + WS_GK), (const bf16*)(ws + WS_GV), (const bf16*)(ws + WS_GG), (const float*)(ws + WS_GB),
                       (const float*)d_in[9], (bf16*)(ws + WS_XB));
    MEGA(PH_WO1, PH_WO1 + 1, 0); MEGA(PH_UP1, PH_UP1 + 1, 0); MEGA(PH_DN1, PH_DN1 + 1, 0); MEGA(PH_FIN, PH_FIN + 1, 0);
    hipLaunchKernelGGL(probe_encode, dim3(2048), dim3(256), 0, stream, (float*)d_out, (size_t)MTOK * DM, slot, 1.0f);
    hipLaunchKernelGGL(probe_encode, dim3(2048), dim3(256), 0, stream, (float*)d_out, (size_t)MTOK * DM, slot2, 1e-3f);
#elif MK_MODE == 4
    a.skip_mask = 0;
    unsigned* slot = (unsigned*)(ws + WS_CTL) + 2048;
    for (int p = PH_PRO; p <= PH_GLA3; ++p) MEGA(p, p + 1, 0);
    hipLaunchKernelGGL(naive_gla, dim3(BATCH * GH), dim3(1024), 0, stream, (const bf16*)(ws + WS_GQ), (const bf16*)(ws + WS_GK), (const bf16*)(ws + WS_GV), (const bf16*)(ws + WS_GG), (const float*)(ws + WS_GB),
                       (const float*)d_in[9], (bf16*)(ws + WS_GS));
    hipLaunchKernelGGL(probe_maxdiff_h, dim3(2048), dim3(256), 0, stream, (const unsigned short*)(ws + WS_XB), (const unsigned short*)(ws + WS_GS), (size_t)MTOK * DM, slot);
    MEGA(PH_WO1, PH_WO1 + 1, 0); MEGA(PH_UP1, PH_UP1 + 1, 0); MEGA(PH_DN1, PH_DN1 + 1, 0); MEGA(PH_FIN, PH_FIN + 1, 0);
    hipLaunchKernelGGL(probe_encode, dim3(2048), dim3(256), 0, stream, (float*)d_out, (size_t)MTOK * DM, slot, 1e-2f);
#else
    a.skip_mask = 0;
    MEGA(0, PH_N, 0);
#endif
#undef MEGA
}
```

```cpp
#include <hip/hip_runtime.h>
#include <cstdio>
#include <cstdint>
#include <cmath>
#include <hip/hip_runtime.h>
#include <cstdio>
#include <cstdint>
namespace pg8 {
#define PG8_LAS __attribute__((address_space(3)))
typedef unsigned short bf16_t;
typedef short bf16x8 __attribute__((ext_vector_type(8)));
typedef _Float16 f16x8 __attribute__((ext_vector_type(8)));
typedef float f32x4 __attribute__((ext_vector_type(4)));
typedef unsigned u32x4 __attribute__((ext_vector_type(4)));
constexpr int BM = 256, BK = 64, HALF = 128, HTB = HALF * BK * 2  , STAGE_BYTES = 8 * HTB, NXCD = 8, WGM = 8;

__host__ __device__ __forceinline__ int lds_byte(int r, int c) { const int st = (r >> 4) * 2 + (c >> 5), rr = r & 15, cc = c & 31, ob = rr * 64 + cc * 2; return st * 1024 + (ob ^ (((ob >> 9) & 1) << 5)); }
__host__ __device__ __forceinline__ void stage_rc(int b, int& R, int& C) { const int st = b / 1024, sb = b % 1024, swz = sb ^ (((sb >> 9) & 1) << 5); R = (st >> 1) * 16 + swz / 64; C = (st & 1) * 32 + (swz % 64) / 2; }
__host__ __device__ __forceinline__ int perm32(int rho) { const int n = rho >> 4, i = rho & 15; return 8 * (i >> 2) + 4 * n + (i & 3); }

struct Unit { int pm, pn; };
struct Gemm { const bf16_t* A; const bf16_t* Bt; int M, N, K; };

struct StaticOrder {
    int nM, nN, nwg, G, c;
    __host__ __device__ void init(int M, int N, int G_, int c_) { nM = M / BM; nN = N / BM; nwg = nM * nN; G = G_; c = c_; }
    __host__ __device__ bool next(int i, Unit& u) const {
        const long L = (long)i * G + c; if (L >= nwg) return false;
        int wgid = (int)L; { const int q = nwg / NXCD, r = nwg % NXCD, xcd = wgid % NXCD, off = wgid / NXCD; wgid = (xcd < r ? xcd * (q + 1) : r * (q + 1) + (xcd - r) * q) + off; }
        const int nig = WGM * nN, gid = wgid / nig, fm = gid * WGM, gsz = (nM - fm) < WGM ? (nM - fm) : WGM;
        u.pm = fm + ((wgid % nig) % gsz); u.pn = (wgid % nig) / gsz; return true;
    }
    __device__ __forceinline__ void a_ready(const Unit&) const {}
    __device__ __forceinline__ void done(const Unit&) const {}
};

typedef __bf16 bf16x2_t __attribute__((ext_vector_type(2))); typedef float f32x2_t __attribute__((ext_vector_type(2)));
__device__ __forceinline__ unsigned cvt_pk_bf16(float lo, float hi) { const f32x2_t v = {lo, hi}; return __builtin_bit_cast(unsigned, __builtin_convertvector(v, bf16x2_t)); }
typedef unsigned u32x2 __attribute__((ext_vector_type(2)));
typedef _Float16 h16x2 __attribute__((ext_vector_type(2)));
typedef float f32x2 __attribute__((ext_vector_type(2)));
__device__ __forceinline__ unsigned cvt_pk_h(float lo, float hi) { const f32x2 v = {lo, hi}; return __builtin_bit_cast(unsigned, __builtin_convertvector(v, h16x2)); }
constexpr int P_SEQ = 8192, P_DM = 1024, P_DFF = 4096, P_AH = 8, P_HD = 128;
constexpr int RSTD_LDS_OFF = 131072 + 512;
struct PlainOrder : StaticOrder { __device__ __forceinline__ void a_ready(const Unit&, int) const {} };
struct RstdOrder : StaticOrder {
    const float* ssq; PG8_LAS float* rl;
    __device__ __forceinline__ void a_ready(const Unit& u, int ui) const {
        int t = threadIdx.x; asm volatile("" : "+v"(t));
        const int row = t >> 1, hf = t & 1;
        const f32x4* p = (const f32x4*)(ssq + (size_t)(u.pm * BM + row) * 16 + hf * 8); const f32x4 a = p[0], b = p[1];
        float s = ((a[0] + a[1]) + (a[2] + a[3])) + ((b[0] + b[1]) + (b[2] + b[3])); s += __shfl_xor(s, 1);
        if (hf == 0) rl[(ui & 1) * 256 + row] = 1.0f / sqrtf(s * (1.0f / 1024.0f) + 1e-5f);
    }
};
__device__ __forceinline__ void row_rstd(const PG8_LAS float* rl, int ui, int wr, int fr, float (&rs)[2][4]) {
#pragma unroll
    for (int ai = 0; ai < 2; ++ai)
#pragma unroll
        for (int m = 0; m < 4; ++m) rs[ai][m] = rl[(ui & 1) * 256 + ai * HALF + wr * 64 + m * 16 + fr];
}
__device__ __forceinline__ u32x4 pack8h(const f32x4 a, const f32x4 b) { u32x4 w; w.x = cvt_pk_h(a[0], a[1]); w.y = cvt_pk_h(a[2], a[3]); w.z = cvt_pk_h(b[0], b[1]); w.w = cvt_pk_h(b[2], b[3]); return w; }
__device__ __forceinline__ u32x4 pack8(const f32x4 a, const f32x4 b) { u32x4 w; w.x = cvt_pk_bf16(a[0], a[1]); w.y = cvt_pk_bf16(a[2], a[3]); w.z = cvt_pk_bf16(b[0], b[1]); w.w = cvt_pk_bf16(b[2], b[3]); return w; }

struct EpiQKV {
    static constexpr bool PERM = true, AFTER_DRAIN = false;
    bf16_t* Q; bf16_t* K; bf16_t* V; const PG8_LAS float* rl; const float* cosT; const float* sinT; int ldil;
    __device__ __forceinline__ void operator()(const f32x4 (&acc)[2][2][4][2], const Unit& u, int wr, int wc, int fr, int fq, int ui) const {
        const int row0 = u.pm * BM + wr * 64 + fr;
        float rs[2][4]; row_rstd(rl, ui, wr, fr, rs);
        const int which = u.pn >> 2, hp = u.pn & 3, dmask = (1 << ldil) - 1, L = P_SEQ >> ldil;
        if (which < 2) {
            bf16_t* dst = which == 0 ? Q : K;
            const int head = 2 * hp + (wc >> 1), d0 = 32 * (wc & 1) + 8 * fq;
#pragma unroll
            for (int ai = 0; ai < 2; ++ai)
#pragma unroll
                for (int m = 0; m < 4; ++m) { const int row = row0 + ai * HALF + m * 16, b = row >> 13, t = row & (P_SEQ - 1), r = t & dmask, i = t >> ldil;
                    bf16_t* p = dst + ((size_t)((((b * P_AH + head) << ldil) + r)) * L + i) * P_HD + d0;
                    const float* ct = cosT + t * 64 + d0; const float* st = sinT + t * 64 + d0;
                    const f32x4 c0 = *(const f32x4*)ct, c1 = *(const f32x4*)(ct + 4), s0 = *(const f32x4*)st, s1 = *(const f32x4*)(st + 4);
                    const float sc = rs[ai][m];
                    const f32x4 x1a = acc[ai][0][m][0] * sc, x1b = acc[ai][0][m][1] * sc, x2a = acc[ai][1][m][0] * sc, x2b = acc[ai][1][m][1] * sc;
                    const f32x4 o1a = x1a * c0 - x2a * s0, o1b = x1b * c1 - x2b * s1, o2a = x2a * c0 + x1a * s0, o2b = x2b * c1 + x1b * s1;
                    *(u32x4*)p = pack8h(o1a, o1b); *(u32x4*)(p + 64) = pack8h(o2a, o2b);
                    if (m & 1) asm volatile("" ::: "memory"); }
        } else {
            const int dd = 32 * wc + 8 * fq;
#pragma unroll
            for (int ai = 0; ai < 2; ++ai)
#pragma unroll
                for (int m = 0; m < 4; ++m) { const int row = row0 + ai * HALF + m * 16, b = row >> 13, t = row & (P_SEQ - 1), r = t & dmask, i = t >> ldil;
                    const float sc = rs[ai][m];
#pragma unroll
                    for (int bj = 0; bj < 2; ++bj) { const int head = 2 * hp + bj;
                        bf16_t* p = V + ((size_t)((((b * P_AH + head) << ldil) + r)) * L + i) * P_HD + dd;
                        *(u32x4*)p = pack8h(acc[ai][bj][m][0] * sc, acc[ai][bj][m][1] * sc); } }
        }
    }
};
struct EpiResid {
    static constexpr bool PERM = false, AFTER_DRAIN = false;
    const float* resid; float* out; bf16_t* xb; float* ssq;
    __device__ __forceinline__ void operator()(const f32x4 (&acc)[2][2][4][2], const Unit& u, int wr, int wc, int fr, int fq, int ui) const {
        const int row0 = u.pm * BM + wr * 64 + fr, col0 = u.pn * BM + wc * 32 + 4 * fq;
#pragma unroll
        for (int ai = 0; ai < 2; ++ai)
#pragma unroll
            for (int m = 0; m < 4; ++m) { const int row = row0 + ai * HALF + m * 16; const size_t off = (size_t)row * P_DM + col0; float s = 0.f;
#pragma unroll
                for (int bj = 0; bj < 2; ++bj)
#pragma unroll
                    for (int n = 0; n < 2; ++n) { const f32x4 v = acc[ai][bj][m][n] + *(const f32x4*)(resid + off + bj * HALF + n * 16);
                        *(f32x4*)(out + off + bj * HALF + n * 16) = v; s += (v[0] * v[0] + v[1] * v[1]) + (v[2] * v[2] + v[3] * v[3]);
                        u32x2 w; w.x = cvt_pk_h(v[0], v[1]); w.y = cvt_pk_h(v[2], v[3]); *(u32x2*)(xb + off + bj * HALF + n * 16) = w; }
                s += __shfl_xor(s, 16); s += __shfl_xor(s, 32);
                if (fq == 0) ssq[(size_t)row * 16 + u.pn * 4 + wc] = s;
                asm volatile("" ::: "memory"); }
    }
};
struct EpiUp {
    static constexpr bool PERM = true, AFTER_DRAIN = false;
    bf16_t* H; const PG8_LAS float* rl;
    __device__ __forceinline__ void operator()(const f32x4 (&acc)[2][2][4][2], const Unit& u, int wr, int wc, int fr, int fq, int ui) const {
        const int row0 = u.pm * BM + wr * 64 + fr, col0 = u.pn * BM + wc * 32 + 8 * fq;
        float rs[2][4]; row_rstd(rl, ui, wr, fr, rs);
#pragma unroll
        for (int ai = 0; ai < 2; ++ai)
#pragma unroll
            for (int m = 0; m < 4; ++m) { bf16_t* rowp = H + (size_t)(row0 + ai * HALF + m * 16) * P_DFF + col0; const float sc = rs[ai][m];
#pragma unroll
                for (int bj = 0; bj < 2; ++bj) { f32x4 v0 = acc[ai][bj][m][0] * sc, v1 = acc[ai][bj][m][1] * sc;
                    v0 = __builtin_elementwise_max(v0, (f32x4){0.f, 0.f, 0.f, 0.f}); v1 = __builtin_elementwise_max(v1, (f32x4){0.f, 0.f, 0.f, 0.f});
                    const f32x4 cap = {65504.f, 65504.f, 65504.f, 65504.f};
                    *(u32x4*)(rowp + bj * HALF) = pack8h(__builtin_elementwise_min(v0 * v0, cap), __builtin_elementwise_min(v1 * v1, cap)); } }
    }
};
struct EpiGla {
    static constexpr bool PERM = true, AFTER_DRAIN = false;
    bf16_t* q; bf16_t* k; bf16_t* v; bf16_t* g; const PG8_LAS float* rl;
    __device__ __forceinline__ void operator()(const f32x4 (&acc)[2][2][4][2], const Unit& u, int wr, int wc, int fr, int fq, int ui) const {
        const int row0 = u.pm * BM + wr * 64 + fr;
        float rs[2][4]; row_rstd(rl, ui, wr, fr, rs);
        bf16_t* dst; int ld, coff;
        if (u.pn < 2) { dst = q; ld = 512; coff = u.pn * 256; } else if (u.pn < 4) { dst = k; ld = 512; coff = (u.pn - 2) * 256; }
        else if (u.pn < 8) { dst = v; ld = 1024; coff = (u.pn - 4) * 256; } else { dst = g; ld = 1024; coff = (u.pn - 8) * 256; }
        const int col0 = coff + wc * 32 + 8 * fq;
#pragma unroll
        for (int ai = 0; ai < 2; ++ai)
#pragma unroll
            for (int m = 0; m < 4; ++m) { bf16_t* rowp = dst + (size_t)(row0 + ai * HALF + m * 16) * ld + col0; const float sc = rs[ai][m];
#pragma unroll
                for (int bj = 0; bj < 2; ++bj) *(u32x4*)(rowp + bj * HALF) = pack8(acc[ai][bj][m][0] * sc, acc[ai][bj][m][1] * sc); }
    }
};
template <class Epi, class Sched, bool ALIGN_EPI = false, bool SP2 = false>
__device__ __forceinline__ void gemm_phase(PG8_LAS unsigned char* lds, const Gemm g, const Sched& S, const Epi& E) {
    int tid_ = threadIdx.x; asm volatile("" : "+v"(tid_));
    const int tid = tid_, wid = __builtin_amdgcn_readfirstlane(tid >> 6), lane = tid & 63, wr = wid >> 2, wc = wid & 3, fr = lane & 15, fq = lane >> 4;
    const int K = g.K, nt = K / BK;
    unsigned voffA[2], voffB[2];
#pragma unroll
    for (int i = 0; i < 2; ++i) { int R, C; stage_rc(tid * 16 + i * 8192, R, C); const int Rb = Epi::PERM ? ((R & ~31) + perm32(R & 31)) : R;
        voffA[i] = (unsigned)(R * K + C) * 2u; voffB[i] = (unsigned)(Rb * K + C) * 2u; }
    const size_t kstep = (size_t)(BK * 2);
    const size_t hstep = (size_t)HALF * K * 2;
    const size_t tstep = 2 * hstep;
    const unsigned ldsw = (unsigned)wid * 1024u;
    const int aoff = lds_byte(wr * 64 + fr, fq * 8), boff = lds_byte(wc * 32 + fr, fq * 8);
#define PG8_SA(b, h) (((b) * 2 + (h)) * HTB)
#define PG8_SB(b, h) ((4 + (b) * 2 + (h)) * HTB)
#define PG8_STAGE(bufoff, gbase, voff) do { _Pragma("unroll") for (int _i = 0; _i < 2; ++_i) \
        __builtin_amdgcn_global_load_lds((const unsigned*)((const char*)(gbase) + (voff)[_i]), (PG8_LAS unsigned*)(lds + (bufoff) + ldsw + _i * 8192), 16, 0, 0); } while (0)
#define PG8_LDA(dst, b, h) do { _Pragma("unroll") for (int m = 0; m < 4; ++m) _Pragma("unroll") for (int k = 0; k < 2; ++k) dst[m][k] = *(const PG8_LAS bf16x8*)(lds + PG8_SA(b, h) + aoff + m * 2048 + k * 1024); } while (0)
#define PG8_LDB(dst, b, h) do { _Pragma("unroll") for (int n = 0; n < 2; ++n) _Pragma("unroll") for (int k = 0; k < 2; ++k) dst[n][k] = *(const PG8_LAS bf16x8*)(lds + PG8_SB(b, h) + boff + n * 2048 + k * 1024); } while (0)
#define PG8_MMA(ai, bj, At, Bt) do { __builtin_amdgcn_s_setprio(1); _Pragma("unroll") for (int m = 0; m < 4; ++m) _Pragma("unroll") for (int n = 0; n < 2; ++n) _Pragma("unroll") for (int k = 0; k < 2; ++k) \
        acc[ai][bj][m][n] = __builtin_amdgcn_mfma_f32_16x16x32_f16(__builtin_bit_cast(f16x8, Bt[n][k]), __builtin_bit_cast(f16x8, At[m][k]), acc[ai][bj][m][n], 0, 0, 0); __builtin_amdgcn_s_setprio(0); } while (0)
#define PG8_WAIT_V(n) asm volatile("s_waitcnt vmcnt(" #n ")" ::: "memory")
#define PG8_WAIT_L(n) asm volatile("s_waitcnt lgkmcnt(" #n ")" ::: "memory")
#define PG8_BAR __builtin_amdgcn_s_barrier()
#define PG8_SCHED __builtin_amdgcn_sched_barrier(0)
    Unit cur, nxt; int ui = 0;
    if (!S.next(0, cur)) return;
    f32x4 acc[2][2][4][2];
#pragma unroll
    for (int a = 0; a < 2; ++a)
#pragma unroll
        for (int b = 0; b < 2; ++b)
#pragma unroll
            for (int m = 0; m < 4; ++m)
#pragma unroll
                for (int n = 0; n < 2; ++n) acc[a][b][m][n] = (f32x4){0.f, 0.f, 0.f, 0.f};
    bf16x8 At[4][2], B0[2][2], B1[2][2];
    const char* cA = (const char*)g.A + (size_t)cur.pm * tstep; const char* cB = (const char*)g.Bt + (size_t)cur.pn * tstep;
    S.a_ready(cur, 0);
    if constexpr (SP2) {
        PG8_STAGE(PG8_SB(0, 0), cB, voffB); PG8_STAGE(PG8_SB(0, 1), cB + hstep, voffB); PG8_STAGE(PG8_SA(0, 0), cA, voffA); PG8_STAGE(PG8_SA(0, 1), cA + hstep, voffA);
        if (wr == 1) PG8_BAR;
        PG8_WAIT_V(2); PG8_BAR;
        PG8_STAGE(PG8_SB(1, 0), cB + kstep, voffB); PG8_STAGE(PG8_SA(1, 0), cA + kstep, voffA); PG8_STAGE(PG8_SB(1, 1), cB + hstep + kstep, voffB);
        PG8_WAIT_V(6); PG8_BAR;
    } else {
        PG8_STAGE(PG8_SB(0, 0), cB, voffB); PG8_STAGE(PG8_SA(0, 0), cA, voffA); PG8_STAGE(PG8_SB(0, 1), cB + hstep, voffB); PG8_STAGE(PG8_SA(0, 1), cA + hstep, voffA);
        if (wr == 1) PG8_BAR;
        PG8_WAIT_V(4); PG8_BAR;
        PG8_STAGE(PG8_SB(1, 0), cB + kstep, voffB); PG8_STAGE(PG8_SA(1, 0), cA + kstep, voffA); PG8_STAGE(PG8_SB(1, 1), cB + hstep + kstep, voffB);
        PG8_WAIT_V(6); PG8_BAR;
    }
    for (;;) {
        const bool has_next = S.next(ui + 1, nxt);
        const char* nA = has_next ? (const char*)g.A + (size_t)nxt.pm * tstep : cA; const char* nB = has_next ? (const char*)g.Bt + (size_t)nxt.pn * tstep : cB;
        for (int t = 0; t < nt; t += 2) {
            const bool last = (t == nt - 2);
            const char* a1 = cA + (size_t)(t + 1) * kstep;
            const char* a2 = last ? nA : cA + (size_t)(t + 2) * kstep; const char* b2 = last ? nB : cB + (size_t)(t + 2) * kstep;
            const char* a3 = a2 + kstep; const char* b3 = b2 + kstep;
            if (last && has_next) S.a_ready(nxt, ui + 1);
            if constexpr (SP2) {
            PG8_LDB(B0, 0, 0); PG8_LDB(B1, 0, 1); PG8_SCHED; PG8_LDA(At, 0, 0); PG8_STAGE(PG8_SA(1, 1), a1 + hstep, voffA);
            PG8_WAIT_V(8); PG8_WAIT_L(0); PG8_BAR; PG8_MMA(0, 0, At, B0); PG8_MMA(0, 1, At, B1); PG8_BAR; PG8_SCHED;
            PG8_LDA(At, 0, 1); PG8_STAGE(PG8_SB(0, 0), b2, voffB); PG8_STAGE(PG8_SB(0, 1), b2 + hstep, voffB); PG8_STAGE(PG8_SA(0, 0), a2, voffA);
            PG8_WAIT_V(8); PG8_WAIT_L(0); PG8_BAR; PG8_MMA(1, 0, At, B0); PG8_MMA(1, 1, At, B1); PG8_BAR; PG8_SCHED;
            PG8_LDB(B0, 1, 0); PG8_LDB(B1, 1, 1); PG8_SCHED; PG8_LDA(At, 1, 0); PG8_STAGE(PG8_SA(0, 1), a2 + hstep, voffA);
            PG8_WAIT_V(8); PG8_WAIT_L(0); PG8_BAR; PG8_MMA(0, 0, At, B0); PG8_MMA(0, 1, At, B1); PG8_BAR; PG8_SCHED;
            PG8_LDA(At, 1, 1); PG8_STAGE(PG8_SB(1, 0), b3, voffB); PG8_STAGE(PG8_SB(1, 1), b3 + hstep, voffB); PG8_STAGE(PG8_SA(1, 0), a3, voffA);
            PG8_WAIT_V(8); PG8_WAIT_L(0); PG8_BAR; PG8_MMA(1, 0, At, B0); PG8_MMA(1, 1, At, B1); PG8_BAR; PG8_SCHED;
            } else {
            PG8_LDB(B0, 0, 0); PG8_SCHED; PG8_LDA(At, 0, 0); PG8_STAGE(PG8_SA(1, 1), a1 + hstep, voffA);
            PG8_WAIT_L(8); PG8_BAR; PG8_WAIT_L(0); PG8_MMA(0, 0, At, B0); PG8_BAR; PG8_SCHED;
            PG8_LDB(B1, 0, 1); PG8_STAGE(PG8_SB(0, 0), b2, voffB);
            PG8_BAR; PG8_WAIT_L(0); PG8_MMA(0, 1, At, B1); PG8_BAR;
            PG8_LDA(At, 0, 1); PG8_STAGE(PG8_SA(0, 0), a2, voffA);
            PG8_BAR; PG8_WAIT_L(0); PG8_MMA(1, 0, At, B0); PG8_BAR; PG8_SCHED;
            PG8_STAGE(PG8_SB(0, 1), b2 + hstep, voffB);
            PG8_WAIT_V(6); PG8_BAR; PG8_MMA(1, 1, At, B1); PG8_BAR;
            PG8_LDB(B0, 1, 0); PG8_SCHED; PG8_LDA(At, 1, 0); PG8_STAGE(PG8_SA(0, 1), a2 + hstep, voffA);
            PG8_WAIT_L(8); PG8_BAR; PG8_WAIT_L(0); PG8_MMA(0, 0, At, B0); PG8_BAR; PG8_SCHED;
            PG8_LDB(B1, 1, 1); PG8_STAGE(PG8_SB(1, 0), b3, voffB);
            PG8_BAR; PG8_WAIT_L(0); PG8_MMA(0, 1, At, B1); PG8_BAR;
            PG8_LDA(At, 1, 1); PG8_STAGE(PG8_SA(1, 0), a3, voffA);
            PG8_BAR; PG8_WAIT_L(0); PG8_MMA(1, 0, At, B0); PG8_BAR; PG8_SCHED;
            PG8_STAGE(PG8_SB(1, 1), b3 + hstep, voffB);
            PG8_WAIT_V(6); PG8_BAR; PG8_MMA(1, 1, At, B1); PG8_BAR;
            }
        }
        if constexpr (ALIGN_EPI) { if (wr == 0) PG8_BAR; }
        if constexpr (!Epi::AFTER_DRAIN) { E(acc, cur, wr, wc, fr, fq, ui); S.done(cur); }
        if (!has_next) break;
#pragma unroll
        for (int a = 0; a < 2; ++a)
#pragma unroll
            for (int b = 0; b < 2; ++b)
#pragma unroll
                for (int m = 0; m < 4; ++m)
#pragma unroll
                    for (int n = 0; n < 2; ++n) acc[a][b][m][n] = (f32x4){0.f, 0.f, 0.f, 0.f};
        cur = nxt; cA = nA; cB = nB; ++ui;
        if constexpr (ALIGN_EPI) { if (wr == 1) PG8_BAR; }
    }
    PG8_WAIT_V(0);
    if constexpr (!ALIGN_EPI) { if (wr == 0) PG8_BAR; }
    PG8_BAR;
    if constexpr (Epi::AFTER_DRAIN) { E.fused(acc, cur, wr, wc, fr, fq, lds, wid, lane); S.done(cur); }
#undef PG8_SA
#undef PG8_SB
#undef PG8_STAGE
#undef PG8_LDA
#undef PG8_LDB
#undef PG8_MMA
#undef PG8_WAIT_V
#undef PG8_WAIT_L
#undef PG8_BAR
#undef PG8_SCHED
}
}
#define GAS __attribute__((address_space(1)))
#define LAS __attribute__((address_space(3)))
typedef unsigned short bf16;
typedef unsigned v4u __attribute__((ext_vector_type(4)));
typedef float f32x4 __attribute__((ext_vector_type(4)));
typedef short bf16x8 __attribute__((ext_vector_type(8)));
typedef GAS unsigned gu32;
typedef GAS unsigned long long gu64;
#define RLX_AGENT __ATOMIC_RELAXED, __HIP_MEMORY_SCOPE_AGENT
#define LDS_WAIT() asm volatile("s_waitcnt lgkmcnt(0)" ::: "memory")
#define VM_WAIT() asm volatile("s_waitcnt vmcnt(0)" ::: "memory")
__device__ __forceinline__ unsigned long long rt() { return __builtin_amdgcn_s_memrealtime(); }
__device__ __forceinline__ unsigned f2bf(float f) { unsigned u = __builtin_bit_cast(unsigned, f); return (u + 0x7fffu + ((u >> 16) & 1u)) >> 16; }
__device__ __forceinline__ unsigned pk2(float lo, float hi) { return f2bf(lo) | (f2bf(hi) << 16); }

#define XB_TMO      128
#define XB_XCNT(j)  (256  + 64 * (j))
#define XB_XSUB(j)  (1280 + 64 * (j))
#define XB_XGEN(j)  (2304 + 64 * (j))
#define XB_TOP      3328
#define XB_TOPGEN   3392
#define XCD_BAR_WORDS 3456
#define XB_SPIN_CAP (1u << 18)

__device__ __forceinline__ unsigned xb_ld(unsigned* p)              { return __hip_atomic_load(p, __ATOMIC_RELAXED, __HIP_MEMORY_SCOPE_AGENT); }
__device__ __forceinline__ unsigned xb_add(unsigned* p, unsigned v) { return __hip_atomic_fetch_add(p, v, __ATOMIC_RELAXED, __HIP_MEMORY_SCOPE_AGENT); }
__device__ __forceinline__ unsigned xb_xcc_id() { return (unsigned)__builtin_amdgcn_s_getreg((3 << 11) | 20) & 0xFu; }
#define XB_SPIN(cond, bar) do { unsigned _sp = 0; while (cond) { __builtin_amdgcn_s_sleep(1); \
    if ((++_sp & 255u) == 0u) { if (xb_ld(&(bar)[XB_TMO])) break; if (_sp > XB_SPIN_CAP) { atomicAdd(&(bar)[XB_TMO], 1u); break; } } } } while (0)

struct XcdBarrier {
    unsigned* bar; unsigned x;
    volatile LAS unsigned* st;
};

__device__ __forceinline__ XcdBarrier xcd_barrier_post(unsigned* bar, volatile LAS unsigned* st) {
    XcdBarrier b; b.bar = bar; b.x = xb_xcc_id(); b.st = st;
    if (threadIdx.x == 0) (void)xb_add(&bar[XB_XCNT(b.x)], 1u);
    return b;
}
__device__ __forceinline__ void xcd_barrier_complete(unsigned* bar, unsigned x, unsigned& nloc, unsigned& nx) {
    const unsigned G = gridDim.x * gridDim.y * gridDim.z;
    unsigned sum, cnt, mine, sp = 0u;
    for (;;) {
        sum = 0u; cnt = 0u; mine = 0u;
#pragma unroll
        for (unsigned j = 0; j < 16; ++j) { const unsigned c = xb_ld(&bar[XB_XCNT(j)]); sum += c; cnt += (c > 0u) ? 1u : 0u; mine = (j == x) ? c : mine; }
        if (sum == G) break;
        __builtin_amdgcn_s_sleep(1);
        if ((++sp & 255u) == 0u) { if (xb_ld(&bar[XB_TMO])) break; if (sp > XB_SPIN_CAP) { atomicAdd(&bar[XB_TMO], 1u); break; } }
    }
    nloc = mine > 0u ? mine : 1u; nx = cnt > 0u ? cnt : 1u;
}

__device__ __forceinline__ void xcd_barrier(const XcdBarrier& b) {
    asm volatile("s_waitcnt vmcnt(0)" ::: "memory");
    __syncthreads();
    if (threadIdx.x == 0) {
        unsigned* bar = b.bar;
        __builtin_amdgcn_s_waitcnt(0);
        unsigned nloc = b.st[0], nx = b.st[1];
        if (nloc == 0u) { xcd_barrier_complete(bar, b.x, nloc, nx); b.st[0] = nloc; b.st[1] = nx; }
        const unsigned old = xb_add(&bar[XB_XSUB(b.x)], 1u);
        const unsigned gen = old / nloc;
        if (old + 1u == (gen + 1u) * nloc) {
            __builtin_amdgcn_fence(__ATOMIC_RELEASE, "agent");
            asm volatile("s_waitcnt vmcnt(0)" ::: "memory");
            const unsigned og = xb_add(&bar[XB_TOP], 1u);
            const unsigned tg = og / nx;
            if (og + 1u == (tg + 1u) * nx) xb_add(&bar[XB_TOPGEN], 1u);
            else XB_SPIN(xb_ld(&bar[XB_TOPGEN]) == tg, bar);
            __builtin_amdgcn_fence(__ATOMIC_ACQUIRE, "agent");
            xb_add(&bar[XB_XGEN(b.x)], 1u);
            asm volatile("s_waitcnt vmcnt(0)" ::: "memory");
        } else {
            XB_SPIN(xb_ld(&bar[XB_XGEN(b.x)]) == gen, bar);
            __builtin_amdgcn_fence(__ATOMIC_ACQUIRE, "agent");
            asm volatile("s_waitcnt vmcnt(0)" ::: "memory");
        }
    }
    __syncthreads();
}

namespace swa {
typedef unsigned short u16;
typedef short bf16x8 __attribute__((ext_vector_type(8)));
typedef _Float16 f16x8 __attribute__((ext_vector_type(8)));
typedef short s16x4 __attribute__((ext_vector_type(4)));
typedef float f32x16 __attribute__((ext_vector_type(16)));
typedef float f32x4 __attribute__((ext_vector_type(4)));
typedef unsigned u32x4 __attribute__((ext_vector_type(4)));
constexpr int D = 128, W = 129;
constexpr float THR = 8.f;
constexpr float SCALE = 0.08838834764831845f;
constexpr int NW = 8, QBLK = 32, KVBLK = 64, QB = NW * QBLK;
constexpr int SHM_V = KVBLK * D * 2, SHM_K = KVBLK * D * 2;
constexpr int LDS_BYTES = 2 * SHM_V + 2 * SHM_K + NW * 64 * 4;
#define KSWZ(row, colB) ((row) * 256 + ((colB) ^ (((row) & 7) << 4)))
#define SBAR() __builtin_amdgcn_sched_barrier(0)
__device__ __forceinline__ int v_st(int k, int c) { const int kk = (k & ~0xC) | ((k & 4) << 1) | ((k & 8) >> 1); return ((kk >> 3) * 4 + (c >> 5)) * 512 + ((kk & 7) * 32 + (c & 31)) * 2; }
__device__ __forceinline__ int v_rd_base(int lane) { return ((lane & 3) << 3) | (((lane >> 2) & 3) << 6) | (((lane >> 4) & 1) << 5) | (((lane >> 5) & 1) << 8); }
constexpr int v_rd_off(int d0, int ks, int half) { return d0 * 512 + ks * 4096 + half * 2048; }
__device__ __forceinline__ int crow(int r, int hi) { return (r & 3) + 8 * (r >> 2) + 4 * hi; }
__device__ __forceinline__ unsigned cvtpk(float lo, float hi) { return pg8::cvt_pk_h(lo, hi); }
__device__ __forceinline__ float hlo(unsigned w) { return (float)__builtin_bit_cast(pg8::h16x2, w)[0]; }
__device__ __forceinline__ float hhi(unsigned w) { return (float)__builtin_bit_cast(pg8::h16x2, w)[1]; }
__device__ __forceinline__ bf16x8 load8(const u16* p) { return *reinterpret_cast<const bf16x8*>(p); }
#define SWA_MFMA(a, b, c) __builtin_amdgcn_mfma_f32_32x32x16_f16(__builtin_bit_cast(f16x8, a), __builtin_bit_cast(f16x8, b), c, 0, 0, 0)
__device__ __forceinline__ void mask_tile(f32x16& p0, f32x16& p1, int dq, unsigned Wd) {
    const float NEG = -__builtin_inff();
#pragma unroll
    for (int r = 0; r < 16; ++r) {
        const int c = (r & 3) + 8 * (r >> 2);
        if ((unsigned)(dq - c) >= Wd) p0[r] = NEG;
        if ((unsigned)(dq - c - 32) >= Wd) p1[r] = NEG;
    }
}
__device__ __forceinline__ void partialSM(f32x16& p0, f32x16& p1, float& m_reg, float& mn, float& alpha) {
    float pmax = p0[0]; for (int r = 1; r < 16; ++r) pmax = fmaxf(pmax, p0[r]); for (int r = 0; r < 16; ++r) pmax = fmaxf(pmax, p1[r]);
    { auto rr = __builtin_amdgcn_permlane32_swap(__float_as_uint(pmax), __float_as_uint(pmax), false, false);
      pmax = fmaxf(__uint_as_float(rr[0]), __uint_as_float(rr[1])); }
    constexpr float C2 = 1.4426950408889634f * SCALE;
    if (__builtin_expect(__all((pmax - m_reg) * SCALE <= THR), 1)) { mn = m_reg; alpha = 1.f; }
    else { mn = fmaxf(m_reg, pmax); alpha = __builtin_amdgcn_exp2f((m_reg - mn) * C2); m_reg = mn; }
    const float mnL = -mn * C2;
    for (int r = 0; r < 16; ++r) p0[r] = fmaf(p0[r], C2, mnL); for (int r = 0; r < 16; ++r) p1[r] = fmaf(p1[r], C2, mnL);
    for (int r = 0; r < 16; ++r) p0[r] = __builtin_amdgcn_exp2f(p0[r]);
}
__device__ __forceinline__ void finishSM(f32x16& p0, f32x16& p1, float alpha, float& l_reg, bf16x8& pa0, bf16x8& pa1, bf16x8& pa2, bf16x8& pa3) {
    for (int r = 0; r < 16; ++r) p1[r] = __builtin_amdgcn_exp2f(p1[r]);
    float ps = 0; for (int r = 0; r < 16; ++r) ps += p0[r]; for (int r = 0; r < 16; ++r) ps += p1[r];
    { auto rr = __builtin_amdgcn_permlane32_swap(__float_as_uint(ps), __float_as_uint(ps), false, false);
      ps = __uint_as_float(rr[0]) + __uint_as_float(rr[1]); }
    l_reg = l_reg * alpha + ps;
#define PK4(P, B_, OUT) do { unsigned a0 = cvtpk(P[B_+0], P[B_+1]), a1 = cvtpk(P[B_+2], P[B_+3]);                          \
        unsigned b0 = cvtpk(P[B_+4], P[B_+5]), b1 = cvtpk(P[B_+6], P[B_+7]);                                             \
        auto r0 = __builtin_amdgcn_permlane32_swap(a0, b0, false, false); auto r1 = __builtin_amdgcn_permlane32_swap(a1, b1, false, false); \
        u32x4 w = {r0[0], r1[0], r0[1], r1[1]}; OUT = *reinterpret_cast<bf16x8*>(&w); } while (0)
    PK4(p0, 0, pa0); PK4(p0, 8, pa1); PK4(p1, 0, pa2); PK4(p1, 8, pa3);
#undef PK4
}
template <int KB>
__device__ __forceinline__ void qkt(f32x16& p0, f32x16& p1, const char* K_lds, int r32, int hi, const bf16x8* qr, bool act) {
    if (!act) { const float NEG = -__builtin_inff();
#pragma unroll
        for (int r = 0; r < 16; ++r) { p0[r] = NEG; p1[r] = NEG; } return; }
    p0 = f32x16{}; p1 = f32x16{};
    const char* kb[4];
#pragma unroll
    for (int dd = 0; dd < 4; ++dd) kb[dd] = K_lds + KB * SHM_K + KSWZ(r32, (dd * 16 + hi * 8) * 2);
#pragma unroll
    for (int d0 = 0; d0 < 8; ++d0) { const char* a = kb[d0 & 3] + (d0 >> 2) * 128;
        bf16x8 b0 = *reinterpret_cast<const bf16x8*>(a);
        bf16x8 b1 = *reinterpret_cast<const bf16x8*>(a + 32 * 256);
        p0 = SWA_MFMA(b0, qr[d0], p0);
        p1 = SWA_MFMA(b1, qr[d0], p1); }
}
template <int VB>
__device__ __forceinline__ void pv_tile(f32x16* o, int vb0, bf16x8 pa0, bf16x8 pa1, bf16x8 pa2, bf16x8 pa3, bool act) {
    if (!act) return;
#define TRRD(dst, off) asm volatile("ds_read_b64_tr_b16 %0, %1 offset:%2" : "=&v"(dst) : "v"(vb0), "i"(off) : "memory")
#define PV_D0(d0) do { s16x4 l0, l1, l2, l3, h0, h1, h2, h3; constexpr int b_ = VB * SHM_V + v_rd_off(d0, 0, 0); \
        TRRD(l0, b_); TRRD(h0, b_ + 2048); TRRD(l1, b_ + 4096); TRRD(h1, b_ + 6144); TRRD(l2, b_ + 8192); TRRD(h2, b_ + 10240); TRRD(l3, b_ + 12288); TRRD(h3, b_ + 14336); \
        asm volatile("s_waitcnt lgkmcnt(0)" ::: "memory"); SBAR();   \
        o[d0] = SWA_MFMA(pa0, ((bf16x8){l0[0], l0[1], l0[2], l0[3], h0[0], h0[1], h0[2], h0[3]}), o[d0]);   \
        o[d0] = SWA_MFMA(pa1, ((bf16x8){l1[0], l1[1], l1[2], l1[3], h1[0], h1[1], h1[2], h1[3]}), o[d0]);   \
        o[d0] = SWA_MFMA(pa2, ((bf16x8){l2[0], l2[1], l2[2], l2[3], h2[0], h2[1], h2[2], h2[3]}), o[d0]);   \
        o[d0] = SWA_MFMA(pa3, ((bf16x8){l3[0], l3[1], l3[2], l3[3], h3[0], h3[1], h3[2], h3[3]}), o[d0]); } while (0)
    PV_D0(0); PV_D0(1); PV_D0(2); PV_D0(3);
#undef PV_D0
#undef TRRD
}
struct BlockRef { const u16* Q; const u16* K; const u16* V; int P0, skv, trow0, tstep, h; };
struct Seam { bf16x8 qr[8]; bf16x8 st_v0, st_v1, st_k0, st_k1; };
__device__ __forceinline__ int swa_jlo(int P0) { const int lowk = P0 - W + 1; return lowk > 0 ? lowk / KVBLK : 0; }
#define ROW(p, k0, rr) ((p) + (size_t)((k0) + (rr)) * D + sc)
#define VMW() asm volatile("s_waitcnt vmcnt(0)" ::: "memory")
#define VMWN(n) asm volatile("s_waitcnt vmcnt(%0)" :: "i"(n) : "memory")
#define SLOAD_H(Kp, Vp, k0) do { S.st_v0 = load8(ROW(Vp, k0, sr)); S.st_v1 = load8(ROW(Vp, k0, 32 + sr));              \
                         S.st_k0 = load8(ROW(Kp, k0, sr)); S.st_k1 = load8(ROW(Kp, k0, 32 + sr)); } while (0)
#define SWRITE_HK(bf) do { *(bf16x8*)(K_lds + (bf) * SHM_K + kws) = S.st_k0; *(bf16x8*)(K_lds + (bf) * SHM_K + kws + 32 * 256) = S.st_k1; } while (0)
#define SWRITE_HV(bf) do { *(bf16x8*)(V_lds + (bf) * SHM_V + vst0) = S.st_v0; *(bf16x8*)(V_lds + (bf) * SHM_V + vst1) = S.st_v1; } while (0)
#define SWRITE_H(bf) do { SWRITE_HV(bf); SWRITE_HK(bf); } while (0)
__device__ __forceinline__ void swa_prime(const BlockRef& cur, char* lds, Seam& S) {
    int tid = threadIdx.x; asm volatile("" : "+v"(tid));
    const int wid = __builtin_amdgcn_readfirstlane(tid >> 6), lane = tid & 63, r32 = lane & 31, hi = lane >> 5;
    const int sr = tid >> 4, sc = (tid & 15) * 8, kws = KSWZ(sr, sc * 2); char* K_lds = lds + 2 * SHM_V;
    const int kb0 = swa_jlo(cur.P0) * KVBLK;
    for (int d0 = 0; d0 < 8; ++d0) S.qr[d0] = load8(cur.Q + (size_t)(cur.P0 + wid * QBLK + r32) * D + d0 * 16 + hi * 8);
    SLOAD_H(cur.K, cur.V, kb0); VMW(); SWRITE_HK(0);
    __syncthreads();
}
__device__ __forceinline__ void swa_block(const BlockRef& cur, const BlockRef& nxt, char* lds, Seam& S, u16* OM, float* LSE, int first_group) {
    int tid = threadIdx.x; asm volatile("" : "+v"(tid));
    const int wid = __builtin_amdgcn_readfirstlane(tid >> 6), lane = tid & 63, r32 = lane & 31, hi = lane >> 5;
    const int j_lo = swa_jlo(cur.P0);
    int j_hi = (cur.P0 + QB - 1) / KVBLK + 1; if (j_hi > cur.skv / KVBLK) j_hi = cur.skv / KVBLK;
    const int NT = j_hi - j_lo;
    const int kbn = swa_jlo(nxt.P0) * KVBLK;
    const int qlo = cur.P0 + wid * QBLK, qm = qlo + r32 - 4 * hi;
    char* V_lds = lds; char* K_lds = lds + 2 * SHM_V;
    float* ws = (float*)(lds + 2 * SHM_V + 2 * SHM_K) + wid * 64; float* li_l = ws, * al_l = ws + 32;
    float m_reg = -1e30f, l_reg = 0; f32x16 o[4] = {};
    const int sr = tid >> 4, sc = (tid & 15) * 8, vst0 = v_st(sr, sc), vst1 = v_st(32 + sr, sc), kws = KSWZ(sr, sc * 2);
    const int vb0 = (int)(uintptr_t)V_lds + v_rd_base(lane);
    const u16* Kh = cur.K; const u16* Vh = cur.V;
#define RESC(a) do { if (__any((a) < 1.f)) { if (hi == 0) al_l[r32] = (a); asm volatile("s_waitcnt lgkmcnt(0)" ::: "memory");              \
                     for (int d_ = 0; d_ < 4; ++d_) for (int r = 0; r < 16; ++r) o[d_][r] *= al_l[crow(r, hi)]; } } while (0)
#define KBASE(t) ((j_lo + (t)) * KVBLK)
#define ACT(t) (KBASE(t) <= qlo + QBLK - 1 && KBASE(t) + KVBLK - 1 >= qlo - W + 1)
#define MASKT(P0_, P1_, t) do { const int kb_ = KBASE(t); if (ACT(t) && (kb_ + KVBLK - 1 > qlo || kb_ <= qlo + QBLK - 1 - W)) mask_tile(P0_, P1_, qm - kb_, (unsigned)W); } while (0)
    constexpr int NQL = 8;
#define SEAM_K0() do { VMWN(NQL); SWRITE_HK(0); SBAR(); } while (0)
    f32x16 pA0, pA1, pB0, pB1; float mnA, mnB, alA, alB; bf16x8 pa0, pa1, pa2, pa3;
    SWRITE_HV(0); SBAR();
    if (NT > 1) { SLOAD_H(Kh, Vh, KBASE(1)); }
    SBAR(); qkt<0>(pA0, pA1, K_lds, r32, hi, S.qr, ACT(0));
    MASKT(pA0, pA1, 0); partialSM(pA0, pA1, m_reg, mnA, alA);
    if (NT > 1) { VMW(); SWRITE_H(1); }
    __syncthreads();
#define HALF_STEP(PX0, PX1, mnX, alX, PY0, PY1, alY, t, KB, VB, SB) do {                                                      \
        SBAR(); qkt<KB>(PX0, PX1, K_lds, r32, hi, S.qr, ACT(t));                                             \
        finishSM(PY0, PY1, alY, l_reg, pa0, pa1, pa2, pa3); SBAR();                                                           \
        if ((t) + 1 < NT) { SLOAD_H(Kh, Vh, KBASE((t) + 1)); SBAR(); }                                               \
        pv_tile<VB>(o, vb0, pa0, pa1, pa2, pa3, ACT((t) - 1)); MASKT(PX0, PX1, (t)); partialSM(PX0, PX1, m_reg, mnX, alX);                                        \
        __syncthreads();                                                                                                      \
        if ((t) + 1 < NT) { VMW(); SWRITE_H(SB); }                                                                          \
        RESC(alX); __syncthreads(); } while (0)
    for (int t = 1; t + 1 < NT; t += 2) {
        HALF_STEP(pB0, pB1, mnB, alB, pA0, pA1, alA, t, 1, 0, 0);
        HALF_STEP(pA0, pA1, mnA, alA, pB0, pB1, alB, t + 1, 0, 1, 1);
    }
    const bool even = (NT & 1) == 0;
    if (even) { SBAR(); qkt<1>(pB0, pB1, K_lds, r32, hi, S.qr, ACT(NT - 1)); SBAR(); }
    SLOAD_H(nxt.K, nxt.V, kbn); SBAR();
#pragma unroll
    for (int d0 = 0; d0 < 8; ++d0) S.qr[d0] = load8(nxt.Q + (size_t)(nxt.P0 + wid * QBLK + r32) * D + d0 * 16 + hi * 8);
    SBAR();
    finishSM(pA0, pA1, alA, l_reg, pa0, pa1, pa2, pa3); SBAR();
    pv_tile<0>(o, vb0, pa0, pa1, pa2, pa3, ACT(even ? NT - 2 : NT - 1));
    if (even) { MASKT(pB0, pB1, NT - 1); partialSM(pB0, pB1, m_reg, mnB, alB); __syncthreads(); RESC(alB);
        finishSM(pB0, pB1, alB, l_reg, pa0, pa1, pa2, pa3); SBAR(); pv_tile<1>(o, vb0, pa0, pa1, pa2, pa3, ACT(NT - 1)); }
    SBAR(); SEAM_K0();
    if (hi == 0) { const size_t li = (size_t)(cur.trow0 + cur.tstep * (wid * QBLK + r32)) * 8 + cur.h; const float lse_n = m_reg * SCALE + __logf(l_reg);
        if (first_group) { li_l[r32] = 1.0f / l_reg; al_l[r32] = 0.f; LSE[li] = lse_n; }
        else { const float lo = LSE[li], mx = fmaxf(lo, lse_n), eo = __expf(lo - mx), en = __expf(lse_n - mx), inv = 1.0f / (eo + en);
               li_l[r32] = en * inv / l_reg; al_l[r32] = eo * inv; LSE[li] = mx + __logf(eo + en); } }
    asm volatile("s_waitcnt lgkmcnt(0)" ::: "memory");
    {
        u16* Ow = OM + (size_t)(cur.trow0 + cur.tstep * (wid * QBLK)) * 1024 + cur.h * D;
        const size_t rstep = (size_t)cur.tstep * 1024;
#pragma unroll
        for (int r = 0; r < 16; ++r) { const int orow = crow(r, hi); const float wn = li_l[orow], wo = al_l[orow];
            unsigned* rowp = (unsigned*)(Ow + (size_t)orow * rstep + r32);
#pragma unroll
            for (int d0 = 0; d0 < 4; ++d0) { float v = o[d0][r] * wn; float vn = __shfl_xor(v, 1);
                if ((r32 & 1) == 0) { unsigned* p = rowp + d0 * 16;
                    if (!first_group) { const unsigned ov = *p; v += wo * hlo(ov); vn += wo * hhi(ov); }
                    *p = cvtpk(v, vn); } } }
    }
    __syncthreads();
#undef RESC
#undef KBASE
#undef ACT
#undef MASKT
#undef SEAM_K0
#undef HALF_STEP
}
#undef ROW
#undef VMW
#undef VMWN
#undef SLOAD_H
#undef SWRITE_HK
#undef SWRITE_HV
#undef SWRITE_H
#undef KSWZ
#undef SBAR
#undef SWA_MFMA
__device__ __forceinline__ BlockRef swa_ref(int item, int ldil, const u16* Q, const u16* K, const u16* V) {
    const int L = 8192 >> ldil, nqb = L / QB, qb = item % nqb, seq = item / nqb;
    const int r = seq & ((1 << ldil) - 1), bh = seq >> ldil, b = bh >> 3, h = bh & 7;
    BlockRef x; const size_t base = (size_t)seq * L * D;
    x.Q = Q + base; x.K = K + base; x.V = V + base; x.P0 = qb * QB; x.skv = L; x.trow0 = b * 8192 + r + ((qb * QB) << ldil); x.tstep = 1 << ldil; x.h = h;
    return x;
}
__device__ __forceinline__ void attn_phase(char* lds, int vcu, int G, int ldil, const u16* Q, const u16* K, const u16* V, u16* OM, float* LSE, int first_group) {
    const int total = 512;
    int it = 2 * vcu; if (it >= total) return;
    const int per = 2;
    BlockRef cur = swa_ref(it, ldil, Q, K, V);
    Seam S;
    swa_prime(cur, lds, S);
    for (int k = 0; k < per; ++k) {
        const bool last = (k == per - 1);
        const BlockRef nxt = last ? cur : swa_ref(it + k + 1, ldil, Q, K, V);
        swa_block(cur, nxt, lds, S, OM, LSE, first_group);
        cur = nxt;
    }
}
}

namespace gla {
typedef unsigned short u16;
typedef short bf16x8 __attribute__((ext_vector_type(8)));
typedef short s16x4 __attribute__((ext_vector_type(4)));
typedef float f32x16 __attribute__((ext_vector_type(16)));
typedef float f32x4 __attribute__((ext_vector_type(4)));
typedef unsigned u32x4 __attribute__((ext_vector_type(4)));
typedef unsigned u32x2 __attribute__((ext_vector_type(2)));
#define GLAS __attribute__((address_space(3)))
constexpr int RQ = 320, RV = 576;
constexpr int O_QT = 0, O_KT = 64 * RQ, O_KD = 2 * 64 * RQ, O_V = 3 * 64 * RQ, O_DEC = O_V + 64 * RV, O_BL = O_DEC + 512, O_END = O_BL + 512;
constexpr int O_OS = 0;
constexpr int NSEG = 32, SEGC = 4;
typedef float f32x2_t __attribute__((ext_vector_type(2))); typedef __bf16 bf16x2_t __attribute__((ext_vector_type(2)));
__device__ __forceinline__ unsigned cvtpk_bf(float lo, float hi) { const f32x2_t v = {lo, hi}; return __builtin_bit_cast(unsigned, __builtin_convertvector(v, bf16x2_t)); }
__device__ __forceinline__ int crow(int r, int hi) { return (r & 3) + 8 * (r >> 2) + 4 * hi; }
__device__ __forceinline__ float bf_lo(unsigned w) { return __builtin_bit_cast(float, w << 16); }
__device__ __forceinline__ float bf_hi(unsigned w) { return __builtin_bit_cast(float, w & 0xffff0000u); }
__device__ __forceinline__ s16x4 trrd(GLAS const unsigned char* p) { typedef short v4i16_t __attribute__((ext_vector_type(4))); return __builtin_bit_cast(s16x4, __builtin_amdgcn_ds_read_tr16_b64_v4i16((GLAS v4i16_t*)p)); }
template <int PITCH> __device__ __forceinline__ int tr_lane_off(int lane) { const int g = lane >> 4, q = (lane >> 2) & 3, p = lane & 3; return (8 * (g >> 1) + q) * PITCH + (16 * (g & 1) + 4 * p) * 2; }
template <int PITCH> __device__ __forceinline__ bf16x8 tr_frag(GLAS const unsigned char* base, int off) {
    const s16x4 lo = trrd(base + off), hi = trrd(base + off + 4 * PITCH);
    return (bf16x8){lo[0], lo[1], lo[2], lo[3], hi[0], hi[1], hi[2], hi[3]};
}
#define GLA_MFMA(a, b, c) __builtin_amdgcn_mfma_f32_32x32x16_bf16(a, b, c, 0, 0, 0)

struct Tensors { const u16* q; const u16* k; const u16* v; const u16* g; const float* Bc; const float* normw; float* GS; float* GD; u16* GO; };

template <bool FULL>
__device__ __forceinline__ void stage_chunk(GLAS unsigned char* L, const Tensors& T, int b, int h, int tok0, int tid) {
    const int s = tid >> 3, d0 = (tid & 7) * 16; const size_t row = (size_t)b * 8192 + tok0 + s, rowl = (size_t)b * 8192 + tok0 + 63;
    const float* bp = T.Bc + row * 512 + h * 128 + d0; const float* blp = T.Bc + rowl * 512 + h * 128 + d0;
    const u32x4* kp = (const u32x4*)(T.k + row * 512 + h * 128 + d0);
    const u32x4 k0 = kp[0], k1 = kp[1];
    u32x4 q0 = {0, 0, 0, 0}, q1 = {0, 0, 0, 0}; if (FULL) { const u32x4* qp = (const u32x4*)(T.q + row * 512 + h * 128 + d0); q0 = qp[0]; q1 = qp[1]; }
    f32x4 bv[4], bl[4];
#pragma unroll
    for (int i = 0; i < 4; ++i) { bv[i] = *(const f32x4*)(bp + 4 * i); bl[i] = *(const f32x4*)(blp + 4 * i); }
    const u32x4* vp = (const u32x4*)(T.v + row * 1024 + h * 256 + (tid & 7) * 32);
    const u32x4 v0 = vp[0], v1 = vp[1], v2 = vp[2], v3 = vp[3];
    unsigned qt[8], kt[8], kd[8];
#pragma unroll
    for (int i = 0; i < 8; ++i) { const unsigned kw = i < 4 ? k0[i] : k1[i - 4], qw = i < 4 ? q0[i] : q1[i - 4];
        const float b0 = bv[i >> 1][(2 * i) & 3], b1 = bv[i >> 1][(2 * i + 1) & 3], l0 = bl[i >> 1][(2 * i) & 3], l1 = bl[i >> 1][(2 * i + 1) & 3];
        const float kf0 = bf_lo(kw), kf1 = bf_hi(kw);
        kd[i] = cvtpk_bf(kf0 * __expf(l0 - b0), kf1 * __expf(l1 - b1));
        if (FULL) { const float e0 = __expf(b0), e1 = __expf(b1);
            qt[i] = cvtpk_bf(bf_lo(qw) * (0.08838834764831845f * e0), bf_hi(qw) * (0.08838834764831845f * e1));
            kt[i] = cvtpk_bf(kf0 * __builtin_amdgcn_rcpf(e0), kf1 * __builtin_amdgcn_rcpf(e1)); } }
    GLAS unsigned char* r = L + s * RQ + d0 * 2;
    *(GLAS u32x4*)(r + O_KD) = (u32x4){kd[0], kd[1], kd[2], kd[3]}; *(GLAS u32x4*)(r + O_KD + 16) = (u32x4){kd[4], kd[5], kd[6], kd[7]};
    if (FULL) { *(GLAS u32x4*)(r + O_QT) = (u32x4){qt[0], qt[1], qt[2], qt[3]}; *(GLAS u32x4*)(r + O_QT + 16) = (u32x4){qt[4], qt[5], qt[6], qt[7]};
                *(GLAS u32x4*)(r + O_KT) = (u32x4){kt[0], kt[1], kt[2], kt[3]}; *(GLAS u32x4*)(r + O_KT + 16) = (u32x4){kt[4], kt[5], kt[6], kt[7]}; }
    GLAS unsigned char* rv = L + O_V + s * RV + (tid & 7) * 64;
    *(GLAS u32x4*)(rv) = v0; *(GLAS u32x4*)(rv + 16) = v1; *(GLAS u32x4*)(rv + 32) = v2; *(GLAS u32x4*)(rv + 48) = v3;
    if (tid < 128) { const float bl_ = T.Bc[rowl * 512 + h * 128 + tid]; ((GLAS float*)(L + O_BL))[tid] = bl_; ((GLAS float*)(L + O_DEC))[tid] = __expf(bl_); }
}
__device__ __forceinline__ void state_update(GLAS const unsigned char* Ltq, GLAS const unsigned char* Ld, f32x16 (&S)[4], const bf16x8 (&vf)[4]) {
#pragma unroll
    for (int T = 0; T < 4; ++T) {
#pragma unroll
        for (int i = 0; i < 4; ++i) { const f32x4 dc = *(GLAS const f32x4*)(Ld + O_DEC + 128 * T + 32 * i);
#pragma unroll
            for (int e = 0; e < 4; ++e) S[T][4 * i + e] *= dc[e]; }
#pragma unroll
        for (int kk = 0; kk < 4; ++kk) { const bf16x8 a = tr_frag<RQ>(Ltq, O_KD + 16 * kk * RQ + 64 * T); S[T] = GLA_MFMA(a, vf[kk], S[T]); }
    }
}
__device__ __forceinline__ void load_vfrags(GLAS const unsigned char* Ltv, bf16x8 (&vf)[4]) {
#pragma unroll
    for (int kk = 0; kk < 4; ++kk) vf[kk] = tr_frag<RV>(Ltv, 16 * kk * RV);
}
#define GLA_OPAQUE(p) asm volatile("" : "+v"(p))
__device__ __forceinline__ void gla1_phase(GLAS unsigned char* L, int unit, const Tensors& T) {
    int tid = threadIdx.x; asm volatile("" : "+v"(tid));
    const int wid = __builtin_amdgcn_readfirstlane(tid >> 6), lane = tid & 63, hi = lane >> 5, n = lane & 31;
    const int bh = unit / NSEG, seg = unit % NSEG, b = bh >> 2, h = bh & 3;
    f32x16 S[4] = {};
    float dsum = 0.f;
    for (int c = 0; c < SEGC; ++c) {
        stage_chunk<false>(L, T, b, h, seg * 256 + c * 64, tid);
        asm volatile("s_waitcnt lgkmcnt(0)" ::: "memory"); __syncthreads();
        if (tid < 128) dsum += ((GLAS const float*)(L + O_BL))[tid];
        GLAS const unsigned char* Ltq = L + tr_lane_off<RQ>(lane); GLAS const unsigned char* Ltv = L + O_V + tr_lane_off<RV>(lane) + 64 * wid; GLAS const unsigned char* Ld = L + 16 * hi;
        GLA_OPAQUE(Ltq); GLA_OPAQUE(Ltv); GLA_OPAQUE(Ld);
        bf16x8 vf[4]; load_vfrags(Ltv, vf);
        state_update(Ltq, Ld, S, vf);
        __syncthreads();
    }
    float* gs = T.GS + (size_t)unit * (128 * 256);
#pragma unroll
    for (int Tt = 0; Tt < 4; ++Tt)
#pragma unroll
        for (int r = 0; r < 16; ++r) gs[(size_t)(32 * Tt + crow(r, hi)) * 256 + 32 * wid + n] = S[Tt][r];
    if (tid < 128) T.GD[(size_t)unit * 128 + tid] = __expf(dsum);
}
__device__ __forceinline__ void gla2_phase(int vcu, int G, const Tensors& T) {
    int tid = threadIdx.x; asm volatile("" : "+v"(tid));
    for (int e = vcu * 512 + tid; e < 8 * 128 * 256; e += G * 512) { const int bh = e >> 15, dv = e & 32767, d = dv >> 8;
        float* p0 = T.GS + ((size_t)(bh * NSEG) << 15) + dv; const float* d0 = T.GD + (size_t)(bh * NSEG) * 128 + d;
        float loc[NSEG], dec[NSEG];
#pragma unroll
        for (int seg = 0; seg < NSEG; ++seg) { loc[seg] = p0[(size_t)seg << 15]; dec[seg] = d0[seg * 128]; }
        float run = 0.f;
#pragma unroll
        for (int seg = 0; seg < NSEG; ++seg) { p0[(size_t)seg << 15] = run; run = dec[seg] * run + loc[seg]; } }
}
__device__ __forceinline__ void gla3_phase(GLAS unsigned char* L, int unit, const Tensors& T) {
    int tid = threadIdx.x; asm volatile("" : "+v"(tid));
    const int wid = __builtin_amdgcn_readfirstlane(tid >> 6), lane = tid & 63, hi = lane >> 5, n = lane & 31;
    const int bh = unit / NSEG, seg = unit % NSEG, b = bh >> 2, h = bh & 3;
    f32x16 S[4];
    { const float* gs = T.GS + (size_t)unit * (128 * 256);
#pragma unroll
      for (int Tt = 0; Tt < 4; ++Tt)
#pragma unroll
          for (int r = 0; r < 16; ++r) S[Tt][r] = gs[(size_t)(32 * Tt + crow(r, hi)) * 256 + 32 * wid + n]; }
    const f32x4 nw4 = *(const f32x4*)(T.normw + 4 * lane);
    for (int c = 0; c < SEGC; ++c) { const int tok0 = seg * 256 + c * 64;
        stage_chunk<true>(L, T, b, h, tok0, tid);
        asm volatile("s_waitcnt lgkmcnt(0)" ::: "memory"); __syncthreads();
        GLAS const unsigned char* Ltq = L + tr_lane_off<RQ>(lane); GLAS const unsigned char* Ltv = L + O_V + tr_lane_off<RV>(lane) + 64 * wid; GLAS const unsigned char* Ld = L + 16 * hi;
        GLAS const unsigned char* Lq = L + n * RQ + 16 * hi; GLAS const unsigned char* Lp = L + n * RQ + 8 * hi;
        GLAS unsigned char* Lo = L + O_OS + 4096 * hi + (32 * wid + n) * 4; GLAS const unsigned char* Lr = L + O_OS + 8192 * wid + 16 * lane;
        GLA_OPAQUE(Ltq); GLA_OPAQUE(Ltv); GLA_OPAQUE(Ld); GLA_OPAQUE(Lq); GLA_OPAQUE(Lp); GLA_OPAQUE(Lo); GLA_OPAQUE(Lr);
        bf16x8 vf[4]; load_vfrags(Ltv, vf);
        f32x16 o[2] = {};
#pragma unroll
        for (int bq = 0; bq < 2; ++bq)
#pragma unroll
            for (int a = 0; a <= bq; ++a) {
                f32x16 x = {};
#pragma unroll
                for (int kk = 0; kk < 8; ++kk) { const bf16x8 ka = *(GLAS const bf16x8*)(Lq + O_KT + 32 * a * RQ + 32 * kk);
                                                 const bf16x8 qb = *(GLAS const bf16x8*)(Lq + O_QT + 32 * bq * RQ + 32 * kk);
                                                 x = GLA_MFMA(ka, qb, x); }
                if (a == bq) {
#pragma unroll
                    for (int r = 0; r < 16; ++r) if (crow(r, hi) > n) x[r] = 0.f; }
                bf16x8 pa0, pa1;
#define PK4(P, B_, OUT) do { unsigned a0 = cvtpk_bf(P[B_+0], P[B_+1]), a1 = cvtpk_bf(P[B_+2], P[B_+3]), b0 = cvtpk_bf(P[B_+4], P[B_+5]), b1 = cvtpk_bf(P[B_+6], P[B_+7]); \
        auto r0 = __builtin_amdgcn_permlane32_swap(a0, b0, false, false); auto r1 = __builtin_amdgcn_permlane32_swap(a1, b1, false, false); \
        u32x4 w = {r0[0], r1[0], r0[1], r1[1]}; OUT = __builtin_bit_cast(bf16x8, w); } while (0)
                PK4(x, 0, pa0); PK4(x, 8, pa1);
#undef PK4
                o[bq] = GLA_MFMA(pa0, vf[2 * a], o[bq]); o[bq] = GLA_MFMA(pa1, vf[2 * a + 1], o[bq]);
            }
#pragma unroll
        for (int Tt = 0; Tt < 4; ++Tt)
#pragma unroll
            for (int s2 = 0; s2 < 2; ++s2) {
                u32x4 sw; sw.x = cvtpk_bf(S[Tt][8 * s2 + 0], S[Tt][8 * s2 + 1]); sw.y = cvtpk_bf(S[Tt][8 * s2 + 2], S[Tt][8 * s2 + 3]); sw.z = cvtpk_bf(S[Tt][8 * s2 + 4], S[Tt][8 * s2 + 5]); sw.w = cvtpk_bf(S[Tt][8 * s2 + 6], S[Tt][8 * s2 + 7]);
                const bf16x8 sb = __builtin_bit_cast(bf16x8, sw);
#pragma unroll
                for (int bq = 0; bq < 2; ++bq) { GLAS const unsigned char* qp = Lp + O_QT + 32 * bq * RQ + 64 * Tt + 32 * s2;
                    const u32x2 lo = *(GLAS const u32x2*)qp, hi2 = *(GLAS const u32x2*)(qp + 16);
                    const bf16x8 qa = __builtin_bit_cast(bf16x8, (u32x4){lo.x, lo.y, hi2.x, hi2.y});
                    o[bq] = GLA_MFMA(qa, sb, o[bq]); }
            }
        state_update(Ltq, Ld, S, vf);
        __syncthreads();
        {
#pragma unroll
          for (int bq = 0; bq < 2; ++bq)
#pragma unroll
              for (int r = 0; r < 16; ++r) *(GLAS float*)(Lo + (32 * bq + (r & 3) + 8 * (r >> 2)) * 1024) = o[bq][r]; }
        asm volatile("s_waitcnt lgkmcnt(0)" ::: "memory"); __syncthreads();
#pragma unroll
        for (int t8 = 0; t8 < 8; ++t8) { const int tk = 8 * wid + t8; const size_t row = (size_t)b * 8192 + tok0 + tk;
            const f32x4 ov = *(GLAS const f32x4*)(Lr + t8 * 1024);
            const u32x2 gw = *(const u32x2*)(T.g + row * 1024 + h * 256 + 4 * lane);
            float sq = (ov[0] * ov[0] + ov[1] * ov[1]) + (ov[2] * ov[2] + ov[3] * ov[3]);
#pragma unroll
            for (int of = 1; of < 64; of <<= 1) sq += __shfl_xor(sq, of);
            const float rstd = 1.0f / sqrtf(sq * (1.0f / 256.0f) + 1e-5f);
            const float g0 = bf_lo(gw.x), g1 = bf_hi(gw.x), g2 = bf_lo(gw.y), g3 = bf_hi(gw.y);
            const float y0 = ov[0] * rstd * nw4[0] * (g0 / (1.0f + __expf(-g0))), y1 = ov[1] * rstd * nw4[1] * (g1 / (1.0f + __expf(-g1)));
            const float y2 = ov[2] * rstd * nw4[2] * (g2 / (1.0f + __expf(-g2))), y3 = ov[3] * rstd * nw4[3] * (g3 / (1.0f + __expf(-g3)));
            u32x2 w; w.x = pg8::cvt_pk_h(y0, y1); w.y = pg8::cvt_pk_h(y2, y3);
            *(u32x2*)(T.GO + row * 1024 + h * 256 + 4 * lane) = w; }
        __syncthreads();
    }
}
#undef GLA_MFMA
#undef GLA_OPAQUE
#undef GLAS
}

constexpr int NWAVES = 8;
constexpr int BATCH = 2, SEQ = 8192, DM = 1024, MTOK = BATCH * SEQ, DFF = 4096;
constexpr int NGRP = 3, AH = 8, HD = 128, AIN = 9216;
constexpr int GH = 4, GDK = 128, GDV = 256, GKD = 512, GVD = 1024, GRANK = 16, GIN = 3088, GCH = 64;
constexpr float EPS = 1e-5f;
__host__ __device__ constexpr int grp_ldil(int g) { return g == 0 ? 0 : (g == 1 ? 2 : 4); }

constexpr size_t MiB = 1u << 20;
constexpr size_t WS_CTL = 0, CTL_ZERO_BYTES = 1 * MiB;
constexpr size_t WS_SSQ = 1 * MiB;
constexpr size_t WS_LSE = 2 * MiB;
constexpr size_t WS_COS = 3 * MiB, WS_SIN = 5 * MiB;
constexpr size_t WS_WG = 7 * MiB;
constexpr size_t WS_WQKV = 8 * MiB, WS_WO0 = 26 * MiB, WS_WUP0 = 28 * MiB, WS_WDN0 = 36 * MiB;
constexpr size_t WS_WGLA = 44 * MiB, WS_WO1 = 50 * MiB, WS_WUP1 = 52 * MiB, WS_WDN1 = 60 * MiB;
constexpr size_t WS_XB = 68 * MiB;
constexpr size_t WS_Q = 100 * MiB, WS_K = 132 * MiB, WS_V = 164 * MiB;
constexpr size_t WS_OM = 196 * MiB;
constexpr size_t WS_H = 100 * MiB;
constexpr size_t WS_GQ = 100 * MiB, WS_GK = 116 * MiB, WS_GV = 132 * MiB, WS_GG = 164 * MiB;
constexpr size_t WS_GB = 196 * MiB;
constexpr size_t WS_GS = 8 * MiB;
constexpr size_t WS_XB1 = 8 * MiB;
constexpr size_t WS_GD = 228 * MiB;
constexpr size_t WS_END = 256 * MiB;
constexpr int CW_TMO = 0, CW_CODE = 1, CW_BAR = 4096;

constexpr int RING_OFF = 0, RING_BYTES = 131072;
constexpr int LDSCTL_OFF = RING_BYTES, MISC_OFF = LDSCTL_OFF + 320;
constexpr int LDS_BYTES = 147456;
constexpr int INPTR_LDS_OFF = 131072 + 512 + 2048 + 512;
constexpr int GLR_LDS_OFF = 131072 + 512 + 2048;
static_assert(MISC_OFF + 128 <= LDS_BYTES, "LDS map");

#ifndef GLA_SIMPLE
#define GLA_SIMPLE 0
#endif
enum Phase { PH_PRO = 0, PH_QKV0 = 1, PH_ATT0 = 2, PH_QKV1 = 3, PH_ATT1 = 4, PH_QKV2 = 5, PH_ATT2 = 6, PH_WO0 = 7, PH_UP0 = 8, PH_DN0 = 9,
             PH_GLAP = 10, PH_GLA1 = 11, PH_GLA2 = 12, PH_GLA3 = 13, PH_WO1 = 14, PH_UP1 = 15, PH_DN1 = 16, PH_FIN = 17, PH_N = 18 };

struct Frame {
    LAS unsigned char* lds;
    volatile LAS unsigned* MISC;
    gu32* ctl;
    int tid, lane, wave;
    int vcu, G;
};
__device__ __forceinline__ float wave_sum(float v) {
#pragma unroll
    for (int o = 1; o < 64; o <<= 1) v += __shfl_xor(v, o);
    return v;
}
__device__ __forceinline__ float bf2f(unsigned short h) { return __builtin_bit_cast(float, (unsigned)h << 16); }
__device__ __forceinline__ unsigned pkh(float lo, float hi) { return pg8::cvt_pk_h(lo, hi); }
__device__ __forceinline__ float hlo(unsigned w) { return (float)__builtin_bit_cast(pg8::h16x2, w)[0]; }
__device__ __forceinline__ float hhi(unsigned w) { return (float)__builtin_bit_cast(pg8::h16x2, w)[1]; }
__device__ __forceinline__ float h2f(unsigned short h) { return (float)__builtin_bit_cast(_Float16, h); }

__device__ __forceinline__ void xpose_item(const float* W, int ldn, int K, const float* nw, bf16* WT, int dst_row0, int k0, int n0, int nvalid, int lane) {
    const bool cv = lane < nvalid;
    const float* wp = W + (size_t)k0 * ldn + n0 + (cv ? lane : 0);
    GAS v4u* op = (GAS v4u*)(WT + (size_t)(dst_row0 + (cv ? lane : 0)) * K + k0);
#pragma unroll
    for (int h = 0; h < 2; ++h) { float w[32];
#pragma unroll
        for (int e = 0; e < 32; ++e) w[e] = wp[(size_t)(32 * h + e) * ldn];
        if (nw) {
#pragma unroll
            for (int e = 0; e < 32; ++e) w[e] *= nw[k0 + 32 * h + e]; }
#pragma unroll
        for (int q = 0; q < 4; ++q) { v4u o; o.x = pkh(w[8 * q], w[8 * q + 1]); o.y = pkh(w[8 * q + 2], w[8 * q + 3]); o.z = pkh(w[8 * q + 4], w[8 * q + 5]); o.w = pkh(w[8 * q + 6], w[8 * q + 7]);
            if (cv) op[4 * h + q] = o; } }
}
__device__ __forceinline__ void sincos_f(float x, float& s, float& c) {
    const float k = __builtin_rintf(x * 0.636619772f);
    float r = __builtin_fmaf(-k, 1.5703125f, x); r = __builtin_fmaf(-k, 0.0004837512969970703f, r); r = __builtin_fmaf(-k, 7.549533620476723e-08f, r); r = __builtin_fmaf(-k, 2.5632829192545614e-12f, r);
    const float r2 = r * r;
    const float sr = r + r * r2 * (-1.6666654611e-1f + r2 * (8.3321608736e-3f + r2 * -1.9515295891e-4f));
    const float cr = 1.0f - 0.5f * r2 + r2 * r2 * (4.166664568298827e-2f + r2 * (-1.388731625493765e-3f + r2 * 2.443315711809948e-5f));
    const int q = (int)k & 3;
    s = (q == 0) ? sr : (q == 1) ? cr : (q == 2) ? -sr : -cr;
    c = (q == 0) ? cr : (q == 1) ? -sr : (q == 2) ? -cr : sr;
}
__device__ const float ROPE_INVF[64] = {1.000000000e+00f, 8.659643531e-01f, 7.498942614e-01f, 6.493816376e-01f, 5.623413324e-01f, 4.869675338e-01f, 4.216965139e-01f, 3.651741147e-01f, 3.162277639e-01f, 2.738419771e-01f, 2.371373773e-01f, 2.053525001e-01f, 1.778279394e-01f, 1.539926529e-01f, 1.333521307e-01f, 1.154782027e-01f, 1.000000015e-01f, 8.659642935e-02f, 7.498941571e-02f, 6.493816525e-02f, 5.623413250e-02f, 4.869675264e-02f, 4.216965288e-02f, 3.651741147e-02f, 3.162277490e-02f, 2.738419734e-02f, 2.371373773e-02f, 2.053525113e-02f, 1.778279431e-02f, 1.539926510e-02f, 1.333521493e-02f, 1.154782064e-02f, 9.999999776e-03f, 8.659643121e-03f, 7.498941850e-03f, 6.493816152e-03f, 5.623413250e-03f, 4.869675264e-03f, 4.216964822e-03f, 3.651741194e-03f, 3.162277630e-03f, 2.738419687e-03f, 2.371373586e-03f, 2.053524833e-03f, 1.778279431e-03f, 1.539926510e-03f, 1.333521446e-03f, 1.154781901e-03f, 1.000000047e-03f, 8.659643354e-04f, 7.498942432e-04f, 6.493816618e-04f, 5.623413017e-04f, 4.869675322e-04f, 4.216965172e-04f, 3.651741426e-04f, 3.162277571e-04f, 2.738419571e-04f, 2.371373703e-04f, 2.053525095e-04f, 1.778279402e-04f, 1.539926452e-04f, 1.333521504e-04f, 1.154782003e-04f};

__device__ __forceinline__ const float* in_ptr(LAS unsigned char* lds, int k) {
    const unsigned long long v = ((volatile LAS unsigned long long*)(lds + INPTR_LDS_OFF))[k];
    const unsigned lo = __builtin_amdgcn_readfirstlane((unsigned)v), hi = __builtin_amdgcn_readfirstlane((unsigned)(v >> 32));
    return (const float*)(((unsigned long long)hi << 32) | lo);
}

__device__ __forceinline__ void gla_simple_phase(LAS unsigned char* ldsb, int vcu, const bf16* q, const bf16* k, const bf16* v, const bf16* g, const float* Bc, const float* normw, bf16* GO) {
    if (vcu >= BATCH * GH) return;
    int tid = threadIdx.x; asm volatile("" : "+v"(tid));
    LAS float* as_ = (LAS float*)ldsb; LAS float* ks_ = as_ + 256; LAS float* qs_ = ks_ + 256; LAS float* red = qs_ + 256;
    const int vp = tid >> 2, qt = tid & 3, wv = tid >> 6, lane = tid & 63;
    const int b = vcu >> 2, h = vcu & 3;
    float S0[32], S1[32];
#pragma unroll
    for (int j = 0; j < 32; ++j) { S0[j] = 0.f; S1[j] = 0.f; }
    const float nw0 = normw[vp], nw1 = normw[vp + 128];
    for (int t = 0; t < SEQ; ++t) { const size_t row = (size_t)b * SEQ + t; const int bf = t & 1;
        if (tid < 128) { const float* bp = Bc + row * GKD + h * GDK + tid; const float la = bp[0] - ((t & 63) ? bp[-GKD] : 0.f);
            as_[bf * 128 + tid] = expf(la); ks_[bf * 128 + tid] = bf2f(k[row * GKD + h * GDK + tid]); qs_[bf * 128 + tid] = bf2f(q[row * GKD + h * GDK + tid]) * 0.08838834764831845f; }
        const float v0 = bf2f(v[row * GVD + h * GDV + vp]), v1 = bf2f(v[row * GVD + h * GDV + vp + 128]);
        __syncthreads();
        float o0 = 0.f, o1 = 0.f;
#pragma unroll
        for (int c = 0; c < 8; ++c) { const f32x4 a4 = *(const LAS f32x4*)&as_[bf * 128 + qt * 32 + 4 * c], k4 = *(const LAS f32x4*)&ks_[bf * 128 + qt * 32 + 4 * c], q4 = *(const LAS f32x4*)&qs_[bf * 128 + qt * 32 + 4 * c];
#pragma unroll
            for (int e = 0; e < 4; ++e) { const int j = 4 * c + e; S0[j] = a4[e] * S0[j] + k4[e] * v0; o0 += q4[e] * S0[j]; S1[j] = a4[e] * S1[j] + k4[e] * v1; o1 += q4[e] * S1[j]; } }
        o0 += __shfl_xor(o0, 1); o0 += __shfl_xor(o0, 2); o1 += __shfl_xor(o1, 1); o1 += __shfl_xor(o1, 2);
        float sq = qt == 0 ? o0 * o0 + o1 * o1 : 0.f; sq = wave_sum(sq);
        if (lane == 0) red[bf * 8 + wv] = sq;
        __syncthreads();
        float tot = 0.f;
#pragma unroll
        for (int w = 0; w < 8; ++w) tot += red[bf * 8 + w];
        const float rstd = 1.0f / sqrtf(tot * (1.0f / GDV) + EPS);
        if (qt == 0) { const float g0 = bf2f(g[row * GVD + h * GDV + vp]), g1 = bf2f(g[row * GVD + h * GDV + vp + 128]);
            GO[row * GVD + h * GDV + vp] = __builtin_bit_cast(unsigned short, (_Float16)(o0 * rstd * nw0 * (g0 / (1.0f + expf(-g0)))));
            GO[row * GVD + h * GDV + vp + 128] = __builtin_bit_cast(unsigned short, (_Float16)(o1 * rstd * nw1 * (g1 / (1.0f + expf(-g1))))); }
    }
}

#ifndef REP_EXTRA
#define REP_EXTRA 0
#endif
#ifndef REP_MASK
#define REP_MASK 0
#endif
struct Args { const float* in[13]; float* out; unsigned char* ws; int ph_lo, ph_hi, li, skip_mask; };

__global__ void __launch_bounds__(NWAVES * 64, 2) mega_fwd(Args args) {
    extern __shared__ __attribute__((aligned(16))) unsigned char lds[];
    Frame F;
    F.lds = (LAS unsigned char*)lds;
    F.MISC = (volatile LAS unsigned*)(F.lds + MISC_OFF);
    F.tid = threadIdx.x; F.lane = F.tid & 63; F.wave = __builtin_amdgcn_readfirstlane(F.tid >> 6);
    F.G = gridDim.x; { const int bx = blockIdx.x; F.vcu = (F.G % 8 == 0) ? (bx % 8) * (F.G / 8) + bx / 8 : bx; }
    unsigned char* ws = args.ws;
    F.ctl = (gu32*)(ws + WS_CTL);
    for (int u = F.tid; u < (LDS_BYTES - LDSCTL_OFF) / 4; u += NWAVES * 64) ((LAS unsigned*)(F.lds + LDSCTL_OFF))[u] = 0u;
    __syncthreads();
    const bool multi = (args.ph_hi - args.ph_lo) > 1;
    XcdBarrier bar; bar.bar = (unsigned*)(F.ctl + CW_BAR) + args.li * XCD_BAR_WORDS; bar.x = 0; bar.st = nullptr;
    if (multi) bar = xcd_barrier_post((unsigned*)(F.ctl + CW_BAR) + args.li * XCD_BAR_WORDS, F.MISC + 8);

    if (F.tid == 0) {
#pragma unroll
        for (int k = 0; k < 13; ++k) ((LAS unsigned long long*)(F.lds + INPTR_LDS_OFF))[k] = (unsigned long long)args.in[k]; }
    __syncthreads();
#define INP(k) in_ptr(F.lds, (k))
    float* const xres = args.out;
    float* const ssq = (float*)(ws + WS_SSQ);
    bf16* const XB = (bf16*)(ws + WS_XB);
    const int gw = F.vcu * NWAVES + F.wave, NGW = F.G * NWAVES;
    LAS float* const rl = (LAS float*)(F.lds + pg8::RSTD_LDS_OFF);

    for (int ph = args.ph_lo; ph < args.ph_hi; ++ph) {
      const int reps = 1 + ((args.skip_mask >> ph) & 1) * REP_EXTRA;
      for (int rp = 0; rp < reps; ++rp) {
        if (rp) xcd_barrier(bar);
        if (ph == PH_PRO) {
#ifndef NO_PRO
            int tid = threadIdx.x; asm volatile("" : "+v"(tid)); const int lane = tid & 63;
            constexpr int I_QKV = 16 * 144, I_O = 16 * 16, I_UP = 16 * 64, I_DN = 64 * 16, I_GLA = 16 * 49;
            constexpr int NITEMS = I_QKV + 2 * I_O + 2 * I_UP + 2 * I_DN + I_GLA;
            for (int it = gw; it < NITEMS; it += NGW) {
                int r = it; const float* W; int ldn, K = DM, nvalid = 64, dst_row0, k0, n0; const float* nw = nullptr; bf16* WT;
                if (r < I_QKV) { const int kb = r / 144, nb = r % 144; n0 = nb * 64; const int nin = n0 % 3072, which = nin / 1024, j = nin % 1024;
                    const int jd = which < 2 ? ((j & ~0xC0) | ((j & 0x40) << 1) | ((j & 0x80) >> 1)) : j;
                    W = INP(4); ldn = AIN; nw = INP(1); WT = (bf16*)(ws + WS_WQKV); dst_row0 = n0 - j + jd; k0 = kb * 64; }
                else if ((r -= I_QKV) < I_O) { W = INP(5); ldn = DM; WT = (bf16*)(ws + WS_WO0); n0 = dst_row0 = (r % 16) * 64; k0 = (r / 16) * 64; }
                else if ((r -= I_O) < I_O) { W = INP(10); ldn = DM; WT = (bf16*)(ws + WS_WO1); n0 = dst_row0 = (r % 16) * 64; k0 = (r / 16) * 64; }
                else if ((r -= I_O) < I_UP) { W = INP(11); ldn = DFF; nw = INP(2); WT = (bf16*)(ws + WS_WUP0); n0 = dst_row0 = (r % 64) * 64; k0 = (r / 64) * 64; }
                else if ((r -= I_UP) < I_UP) { W = INP(11) + (size_t)DM * DFF; ldn = DFF; nw = INP(2) + DM; WT = (bf16*)(ws + WS_WUP1); n0 = dst_row0 = (r % 64) * 64; k0 = (r / 64) * 64; }
                else if ((r -= I_UP) < I_DN) { W = INP(12); ldn = DM; K = DFF; WT = (bf16*)(ws + WS_WDN0); n0 = dst_row0 = (r % 16) * 64; k0 = (r / 16) * 64; }
                else if ((r -= I_DN) < I_DN) { W = INP(12) + (size_t)DFF * DM; ldn = DM; K = DFF; WT = (bf16*)(ws + WS_WDN1); n0 = dst_row0 = (r % 16) * 64; k0 = (r / 16) * 64; }
                else { r -= I_DN; const int kb = r / 49, nb = r % 49; W = INP(6); ldn = GIN; nw = INP(1) + DM; k0 = kb * 64; n0 = nb * 64;
                    if (nb < 48) { WT = (bf16*)(ws + WS_WGLA); dst_row0 = n0; } else { WT = (bf16*)(ws + WS_WG); dst_row0 = 0; nvalid = 16; } }
                xpose_item(W, ldn, K, nw, WT, dst_row0, k0, n0, nvalid, lane);
            }
            { float* cosT = (float*)(ws + WS_COS); float* sinT = (float*)(ws + WS_SIN);
              for (int e = blockIdx.x * (NWAVES * 64) + tid; e < SEQ * 64; e += F.G * NWAVES * 64) { const int pos = e >> 6, i = e & 63;
                  const float ang = (float)pos * ROPE_INVF[i]; float sn, cs; sincos_f(ang, sn, cs); cosT[e] = cs; sinT[e] = sn; } }
            const float* x_in = INP(0);
            for (int m = gw; m < MTOK; m += NGW) { const GAS f32x4* xr = (const GAS f32x4*)(x_in + (size_t)m * DM) + lane; float s = 0.f;
                GAS unsigned long long* o8 = (GAS unsigned long long*)(XB + (size_t)m * DM) + lane;
#pragma unroll
                for (int j = 0; j < 4; ++j) { const f32x4 v = xr[64 * j]; s += (v.x * v.x + v.y * v.y) + (v.z * v.z + v.w * v.w);
                    o8[64 * j] = (unsigned long long)pkh(v.x, v.y) | ((unsigned long long)pkh(v.z, v.w) << 32); }
                s = wave_sum(s); if (lane < 16) ssq[(size_t)m * 16 + lane] = lane == 0 ? s : 0.f; }
#endif
        }
        else if (ph == PH_QKV0 || ph == PH_QKV1 || ph == PH_QKV2) {
            const int g = (ph - PH_QKV0) >> 1;
            pg8::Gemm gm{XB, (const bf16*)(ws + WS_WQKV) + (size_t)g * 3072 * DM, MTOK, 3072, DM}; pg8::RstdOrder S; S.init(MTOK, 3072, F.G, (int)blockIdx.x); S.ssq = ssq; S.rl = rl;
            pg8::EpiQKV E{(bf16*)(ws + WS_Q), (bf16*)(ws + WS_K), (bf16*)(ws + WS_V), rl, (const float*)(ws + WS_COS), (const float*)(ws + WS_SIN), g == 0 ? 0 : (g == 1 ? 2 : 4)};
#ifndef NO_QKV
            pg8::gemm_phase<pg8::EpiQKV, pg8::RstdOrder, true, true>(F.lds + RING_OFF, gm, S, E);
#endif
        }
        else if (ph == PH_ATT0 || ph == PH_ATT1 || ph == PH_ATT2) {
            const int g = (ph - PH_ATT0) >> 1;
            swa::attn_phase((char*)lds, F.vcu, F.G, g == 0 ? 0 : (g == 1 ? 2 : 4), (const swa::u16*)(ws + WS_Q), (const swa::u16*)(ws + WS_K), (const swa::u16*)(ws + WS_V), (swa::u16*)(ws + WS_OM), (float*)(ws + WS_LSE), g == 0);
        }
        else if (ph == PH_WO0 || ph == PH_DN0 || ph == PH_WO1 || ph == PH_DN1) {
            const bf16* A; const bf16* Bt; int K; const float* resid = xres; bf16* xbo = XB;
            if (ph == PH_WO0) { A = (const bf16*)(ws + WS_OM); Bt = (const bf16*)(ws + WS_WO0); K = DM; resid = INP(0); }
            else if (ph == PH_DN0) { A = (const bf16*)(ws + WS_H); Bt = (const bf16*)(ws + WS_WDN0); K = DFF; }
            else if (ph == PH_WO1) { A = XB; Bt = (const bf16*)(ws + WS_WO1); K = DM; xbo = (bf16*)(ws + WS_XB1); }
            else { A = (const bf16*)(ws + WS_H); Bt = (const bf16*)(ws + WS_WDN1); K = DFF; }
            pg8::Gemm gm{A, Bt, MTOK, DM, K}; pg8::PlainOrder S; S.init(MTOK, DM, F.G, (int)blockIdx.x);
            pg8::EpiResid E{resid, xres, xbo, ssq};
#ifndef NO_RES
            pg8::gemm_phase<pg8::EpiResid, pg8::PlainOrder, false, true>(F.lds + RING_OFF, gm, S, E);
#endif
        }
        else if (ph == PH_UP0 || ph == PH_UP1) {
            const bf16* A = ph == PH_UP0 ? XB : (const bf16*)(ws + WS_XB1);
            pg8::Gemm gm{A, (const bf16*)(ws + (ph == PH_UP0 ? WS_WUP0 : WS_WUP1)), MTOK, DFF, DM}; pg8::RstdOrder S; S.init(MTOK, DFF, F.G, (int)blockIdx.x); S.ssq = ssq; S.rl = rl;
            pg8::EpiUp E{(bf16*)(ws + WS_H), rl};
#ifndef NO_UP
            pg8::gemm_phase<pg8::EpiUp, pg8::RstdOrder, true, true>(F.lds + RING_OFF, gm, S, E);
#endif
        }
        else if (ph == PH_GLAP) {
            { pg8::Gemm gm{XB, (const bf16*)(ws + WS_WGLA), MTOK, 3072, DM}; pg8::RstdOrder S; S.init(MTOK, 3072, F.G, (int)blockIdx.x); S.ssq = ssq; S.rl = rl;
              pg8::EpiGla E{(bf16*)(ws + WS_GQ), (bf16*)(ws + WS_GK), (bf16*)(ws + WS_GV), (bf16*)(ws + WS_GG), rl};
#ifndef NO_GLAP
              pg8::gemm_phase<pg8::EpiGla, pg8::RstdOrder, true, true>(F.lds + RING_OFF, gm, S, E);
#endif
 }
#ifndef NO_GATE
            __syncthreads();
            int tid = threadIdx.x; asm volatile("" : "+v"(tid)); const int lane = tid & 63;
            { LAS float* Pp = (LAS float*)(F.lds + RING_OFF);
              LAS float* Rr = Pp + 2048;
              LAS float* Gg = Pp + 2048 + 64;
              const bf16* WG = (const bf16*)(ws + WS_WG); const float* wgu = INP(7); const float* bg = INP(8); float* GB = (float*)(ws + WS_GB);
              for (int ch = F.vcu; ch < MTOK / GCH; ch += F.G) {
                  { const int mt = F.wave & 3, kh = F.wave >> 2, fr = lane & 15, fq = lane >> 4;
                    const GAS v4u* ap = (const GAS v4u*)(XB + (size_t)(ch * GCH + 16 * mt + fr) * DM + 512 * kh + 8 * fq);
                    const GAS v4u* bp = (const GAS v4u*)(WG + (size_t)fr * DM + 512 * kh + 8 * fq);
                    f32x4 acc = {0.f, 0.f, 0.f, 0.f};
#pragma unroll 8
                    for (int ks = 0; ks < 16; ++ks) { const v4u av = ap[4 * ks], bv = bp[4 * ks];
                        acc = __builtin_amdgcn_mfma_f32_16x16x32_f16(__builtin_bit_cast(pg8::f16x8, av), __builtin_bit_cast(pg8::f16x8, bv), acc, 0, 0, 0); }
#pragma unroll
                    for (int r = 0; r < 4; ++r) Pp[(kh * 64 + 16 * mt + 4 * fq + r) * 16 + fr] = acc[r];
                    if (tid < 64) { const f32x4* sp = (const f32x4*)(ssq + (size_t)(ch * GCH + tid) * 16); const f32x4 s0 = sp[0], s1 = sp[1], s2 = sp[2], s3 = sp[3];
                        const float sq = (((s0[0] + s0[1]) + (s0[2] + s0[3])) + ((s1[0] + s1[1]) + (s1[2] + s1[3]))) + (((s2[0] + s2[1]) + (s2[2] + s2[3])) + ((s3[0] + s3[1]) + (s3[2] + s3[3])));
                        Rr[tid] = 1.0f / sqrtf(sq * (1.0f / DM) + EPS); } }
                  LDS_WAIT(); __syncthreads();
                  { const int t = tid >> 3, j0 = (tid & 7) * 2; const float rs = Rr[t];
                    Gg[t * 16 + j0] = (Pp[t * 16 + j0] + Pp[1024 + t * 16 + j0]) * rs; Gg[t * 16 + j0 + 1] = (Pp[t * 16 + j0 + 1] + Pp[1024 + t * 16 + j0 + 1]) * rs; }
                  LDS_WAIT(); __syncthreads();
                  { const int c = tid; float wv[GRANK];
#pragma unroll
                    for (int j = 0; j < GRANK; ++j) wv[j] = wgu[j * GKD + c];
                    const float bc = bg[c]; float run = 0.f; float* gbp = GB + (size_t)(ch * GCH) * GKD + c;
#pragma unroll 4
                    for (int t = 0; t < GCH; ++t) { const f32x4 g0 = *(const LAS f32x4*)(Gg + t * 16), g1 = *(const LAS f32x4*)(Gg + t * 16 + 4), g2 = *(const LAS f32x4*)(Gg + t * 16 + 8), g3 = *(const LAS f32x4*)(Gg + t * 16 + 12);
                        float gk = bc;
#pragma unroll
                        for (int e = 0; e < 4; ++e) { gk += g0[e] * wv[e]; gk += g1[e] * wv[4 + e]; gk += g2[e] * wv[8 + e]; gk += g3[e] * wv[12 + e]; }
                        const float ls = fminf(gk, 0.f) - __logf(1.0f + __expf(-fabsf(gk)));
                        run += ls * (1.0f / 16.0f); gbp[(size_t)t * GKD] = run; } }
                  __syncthreads();
              } }
#endif
        }
        else if (ph == PH_GLA1 || ph == PH_GLA2 || ph == PH_GLA3) {
#if GLA_SIMPLE
            if (ph == PH_GLA3) gla_simple_phase(F.lds + RING_OFF, F.vcu, (const bf16*)(ws + WS_GQ), (const bf16*)(ws + WS_GK), (const bf16*)(ws + WS_GV), (const bf16*)(ws + WS_GG), (const float*)(ws + WS_GB), INP(9), XB);
#else
            const gla::Tensors T{(const bf16*)(ws + WS_GQ), (const bf16*)(ws + WS_GK), (const bf16*)(ws + WS_GV), (const bf16*)(ws + WS_GG), (const float*)(ws + WS_GB), INP(9), (float*)(ws + WS_GS), (float*)(ws + WS_GD), XB};
            if (ph == PH_GLA1) gla::gla1_phase(F.lds + RING_OFF, F.vcu, T);
            else if (ph == PH_GLA2) gla::gla2_phase(F.vcu, F.G, T);
            else gla::gla3_phase(F.lds + RING_OFF, F.vcu, T);
#endif
        }
        else if (ph == PH_FIN) {
            int tid = threadIdx.x; asm volatile("" : "+v"(tid)); const int lane = tid & 63;
            const float* final_w = INP(3);
            for (int m = gw; m < MTOK; m += NGW) { GAS f32x4* xr = (GAS f32x4*)(xres + (size_t)m * DM) + lane; f32x4 v[4]; float s = 0.f;
#pragma unroll
                for (int j = 0; j < 4; ++j) { v[j] = xr[64 * j]; s += (v[j].x * v[j].x + v[j].y * v[j].y) + (v[j].z * v[j].z + v[j].w * v[j].w); }
                const float rstd = 1.0f / sqrtf(wave_sum(s) * (1.0f / DM) + EPS);
#pragma unroll
                for (int j = 0; j < 4; ++j) { const f32x4 w = *((const f32x4*)final_w + lane + 64 * j); f32x4 y = v[j] * rstd * w;
                    xr[64 * j] = y; } }
        }
      }
      if (ph + 1 < args.ph_hi) xcd_barrier(bar);
    }
}

__global__ void __launch_bounds__(256) naive_attn(const bf16* __restrict__ Q, const bf16* __restrict__ K, const bf16* __restrict__ V, bf16* OM, float* LSE, int g, int ldil) {
    __shared__ float qs[4][128];
    const int lane = threadIdx.x & 63, wv = threadIdx.x >> 6;
    const int item = blockIdx.x * 4 + wv, row = item >> 3, h = item & 7;
    const int b = row >> 13, t = row & (SEQ - 1), r = t & ((1 << ldil) - 1), i = t >> ldil, L = SEQ >> ldil;
    const size_t base = (size_t)((((b * AH + h) << ldil) + r)) * L;
    const bf16* Qr = Q + (base + i) * HD; const bf16* Ks = K + base * HD; const bf16* Vs = V + base * HD;
    qs[wv][lane] = h2f(Qr[lane]); qs[wv][lane + 64] = h2f(Qr[lane + 64]);
    __syncthreads();
    float sc[3];
#pragma unroll
    for (int sl = 0; sl < 3; ++sl) { const int jj = lane + 64 * sl; float s = -INFINITY;
        if (jj <= 128 && i - jj >= 0) { const v4u* kp = (const v4u*)(Ks + (size_t)(i - jj) * HD); s = 0.f;
            for (int c = 0; c < 16; ++c) { const v4u kv = kp[c];
#pragma unroll
                for (int e = 0; e < 4; ++e) s += qs[wv][8 * c + 2 * e] * hlo(kv[e]) + qs[wv][8 * c + 2 * e + 1] * hhi(kv[e]); }
            s *= 0.08838834764831845f; }
        sc[sl] = s; }
    float m = fmaxf(fmaxf(sc[0], sc[1]), sc[2]);
#pragma unroll
    for (int o = 1; o < 64; o <<= 1) m = fmaxf(m, __shfl_xor(m, o));
    float p[3], l = 0.f;
#pragma unroll
    for (int sl = 0; sl < 3; ++sl) { p[sl] = expf(sc[sl] - m); l += p[sl]; }
    l = wave_sum(l);
    float o0 = 0.f, o1 = 0.f;
#pragma unroll
    for (int sl = 0; sl < 3; ++sl)
        for (int ll = 0; ll < 64; ++ll) { const int jj = sl * 64 + ll; if (jj > 128 || i - jj < 0) break;
            const float pj = __shfl(p[sl], ll); const unsigned vv = ((const unsigned*)(Vs + (size_t)(i - jj) * HD))[lane];
            o0 += pj * hlo(vv); o1 += pj * hhi(vv); }
    o0 /= l; o1 /= l; float lse = m + logf(l);
    unsigned* op = (unsigned*)(OM + (size_t)row * DM + h * HD) + lane;
    if (g > 0) { const float lo = LSE[(size_t)row * 8 + h]; const unsigned ov = *op; const float mx = fmaxf(lo, lse), wo = expf(lo - mx), wn = expf(lse - mx), inv = 1.0f / (wo + wn);
        o0 = (wo * hlo(ov) + wn * o0) * inv; o1 = (wo * hhi(ov) + wn * o1) * inv; lse = mx + logf(wo + wn); }
    *op = pkh(o0, o1);
    if (lane == 0) LSE[(size_t)row * 8 + h] = lse;
}
__global__ void __launch_bounds__(1024) naive_gla(const bf16* __restrict__ q, const bf16* __restrict__ k, const bf16* __restrict__ v, const bf16* __restrict__ g, const float* __restrict__ Bc,
                                                    const float* __restrict__ normw, bf16* GO) {
    __shared__ float red[2][16];
    __shared__ __attribute__((aligned(16))) float as_[2][128], ks_[2][128], qs_[2][128];
    const int tid = threadIdx.x, vloc = tid >> 2, qt = tid & 3, wv = tid >> 6, lane = tid & 63;
    const int b = blockIdx.x >> 2, h = blockIdx.x & 3;
    float S[32];
#pragma unroll
    for (int j = 0; j < 32; ++j) S[j] = 0.f;
    const float nw = normw[vloc];
    for (int t = 0; t < SEQ; ++t) { const size_t row = (size_t)b * SEQ + t; const int bf = t & 1;
        if (tid < 128) { const float* bp = Bc + row * GKD + h * GDK + tid; const float la = bp[0] - ((t & 63) ? bp[-GKD] : 0.f);
            as_[bf][tid] = expf(la); ks_[bf][tid] = bf2f(k[row * GKD + h * GDK + tid]); qs_[bf][tid] = bf2f(q[row * GKD + h * GDK + tid]) * 0.08838834764831845f; }
        const float vv = bf2f(v[row * GVD + h * GDV + vloc]);
        __syncthreads();
        float o = 0.f;
#pragma unroll
        for (int c = 0; c < 8; ++c) { const f32x4 a4 = *(const f32x4*)&as_[bf][qt * 32 + 4 * c], k4 = *(const f32x4*)&ks_[bf][qt * 32 + 4 * c], q4 = *(const f32x4*)&qs_[bf][qt * 32 + 4 * c];
#pragma unroll
            for (int e = 0; e < 4; ++e) { const int j = 4 * c + e; S[j] = a4[e] * S[j] + k4[e] * vv; o += q4[e] * S[j]; } }
        o += __shfl_xor(o, 1); o += __shfl_xor(o, 2);
        float sq = qt == 0 ? o * o : 0.f; sq = wave_sum(sq);
        if (lane == 0) red[bf][wv] = sq;
        __syncthreads();
        float tot = 0.f;
#pragma unroll
        for (int w = 0; w < 16; ++w) tot += red[bf][w];
        const float rstd = 1.0f / sqrtf(tot * (1.0f / GDV) + EPS);
        if (qt == 0) { const float gg = bf2f(g[row * GVD + h * GDV + vloc]); const float y = o * rstd * nw * (gg / (1.0f + expf(-gg))); GO[row * GVD + h * GDV + vloc] = __builtin_bit_cast(unsigned short, (_Float16)y); }
    }
}


__global__ void __launch_bounds__(256) probe_maxdiff_h(const unsigned short* a, const unsigned short* b, size_t n, unsigned* slot) {
    float m = 0.f;
    for (size_t i = (size_t)blockIdx.x * 256 + threadIdx.x; i < n; i += (size_t)gridDim.x * 256) { const float d = fabsf(h2f(a[i]) - h2f(b[i])); m = (d > m || d != d) ? (d != d ? 1e30f : d) : m; }
#pragma unroll
    for (int o = 1; o < 64; o <<= 1) m = fmaxf(m, __shfl_xor(m, o));
    if ((threadIdx.x & 63) == 0) atomicMax(slot, __float_as_uint(m));
}
__global__ void __launch_bounds__(256) probe_maxdiff_f(const float* a, const float* b, size_t n, unsigned* slot) {
    float m = 0.f;
    for (size_t i = (size_t)blockIdx.x * 256 + threadIdx.x; i < n; i += (size_t)gridDim.x * 256) { const float d = fabsf(a[i] - b[i]); m = (d > m || d != d) ? (d != d ? 1e30f : d) : m; }
#pragma unroll
    for (int o = 1; o < 64; o <<= 1) m = fmaxf(m, __shfl_xor(m, o));
    if ((threadIdx.x & 63) == 0) atomicMax(slot, __float_as_uint(m));
}
__global__ void __launch_bounds__(256) probe_encode(float* out, size_t n, const unsigned* slot, float scale) {
    const float d = sqrtf(scale * __uint_as_float(*slot));
    for (size_t i = (size_t)blockIdx.x * 256 + threadIdx.x; i < n; i += (size_t)gridDim.x * 256) out[i] += d;
}

#ifndef MK_MODE
#define MK_MODE 2
#endif
extern "C" void kernel_launch(void* const* d_in, const int* in_sizes, int n_in, void* d_out, int out_size, void* d_ws, size_t ws_size, hipStream_t stream) {
    static int grid = 0;
    if (grid == 0) {
        if (n_in != 13 || in_sizes[0] != MTOK * DM || out_size != MTOK * DM || ws_size < WS_END) { fprintf(stderr, "kernel_launch: unexpected shapes (n_in %d, in0 %d, out %d, ws %zu); nothing launched\n", n_in, n_in > 0 ? in_sizes[0] : -1, out_size, ws_size); grid = -1; return; }
        int dev = 0, cus = 0;
        if (hipGetDevice(&dev) != hipSuccess || hipDeviceGetAttribute(&cus, hipDeviceAttributeMultiprocessorCount, dev) != hipSuccess) { grid = -1; return; }
        if (hipFuncSetAttribute((const void*)mega_fwd, hipFuncAttributeMaxDynamicSharedMemorySize, LDS_BYTES) != hipSuccess) { fprintf(stderr, "kernel_launch: hipFuncSetAttribute failed\n"); grid = -1; return; }
        (void)hipGetLastError();
        grid = cus;
        if (grid != 256) fprintf(stderr, "kernel_launch: %d CUs (built for 256)\n", grid);
    }
    if (grid < 0) return;
    unsigned char* ws = (unsigned char*)d_ws;
    (void)hipMemsetAsync(ws + WS_CTL, 0, CTL_ZERO_BYTES, stream);
    Args a{};
    for (int i = 0; i < 13; ++i) a.in[i] = (const float*)d_in[i];
    a.out = (float*)d_out; a.ws = ws;
#define MEGA(lo, hi, li_) do { a.ph_lo = (lo); a.ph_hi = (hi); a.li = (li_); hipLaunchKernelGGL(mega_fwd, dim3(grid), dim3(NWAVES * 64), LDS_BYTES, stream, a); } while (0)
#if MK_MODE == 0 || MK_MODE == 1
    a.skip_mask = 0;
    MEGA(PH_PRO, PH_PRO + 1, 0);
    for (int g = 0; g < NGRP; ++g) { MEGA(PH_QKV0 + 2 * g, PH_QKV0 + 2 * g + 1, 0);
#if MK_MODE == 0
        hipLaunchKernelGGL(naive_attn, dim3(MTOK * AH / 4), dim3(256), 0, stream, (const bf16*)(ws + WS_Q), (const bf16*)(ws + WS_K), (const bf16*)(ws + WS_V), (bf16*)(ws + WS_OM), (float*)(ws + WS_LSE), g, grp_ldil(g));
#else
        MEGA(PH_ATT0 + 2 * g, PH_ATT0 + 2 * g + 1, 0);
#endif
    }
    MEGA(PH_WO0, PH_WO0 + 1, 0); MEGA(PH_UP0, PH_UP0 + 1, 0); MEGA(PH_DN0, PH_DN0 + 1, 0); MEGA(PH_GLAP, PH_GLAP + 1, 0);
    hipLaunchKernelGGL(naive_gla, dim3(BATCH * GH), dim3(1024), 0, stream, (const bf16*)(ws + WS_GQ), (const bf16*)(ws + WS_GK), (const bf16*)(ws + WS_GV), (const bf16*)(ws + WS_GG), (const float*)(ws + WS_GB),
                       (const float*)d_in[9], (bf16*)(ws + WS_XB));
    MEGA(PH_WO1, PH_WO1 + 1, 0); MEGA(PH_UP1, PH_UP1 + 1, 0); MEGA(PH_DN1, PH_DN1 + 1, 0); MEGA(PH_FIN, PH_FIN + 1, 0);
#elif MK_MODE == 3
    a.skip_mask = 0;
    unsigned* slot = (unsigned*)(ws + WS_CTL) + 2048; unsigned* slot2 = slot + 64;
    unsigned short* OM2 = (unsigned short*)d_out; float* LSE2 = (float*)((char*)d_out + 48 * MiB);
    MEGA(PH_PRO, PH_PRO + 1, 0);
    for (int g = 0; g < NGRP; ++g) { MEGA(PH_QKV0 + 2 * g, PH_QKV0 + 2 * g + 1, 0);
        hipLaunchKernelGGL(naive_attn, dim3(MTOK * AH / 4), dim3(256), 0, stream, (const bf16*)(ws + WS_Q), (const bf16*)(ws + WS_K), (const bf16*)(ws + WS_V), (bf16*)OM2, LSE2, g, grp_ldil(g));
        MEGA(PH_ATT0 + 2 * g, PH_ATT0 + 2 * g + 1, 0); }
    hipLaunchKernelGGL(probe_maxdiff_h, dim3(2048), dim3(256), 0, stream, (const unsigned short*)(ws + WS_OM), (const unsigned short*)OM2, (size_t)MTOK * DM, slot);
    hipLaunchKernelGGL(probe_maxdiff_f, dim3(256), dim3(256), 0, stream, (const float*)(ws + WS_LSE), (const float*)LSE2, (size_t)MTOK * 8, slot2);
    MEGA(PH_WO0, PH_WO0 + 1, 0); MEGA(PH_UP0, PH_UP0 + 1, 0); MEGA(PH_DN0, PH_DN0 + 1, 0); MEGA(PH_GLAP, PH_GLAP + 1, 0);
    hipLaunchKernelGGL(naive_gla, dim3(BATCH * GH), dim3(1024), 0, stream, (const bf16*)(ws + WS_GQ), (const bf16*)(ws + WS_GK), (const bf16*)(ws + WS_GV), (const bf16*)(ws + WS_GG), (const float*)(ws + WS_GB),
                       (const float*)d_in[9], (bf16*)(ws + WS_XB));
    MEGA(PH_WO1, PH_WO1 + 1, 0); MEGA(PH_UP1, PH_UP1 + 1, 0); MEGA(PH_DN1, PH_DN1 + 1, 0); MEGA(PH_FIN, PH_FIN + 1, 0);
    hipLaunchKernelGGL(probe_encode, dim3(2048), dim3(256), 0, stream, (float*)d_out, (size_t)MTOK * DM, slot, 1.0f);
    hipLaunchKernelGGL(probe_encode, dim3(2048), dim3(256), 0, stream, (float*)d_out, (size_t)MTOK * DM, slot2, 1e-3f);
#elif MK_MODE == 4
    a.skip_mask = 0;
    unsigned* slot = (unsigned*)(ws + WS_CTL) + 2048;
    for (int p = PH_PRO; p <= PH_GLA3; ++p) MEGA(p, p + 1, 0);
    hipLaunchKernelGGL(naive_gla, dim3(BATCH * GH), dim3(1024), 0, stream, (const bf16*)(ws + WS_GQ), (const bf16*)(ws + WS_GK), (const bf16*)(ws + WS_GV), (const bf16*)(ws + WS_GG), (const float*)(ws + WS_GB),
                       (const float*)d_in[9], (bf16*)(ws + WS_GS));
    hipLaunchKernelGGL(probe_maxdiff_h, dim3(2048), dim3(256), 0, stream, (const unsigned short*)(ws + WS_XB), (const unsigned short*)(ws + WS_GS), (size_t)MTOK * DM, slot);
    MEGA(PH_WO1, PH_WO1 + 1, 0); MEGA(PH_UP1, PH_UP1 + 1, 0); MEGA(PH_DN1, PH_DN1 + 1, 0); MEGA(PH_FIN, PH_FIN + 1, 0);
    hipLaunchKernelGGL(probe_encode, dim3(2048), dim3(256), 0, stream, (float*)d_out, (size_t)MTOK * DM, slot, 1e-2f);
#else
    a.skip_mask = REP_MASK;
    MEGA(0, PH_N, 0);
#endif
#undef MEGA
}
```

```cpp
#include <hip/hip_runtime.h>
#include <cstdio>
#include <cstdint>
#include <cmath>
#include <hip/hip_runtime.h>
#include <cstdio>
#include <cstdint>
namespace pg8 {
#define PG8_LAS __attribute__((address_space(3)))
typedef unsigned short bf16_t;
typedef short bf16x8 __attribute__((ext_vector_type(8)));
typedef _Float16 f16x8 __attribute__((ext_vector_type(8)));
typedef float f32x4 __attribute__((ext_vector_type(4)));
typedef unsigned u32x4 __attribute__((ext_vector_type(4)));
constexpr int BM = 256, BK = 64, HALF = 128, HTB = HALF * BK * 2  , STAGE_BYTES = 8 * HTB, NXCD = 8, WGM = 8;

__host__ __device__ __forceinline__ int lds_byte(int r, int c) { const int st = (r >> 4) * 2 + (c >> 5), rr = r & 15, cc = c & 31, ob = rr * 64 + cc * 2; return st * 1024 + (ob ^ (((ob >> 9) & 1) << 5)); }
__host__ __device__ __forceinline__ void stage_rc(int b, int& R, int& C) { const int st = b / 1024, sb = b % 1024, swz = sb ^ (((sb >> 9) & 1) << 5); R = (st >> 1) * 16 + swz / 64; C = (st & 1) * 32 + (swz % 64) / 2; }
__host__ __device__ __forceinline__ int perm32(int rho) { const int n = rho >> 4, i = rho & 15; return 8 * (i >> 2) + 4 * n + (i & 3); }

struct Unit { int pm, pn; };
struct Gemm { const bf16_t* A; const bf16_t* Bt; int M, N, K; };

struct StaticOrder {
    int nM, nN, nwg, G, c;
    __host__ __device__ void init(int M, int N, int G_, int c_) { nM = M / BM; nN = N / BM; nwg = nM * nN; G = G_; c = c_; }
    __host__ __device__ bool next(int i, Unit& u) const {
        const long L = (long)i * G + c; if (L >= nwg) return false;
        int wgid = (int)L; { const int q = nwg / NXCD, r = nwg % NXCD, xcd = wgid % NXCD, off = wgid / NXCD; wgid = (xcd < r ? xcd * (q + 1) : r * (q + 1) + (xcd - r) * q) + off; }
        const int nig = WGM * nN, gid = wgid / nig, fm = gid * WGM, gsz = (nM - fm) < WGM ? (nM - fm) : WGM;
        u.pm = fm + ((wgid % nig) % gsz); u.pn = (wgid % nig) / gsz; return true;
    }
    __device__ __forceinline__ void a_ready(const Unit&) const {}
    __device__ __forceinline__ void done(const Unit&) const {}
};

typedef __bf16 bf16x2_t __attribute__((ext_vector_type(2))); typedef float f32x2_t __attribute__((ext_vector_type(2)));
__device__ __forceinline__ unsigned cvt_pk_bf16(float lo, float hi) { const f32x2_t v = {lo, hi}; return __builtin_bit_cast(unsigned, __builtin_convertvector(v, bf16x2_t)); }
typedef unsigned u32x2 __attribute__((ext_vector_type(2)));
typedef _Float16 h16x2 __attribute__((ext_vector_type(2)));
typedef float f32x2 __attribute__((ext_vector_type(2)));
__device__ __forceinline__ unsigned cvt_pk_h(float lo, float hi) { const f32x2 v = {lo, hi}; return __builtin_bit_cast(unsigned, __builtin_convertvector(v, h16x2)); }
constexpr int P_SEQ = 8192, P_DM = 1024, P_DFF = 4096, P_AH = 8, P_HD = 128;
constexpr int RSTD_LDS_OFF = 131072 + 512;
struct PlainOrder : StaticOrder { __device__ __forceinline__ void a_ready(const Unit&, int) const {} };
struct RstdOrder : StaticOrder {
    const float* ssq; PG8_LAS float* rl;
    __device__ __forceinline__ void a_ready(const Unit& u, int ui) const {
        int t = threadIdx.x; asm volatile("" : "+v"(t));
        const int row = t >> 1, hf = t & 1;
        const f32x4* p = (const f32x4*)(ssq + (size_t)(u.pm * BM + row) * 16 + hf * 8); const f32x4 a = p[0], b = p[1];
        float s = ((a[0] + a[1]) + (a[2] + a[3])) + ((b[0] + b[1]) + (b[2] + b[3])); s += __shfl_xor(s, 1);
        if (hf == 0) rl[(ui & 1) * 256 + row] = 1.0f / sqrtf(s * (1.0f / 1024.0f) + 1e-5f);
    }
};
__device__ __forceinline__ void row_rstd(const PG8_LAS float* rl, int ui, int wr, int fr, float (&rs)[2][4]) {
#pragma unroll
    for (int ai = 0; ai < 2; ++ai)
#pragma unroll
        for (int m = 0; m < 4; ++m) rs[ai][m] = rl[(ui & 1) * 256 + ai * HALF + wr * 64 + m * 16 + fr];
}
__device__ __forceinline__ float hlo_(unsigned w) { return (float)__builtin_bit_cast(h16x2, w)[0]; }
__device__ __forceinline__ float hhi_(unsigned w) { return (float)__builtin_bit_cast(h16x2, w)[1]; }
__device__ __forceinline__ u32x4 pack8h(const f32x4 a, const f32x4 b) { u32x4 w; w.x = cvt_pk_h(a[0], a[1]); w.y = cvt_pk_h(a[2], a[3]); w.z = cvt_pk_h(b[0], b[1]); w.w = cvt_pk_h(b[2], b[3]); return w; }
__device__ __forceinline__ u32x4 pack8(const f32x4 a, const f32x4 b) { u32x4 w; w.x = cvt_pk_bf16(a[0], a[1]); w.y = cvt_pk_bf16(a[2], a[3]); w.z = cvt_pk_bf16(b[0], b[1]); w.w = cvt_pk_bf16(b[2], b[3]); return w; }

struct EpiQKV {
    static constexpr bool PERM = true, AFTER_DRAIN = false;
    bf16_t* Q; bf16_t* K; bf16_t* V; const PG8_LAS float* rl; const bf16_t* cosT; const bf16_t* sinT; int ldil;
    __device__ __forceinline__ void operator()(const f32x4 (&acc)[2][2][4][2], const Unit& u, int wr, int wc, int fr, int fq, int ui) const {
        const int row0 = u.pm * BM + wr * 64 + fr;
        float rs[2][4]; row_rstd(rl, ui, wr, fr, rs);
        const int which = u.pn >> 2, hp = u.pn & 3, dmask = (1 << ldil) - 1, L = P_SEQ >> ldil;
        if (which < 2) {
            bf16_t* dst = which == 0 ? Q : K;
            const int head = 2 * hp + (wc >> 1), d0 = 32 * (wc & 1) + 8 * fq;
#pragma unroll
            for (int ai = 0; ai < 2; ++ai) {
                u32x4 cw[4], sw[4];
#pragma unroll
                for (int m = 0; m < 4; ++m) { const int t = (row0 + ai * HALF + m * 16) & (P_SEQ - 1);
                    cw[m] = *(const u32x4*)(cosT + t * 64 + d0); sw[m] = *(const u32x4*)(sinT + t * 64 + d0); }
#pragma unroll
                for (int m = 0; m < 4; ++m) { const int row = row0 + ai * HALF + m * 16, b = row >> 13, t = row & (P_SEQ - 1), r = t & dmask, i = t >> ldil;
                    bf16_t* p = dst + ((size_t)((((b * P_AH + head) << ldil) + r)) * L + i) * P_HD + d0;
                    const u32x4 cq = cw[m], sq = sw[m];
                    const f32x4 c0 = {hlo_(cq.x), hhi_(cq.x), hlo_(cq.y), hhi_(cq.y)}, c1 = {hlo_(cq.z), hhi_(cq.z), hlo_(cq.w), hhi_(cq.w)};
                    const f32x4 s0 = {hlo_(sq.x), hhi_(sq.x), hlo_(sq.y), hhi_(sq.y)}, s1 = {hlo_(sq.z), hhi_(sq.z), hlo_(sq.w), hhi_(sq.w)};
                    const float sc = rs[ai][m];
                    const f32x4 x1a = acc[ai][0][m][0] * sc, x1b = acc[ai][0][m][1] * sc, x2a = acc[ai][1][m][0] * sc, x2b = acc[ai][1][m][1] * sc;
                    const f32x4 o1a = x1a * c0 - x2a * s0, o1b = x1b * c1 - x2b * s1, o2a = x2a * c0 + x1a * s0, o2b = x2b * c1 + x1b * s1;
                    *(u32x4*)p = pack8h(o1a, o1b); *(u32x4*)(p + 64) = pack8h(o2a, o2b); }
                asm volatile("" ::: "memory"); }
        } else {
            const int dd = 32 * wc + 8 * fq;
#pragma unroll
            for (int ai = 0; ai < 2; ++ai)
#pragma unroll
                for (int m = 0; m < 4; ++m) { const int row = row0 + ai * HALF + m * 16, b = row >> 13, t = row & (P_SEQ - 1), r = t & dmask, i = t >> ldil;
                    const float sc = rs[ai][m];
#pragma unroll
                    for (int bj = 0; bj < 2; ++bj) { const int head = 2 * hp + bj;
                        bf16_t* p = V + ((size_t)((((b * P_AH + head) << ldil) + r)) * L + i) * P_HD + dd;
                        *(u32x4*)p = pack8h(acc[ai][bj][m][0] * sc, acc[ai][bj][m][1] * sc); } }
        }
    }
};
struct EpiResid {
    static constexpr bool PERM = false, AFTER_DRAIN = false;
    const float* resid; float* out; bf16_t* xb; float* ssq;
    __device__ __forceinline__ void operator()(const f32x4 (&acc)[2][2][4][2], const Unit& u, int wr, int wc, int fr, int fq, int ui) const {
        const int row0 = u.pm * BM + wr * 64 + fr, col0 = u.pn * BM + wc * 32 + 4 * fq;
#pragma unroll
        for (int ai = 0; ai < 2; ++ai) {
            f32x4 rv[4][2][2];
#pragma unroll
            for (int m = 0; m < 4; ++m) { const size_t off = (size_t)(row0 + ai * HALF + m * 16) * P_DM + col0;
#pragma unroll
                for (int bj = 0; bj < 2; ++bj)
#pragma unroll
                    for (int n = 0; n < 2; ++n) rv[m][bj][n] = *(const f32x4*)(resid + off + bj * HALF + n * 16); }
#pragma unroll
            for (int m = 0; m < 4; ++m) { const int row = row0 + ai * HALF + m * 16; const size_t off = (size_t)row * P_DM + col0; float s = 0.f;
#pragma unroll
                for (int bj = 0; bj < 2; ++bj)
#pragma unroll
                    for (int n = 0; n < 2; ++n) { const f32x4 v = acc[ai][bj][m][n] + rv[m][bj][n];
                        *(f32x4*)(out + off + bj * HALF + n * 16) = v; s += (v[0] * v[0] + v[1] * v[1]) + (v[2] * v[2] + v[3] * v[3]);
                        u32x2 w; w.x = cvt_pk_h(v[0], v[1]); w.y = cvt_pk_h(v[2], v[3]); *(u32x2*)(xb + off + bj * HALF + n * 16) = w; }
                s += __shfl_xor(s, 16); s += __shfl_xor(s, 32);
                if (fq == 0) ssq[(size_t)row * 16 + u.pn * 4 + wc] = s; }
            asm volatile("" ::: "memory"); }
    }
};
struct EpiUp {
    static constexpr bool PERM = true, AFTER_DRAIN = false;
    bf16_t* H; const PG8_LAS float* rl;
    __device__ __forceinline__ void operator()(const f32x4 (&acc)[2][2][4][2], const Unit& u, int wr, int wc, int fr, int fq, int ui) const {
        const int row0 = u.pm * BM + wr * 64 + fr, col0 = u.pn * BM + wc * 32 + 8 * fq;
        float rs[2][4]; row_rstd(rl, ui, wr, fr, rs);
#pragma unroll
        for (int ai = 0; ai < 2; ++ai)
#pragma unroll
            for (int m = 0; m < 4; ++m) { bf16_t* rowp = H + (size_t)(row0 + ai * HALF + m * 16) * P_DFF + col0; const float sc = rs[ai][m];
#pragma unroll
                for (int bj = 0; bj < 2; ++bj) { f32x4 v0 = acc[ai][bj][m][0] * sc, v1 = acc[ai][bj][m][1] * sc;
                    v0 = __builtin_elementwise_max(v0, (f32x4){0.f, 0.f, 0.f, 0.f}); v1 = __builtin_elementwise_max(v1, (f32x4){0.f, 0.f, 0.f, 0.f});
                    const f32x4 cap = {65504.f, 65504.f, 65504.f, 65504.f};
                    *(u32x4*)(rowp + bj * HALF) = pack8h(__builtin_elementwise_min(v0 * v0, cap), __builtin_elementwise_min(v1 * v1, cap)); } }
    }
};
struct EpiGla {
    static constexpr bool PERM = true, AFTER_DRAIN = false;
    bf16_t* q; bf16_t* k; bf16_t* v; bf16_t* g; const PG8_LAS float* rl;
    __device__ __forceinline__ void operator()(const f32x4 (&acc)[2][2][4][2], const Unit& u, int wr, int wc, int fr, int fq, int ui) const {
        const int row0 = u.pm * BM + wr * 64 + fr;
        float rs[2][4]; row_rstd(rl, ui, wr, fr, rs);
        bf16_t* dst; int ld, coff;
        if (u.pn < 2) { dst = q; ld = 512; coff = u.pn * 256; } else if (u.pn < 4) { dst = k; ld = 512; coff = (u.pn - 2) * 256; }
        else if (u.pn < 8) { dst = v; ld = 1024; coff = (u.pn - 4) * 256; } else { dst = g; ld = 1024; coff = (u.pn - 8) * 256; }
        const int col0 = coff + wc * 32 + 8 * fq;
#pragma unroll
        for (int ai = 0; ai < 2; ++ai)
#pragma unroll
            for (int m = 0; m < 4; ++m) { bf16_t* rowp = dst + (size_t)(row0 + ai * HALF + m * 16) * ld + col0; const float sc = rs[ai][m];
#pragma unroll
                for (int bj = 0; bj < 2; ++bj) *(u32x4*)(rowp + bj * HALF) = pack8(acc[ai][bj][m][0] * sc, acc[ai][bj][m][1] * sc); }
    }
};
template <class Epi, class Sched, bool ALIGN_EPI = false, bool SP2 = false>
__device__ __forceinline__ void gemm_phase(PG8_LAS unsigned char* lds, const Gemm g, const Sched& S, const Epi& E) {
    int tid_ = threadIdx.x; asm volatile("" : "+v"(tid_));
    const int tid = tid_, wid = __builtin_amdgcn_readfirstlane(tid >> 6), lane = tid & 63, wr = wid >> 2, wc = wid & 3, fr = lane & 15, fq = lane >> 4;
    const int K = g.K, nt = K / BK;
    unsigned voffA[2], voffB[2];
#pragma unroll
    for (int i = 0; i < 2; ++i) { int R, C; stage_rc(tid * 16 + i * 8192, R, C); const int Rb = Epi::PERM ? ((R & ~31) + perm32(R & 31)) : R;
        voffA[i] = (unsigned)(R * K + C) * 2u; voffB[i] = (unsigned)(Rb * K + C) * 2u; }
    const size_t kstep = (size_t)(BK * 2);
    const size_t hstep = (size_t)HALF * K * 2;
    const size_t tstep = 2 * hstep;
    const unsigned ldsw = (unsigned)wid * 1024u;
    const int aoff = lds_byte(wr * 64 + fr, fq * 8), boff = lds_byte(wc * 32 + fr, fq * 8);
#define PG8_SA(b, h) (((b) * 2 + (h)) * HTB)
#define PG8_SB(b, h) ((4 + (b) * 2 + (h)) * HTB)
#define PG8_STAGE(bufoff, gbase, voff) do { _Pragma("unroll") for (int _i = 0; _i < 2; ++_i) \
        __builtin_amdgcn_global_load_lds((const unsigned*)((const char*)(gbase) + (voff)[_i]), (PG8_LAS unsigned*)(lds + (bufoff) + ldsw + _i * 8192), 16, 0, 0); } while (0)
#define PG8_LDA(dst, b, h) do { _Pragma("unroll") for (int m = 0; m < 4; ++m) _Pragma("unroll") for (int k = 0; k < 2; ++k) dst[m][k] = *(const PG8_LAS bf16x8*)(lds + PG8_SA(b, h) + aoff + m * 2048 + k * 1024); } while (0)
#define PG8_LDB(dst, b, h) do { _Pragma("unroll") for (int n = 0; n < 2; ++n) _Pragma("unroll") for (int k = 0; k < 2; ++k) dst[n][k] = *(const PG8_LAS bf16x8*)(lds + PG8_SB(b, h) + boff + n * 2048 + k * 1024); } while (0)
#define PG8_MMA(ai, bj, At, Bt) do { __builtin_amdgcn_s_setprio(1); _Pragma("unroll") for (int m = 0; m < 4; ++m) _Pragma("unroll") for (int n = 0; n < 2; ++n) _Pragma("unroll") for (int k = 0; k < 2; ++k) \
        acc[ai][bj][m][n] = __builtin_amdgcn_mfma_f32_16x16x32_f16(__builtin_bit_cast(f16x8, Bt[n][k]), __builtin_bit_cast(f16x8, At[m][k]), acc[ai][bj][m][n], 0, 0, 0); __builtin_amdgcn_s_setprio(0); } while (0)
#define PG8_WAIT_V(n) asm volatile("s_waitcnt vmcnt(" #n ")" ::: "memory")
#define PG8_WAIT_L(n) asm volatile("s_waitcnt lgkmcnt(" #n ")" ::: "memory")
#define PG8_BAR __builtin_amdgcn_s_barrier()
#define PG8_SCHED __builtin_amdgcn_sched_barrier(0)
    Unit cur, nxt; int ui = 0;
    if (!S.next(0, cur)) return;
    f32x4 acc[2][2][4][2];
#pragma unroll
    for (int a = 0; a < 2; ++a)
#pragma unroll
        for (int b = 0; b < 2; ++b)
#pragma unroll
            for (int m = 0; m < 4; ++m)
#pragma unroll
                for (int n = 0; n < 2; ++n) acc[a][b][m][n] = (f32x4){0.f, 0.f, 0.f, 0.f};
    bf16x8 At[4][2], B0[2][2], B1[2][2];
    const char* cA = (const char*)g.A + (size_t)cur.pm * tstep; const char* cB = (const char*)g.Bt + (size_t)cur.pn * tstep;
    S.a_ready(cur, 0);
    if constexpr (SP2) {
        PG8_STAGE(PG8_SB(0, 0), cB, voffB); PG8_STAGE(PG8_SB(0, 1), cB + hstep, voffB); PG8_STAGE(PG8_SA(0, 0), cA, voffA); PG8_STAGE(PG8_SA(0, 1), cA + hstep, voffA);
        if (wr == 1) PG8_BAR;
        PG8_WAIT_V(2); PG8_BAR;
        PG8_STAGE(PG8_SB(1, 0), cB + kstep, voffB); PG8_STAGE(PG8_SA(1, 0), cA + kstep, voffA); PG8_STAGE(PG8_SB(1, 1), cB + hstep + kstep, voffB);
        PG8_WAIT_V(6); PG8_BAR;
    } else {
        PG8_STAGE(PG8_SB(0, 0), cB, voffB); PG8_STAGE(PG8_SA(0, 0), cA, voffA); PG8_STAGE(PG8_SB(0, 1), cB + hstep, voffB); PG8_STAGE(PG8_SA(0, 1), cA + hstep, voffA);
        if (wr == 1) PG8_BAR;
        PG8_WAIT_V(4); PG8_BAR;
        PG8_STAGE(PG8_SB(1, 0), cB + kstep, voffB); PG8_STAGE(PG8_SA(1, 0), cA + kstep, voffA); PG8_STAGE(PG8_SB(1, 1), cB + hstep + kstep, voffB);
        PG8_WAIT_V(6); PG8_BAR;
    }
    for (;;) {
        const bool has_next = S.next(ui + 1, nxt);
        const char* nA = has_next ? (const char*)g.A + (size_t)nxt.pm * tstep : cA; const char* nB = has_next ? (const char*)g.Bt + (size_t)nxt.pn * tstep : cB;
        for (int t = 0; t < nt; t += 2) {
            const bool last = (t == nt - 2);
            const char* a1 = cA + (size_t)(t + 1) * kstep;
            const char* a2 = last ? nA : cA + (size_t)(t + 2) * kstep; const char* b2 = last ? nB : cB + (size_t)(t + 2) * kstep;
            const char* a3 = a2 + kstep; const char* b3 = b2 + kstep;
            if (last && has_next) S.a_ready(nxt, ui + 1);
            if constexpr (SP2) {
            PG8_LDB(B0, 0, 0); PG8_LDB(B1, 0, 1); PG8_SCHED; PG8_LDA(At, 0, 0); PG8_STAGE(PG8_SA(1, 1), a1 + hstep, voffA);
            PG8_WAIT_V(8); PG8_WAIT_L(0); PG8_BAR; PG8_MMA(0, 0, At, B0); PG8_MMA(0, 1, At, B1); PG8_BAR; PG8_SCHED;
            PG8_LDA(At, 0, 1); PG8_STAGE(PG8_SB(0, 0), b2, voffB); PG8_STAGE(PG8_SB(0, 1), b2 + hstep, voffB); PG8_STAGE(PG8_SA(0, 0), a2, voffA);
            PG8_WAIT_V(8); PG8_WAIT_L(0); PG8_BAR; PG8_MMA(1, 0, At, B0); PG8_MMA(1, 1, At, B1); PG8_BAR; PG8_SCHED;
            PG8_LDB(B0, 1, 0); PG8_LDB(B1, 1, 1); PG8_SCHED; PG8_LDA(At, 1, 0); PG8_STAGE(PG8_SA(0, 1), a2 + hstep, voffA);
            PG8_WAIT_V(8); PG8_WAIT_L(0); PG8_BAR; PG8_MMA(0, 0, At, B0); PG8_MMA(0, 1, At, B1); PG8_BAR; PG8_SCHED;
            PG8_LDA(At, 1, 1); PG8_STAGE(PG8_SB(1, 0), b3, voffB); PG8_STAGE(PG8_SB(1, 1), b3 + hstep, voffB); PG8_STAGE(PG8_SA(1, 0), a3, voffA);
            PG8_WAIT_V(8); PG8_WAIT_L(0); PG8_BAR; PG8_MMA(1, 0, At, B0); PG8_MMA(1, 1, At, B1); PG8_BAR; PG8_SCHED;
            } else {
            PG8_LDB(B0, 0, 0); PG8_SCHED; PG8_LDA(At, 0, 0); PG8_STAGE(PG8_SA(1, 1), a1 + hstep, voffA);
            PG8_WAIT_L(8); PG8_BAR; PG8_WAIT_L(0); PG8_MMA(0, 0, At, B0); PG8_BAR; PG8_SCHED;
            PG8_LDB(B1, 0, 1); PG8_STAGE(PG8_SB(0, 0), b2, voffB);
            PG8_BAR; PG8_WAIT_L(0); PG8_MMA(0, 1, At, B1); PG8_BAR;
            PG8_LDA(At, 0, 1); PG8_STAGE(PG8_SA(0, 0), a2, voffA);
            PG8_BAR; PG8_WAIT_L(0); PG8_MMA(1, 0, At, B0); PG8_BAR; PG8_SCHED;
            PG8_STAGE(PG8_SB(0, 1), b2 + hstep, voffB);
            PG8_WAIT_V(6); PG8_BAR; PG8_MMA(1, 1, At, B1); PG8_BAR;
            PG8_LDB(B0, 1, 0); PG8_SCHED; PG8_LDA(At, 1, 0); PG8_STAGE(PG8_SA(0, 1), a2 + hstep, voffA);
            PG8_WAIT_L(8); PG8_BAR; PG8_WAIT_L(0); PG8_MMA(0, 0, At, B0); PG8_BAR; PG8_SCHED;
            PG8_LDB(B1, 1, 1); PG8_STAGE(PG8_SB(1, 0), b3, voffB);
            PG8_BAR; PG8_WAIT_L(0); PG8_MMA(0, 1, At, B1); PG8_BAR;
            PG8_LDA(At, 1, 1); PG8_STAGE(PG8_SA(1, 0), a3, voffA);
            PG8_BAR; PG8_WAIT_L(0); PG8_MMA(1, 0, At, B0); PG8_BAR; PG8_SCHED;
            PG8_STAGE(PG8_SB(1, 1), b3 + hstep, voffB);
            PG8_WAIT_V(6); PG8_BAR; PG8_MMA(1, 1, At, B1); PG8_BAR;
            }
        }
        if constexpr (ALIGN_EPI) { if (wr == 0) PG8_BAR; }
        if constexpr (!Epi::AFTER_DRAIN) { E(acc, cur, wr, wc, fr, fq, ui); S.done(cur); }
        if (!has_next) break;
#pragma unroll
        for (int a = 0; a < 2; ++a)
#pragma unroll
            for (int b = 0; b < 2; ++b)
#pragma unroll
                for (int m = 0; m < 4; ++m)
#pragma unroll
                    for (int n = 0; n < 2; ++n) acc[a][b][m][n] = (f32x4){0.f, 0.f, 0.f, 0.f};
        cur = nxt; cA = nA; cB = nB; ++ui;
        if constexpr (ALIGN_EPI) { if (wr == 1) PG8_BAR; }
    }
    PG8_WAIT_V(0);
    if constexpr (!ALIGN_EPI) { if (wr == 0) PG8_BAR; }
    PG8_BAR;
    if constexpr (Epi::AFTER_DRAIN) { E.fused(acc, cur, wr, wc, fr, fq, lds, wid, lane); S.done(cur); }
#undef PG8_SA
#undef PG8_SB
#undef PG8_STAGE
#undef PG8_LDA
#undef PG8_LDB
#undef PG8_MMA
#undef PG8_WAIT_V
#undef PG8_WAIT_L
#undef PG8_BAR
#undef PG8_SCHED
}
}
#define GAS __attribute__((address_space(1)))
#define LAS __attribute__((address_space(3)))
typedef unsigned short bf16;
typedef unsigned v4u __attribute__((ext_vector_type(4)));
typedef float f32x4 __attribute__((ext_vector_type(4)));
typedef short bf16x8 __attribute__((ext_vector_type(8)));
typedef GAS unsigned gu32;
typedef GAS unsigned long long gu64;
#define RLX_AGENT __ATOMIC_RELAXED, __HIP_MEMORY_SCOPE_AGENT
#define LDS_WAIT() asm volatile("s_waitcnt lgkmcnt(0)" ::: "memory")
#define VM_WAIT() asm volatile("s_waitcnt vmcnt(0)" ::: "memory")
__device__ __forceinline__ unsigned long long rt() { return __builtin_amdgcn_s_memrealtime(); }
__device__ __forceinline__ unsigned f2bf(float f) { unsigned u = __builtin_bit_cast(unsigned, f); return (u + 0x7fffu + ((u >> 16) & 1u)) >> 16; }
__device__ __forceinline__ unsigned pk2(float lo, float hi) { return f2bf(lo) | (f2bf(hi) << 16); }

#define XB_TMO      128
#define XB_XCNT(j)  (256  + 64 * (j))
#define XB_XSUB(j)  (1280 + 64 * (j))
#define XB_XGEN(j)  (2304 + 64 * (j))
#define XB_TOP      3328
#define XB_TOPGEN   3392
#define XCD_BAR_WORDS 3456
#define XB_SPIN_CAP (1u << 18)

__device__ __forceinline__ unsigned xb_ld(unsigned* p)              { return __hip_atomic_load(p, __ATOMIC_RELAXED, __HIP_MEMORY_SCOPE_AGENT); }
__device__ __forceinline__ unsigned xb_add(unsigned* p, unsigned v) { return __hip_atomic_fetch_add(p, v, __ATOMIC_RELAXED, __HIP_MEMORY_SCOPE_AGENT); }
__device__ __forceinline__ unsigned xb_xcc_id() { return (unsigned)__builtin_amdgcn_s_getreg((3 << 11) | 20) & 0xFu; }
#define XB_SPIN(cond, bar) do { unsigned _sp = 0; while (cond) { __builtin_amdgcn_s_sleep(1); \
    if ((++_sp & 255u) == 0u) { if (xb_ld(&(bar)[XB_TMO])) break; if (_sp > XB_SPIN_CAP) { atomicAdd(&(bar)[XB_TMO], 1u); break; } } } } while (0)

struct XcdBarrier {
    unsigned* bar; unsigned x;
    volatile LAS unsigned* st;
};

__device__ __forceinline__ XcdBarrier xcd_barrier_post(unsigned* bar, volatile LAS unsigned* st) {
    XcdBarrier b; b.bar = bar; b.x = xb_xcc_id(); b.st = st;
    if (threadIdx.x == 0) (void)xb_add(&bar[XB_XCNT(b.x)], 1u);
    return b;
}
__device__ __forceinline__ void xcd_barrier_complete(unsigned* bar, unsigned x, unsigned& nloc, unsigned& nx) {
    const unsigned G = gridDim.x * gridDim.y * gridDim.z;
    unsigned sum, cnt, mine, sp = 0u;
    for (;;) {
        sum = 0u; cnt = 0u; mine = 0u;
#pragma unroll
        for (unsigned j = 0; j < 16; ++j) { const unsigned c = xb_ld(&bar[XB_XCNT(j)]); sum += c; cnt += (c > 0u) ? 1u : 0u; mine = (j == x) ? c : mine; }
        if (sum == G) break;
        __builtin_amdgcn_s_sleep(1);
        if ((++sp & 255u) == 0u) { if (xb_ld(&bar[XB_TMO])) break; if (sp > XB_SPIN_CAP) { atomicAdd(&bar[XB_TMO], 1u); break; } }
    }
    nloc = mine > 0u ? mine : 1u; nx = cnt > 0u ? cnt : 1u;
}

__device__ __forceinline__ void xcd_barrier(const XcdBarrier& b) {
    asm volatile("s_waitcnt vmcnt(0)" ::: "memory");
    __syncthreads();
    if (threadIdx.x == 0) {
        unsigned* bar = b.bar;
        __builtin_amdgcn_s_waitcnt(0);
        unsigned nloc = b.st[0], nx = b.st[1];
        if (nloc == 0u) { xcd_barrier_complete(bar, b.x, nloc, nx); b.st[0] = nloc; b.st[1] = nx; }
        const unsigned old = xb_add(&bar[XB_XSUB(b.x)], 1u);
        const unsigned gen = old / nloc;
        if (old + 1u == (gen + 1u) * nloc) {
            __builtin_amdgcn_fence(__ATOMIC_RELEASE, "agent");
            asm volatile("s_waitcnt vmcnt(0)" ::: "memory");
            const unsigned og = xb_add(&bar[XB_TOP], 1u);
            const unsigned tg = og / nx;
            if (og + 1u == (tg + 1u) * nx) xb_add(&bar[XB_TOPGEN], 1u);
            else XB_SPIN(xb_ld(&bar[XB_TOPGEN]) == tg, bar);
            __builtin_amdgcn_fence(__ATOMIC_ACQUIRE, "agent");
            xb_add(&bar[XB_XGEN(b.x)], 1u);
            asm volatile("s_waitcnt vmcnt(0)" ::: "memory");
        } else {
            XB_SPIN(xb_ld(&bar[XB_XGEN(b.x)]) == gen, bar);
            __builtin_amdgcn_fence(__ATOMIC_ACQUIRE, "agent");
            asm volatile("s_waitcnt vmcnt(0)" ::: "memory");
        }
    }
    __syncthreads();
}

namespace swa {
typedef unsigned short u16;
typedef short bf16x8 __attribute__((ext_vector_type(8)));
typedef _Float16 f16x8 __attribute__((ext_vector_type(8)));
typedef short s16x4 __attribute__((ext_vector_type(4)));
typedef float f32x16 __attribute__((ext_vector_type(16)));
typedef float f32x4 __attribute__((ext_vector_type(4)));
typedef unsigned u32x4 __attribute__((ext_vector_type(4)));
constexpr int D = 128, W = 129;
constexpr float THR = 8.f;
constexpr float SCALE = 0.08838834764831845f;
constexpr int NW = 8, QBLK = 32, KVBLK = 64, QB = NW * QBLK;
constexpr int SHM_V = KVBLK * D * 2, SHM_K = KVBLK * D * 2;
constexpr int LDS_BYTES = 2 * SHM_V + 2 * SHM_K + NW * 64 * 4;
#define KSWZ(row, colB) ((row) * 256 + ((colB) ^ (((row) & 7) << 4)))
#define SBAR() __builtin_amdgcn_sched_barrier(0)
__device__ __forceinline__ int v_st(int k, int c) { const int kk = (k & ~0xC) | ((k & 4) << 1) | ((k & 8) >> 1); return ((kk >> 3) * 4 + (c >> 5)) * 512 + ((kk & 7) * 32 + (c & 31)) * 2; }
__device__ __forceinline__ int v_rd_base(int lane) { return ((lane & 3) << 3) | (((lane >> 2) & 3) << 6) | (((lane >> 4) & 1) << 5) | (((lane >> 5) & 1) << 8); }
constexpr int v_rd_off(int d0, int ks, int half) { return d0 * 512 + ks * 4096 + half * 2048; }
__device__ __forceinline__ int crow(int r, int hi) { return (r & 3) + 8 * (r >> 2) + 4 * hi; }
__device__ __forceinline__ unsigned cvtpk(float lo, float hi) { return pg8::cvt_pk_h(lo, hi); }
__device__ __forceinline__ float hlo(unsigned w) { return (float)__builtin_bit_cast(pg8::h16x2, w)[0]; }
__device__ __forceinline__ float hhi(unsigned w) { return (float)__builtin_bit_cast(pg8::h16x2, w)[1]; }
__device__ __forceinline__ bf16x8 load8(const u16* p) { return *reinterpret_cast<const bf16x8*>(p); }
#define SWA_MFMA(a, b, c) __builtin_amdgcn_mfma_f32_32x32x16_f16(__builtin_bit_cast(f16x8, a), __builtin_bit_cast(f16x8, b), c, 0, 0, 0)
__device__ __forceinline__ void mask_tile(f32x16& p0, f32x16& p1, int dq, unsigned Wd) {
    const float NEG = -__builtin_inff();
#pragma unroll
    for (int r = 0; r < 16; ++r) {
        const int c = (r & 3) + 8 * (r >> 2);
        if ((unsigned)(dq - c) >= Wd) p0[r] = NEG;
        if ((unsigned)(dq - c - 32) >= Wd) p1[r] = NEG;
    }
}
__device__ __forceinline__ void partialSM(f32x16& p0, f32x16& p1, float& m_reg, float& mn, float& alpha) {
    float pmax = p0[0]; for (int r = 1; r < 16; ++r) pmax = fmaxf(pmax, p0[r]); for (int r = 0; r < 16; ++r) pmax = fmaxf(pmax, p1[r]);
    { auto rr = __builtin_amdgcn_permlane32_swap(__float_as_uint(pmax), __float_as_uint(pmax), false, false);
      pmax = fmaxf(__uint_as_float(rr[0]), __uint_as_float(rr[1])); }
    constexpr float C2 = 1.4426950408889634f * SCALE;
    if (__builtin_expect(__all((pmax - m_reg) * SCALE <= THR), 1)) { mn = m_reg; alpha = 1.f; }
    else { mn = fmaxf(m_reg, pmax); alpha = __builtin_amdgcn_exp2f((m_reg - mn) * C2); m_reg = mn; }
    const float mnL = -mn * C2;
    for (int r = 0; r < 16; ++r) p0[r] = fmaf(p0[r], C2, mnL); for (int r = 0; r < 16; ++r) p1[r] = fmaf(p1[r], C2, mnL);
    for (int r = 0; r < 16; ++r) p0[r] = __builtin_amdgcn_exp2f(p0[r]);
}
__device__ __forceinline__ void finishSM(f32x16& p0, f32x16& p1, float alpha, float& l_reg, bf16x8& pa0, bf16x8& pa1, bf16x8& pa2, bf16x8& pa3) {
    for (int r = 0; r < 16; ++r) p1[r] = __builtin_amdgcn_exp2f(p1[r]);
    float ps = 0; for (int r = 0; r < 16; ++r) ps += p0[r]; for (int r = 0; r < 16; ++r) ps += p1[r];
    { auto rr = __builtin_amdgcn_permlane32_swap(__float_as_uint(ps), __float_as_uint(ps), false, false);
      ps = __uint_as_float(rr[0]) + __uint_as_float(rr[1]); }
    l_reg = l_reg * alpha + ps;
#define PK4(P, B_, OUT) do { unsigned a0 = cvtpk(P[B_+0], P[B_+1]), a1 = cvtpk(P[B_+2], P[B_+3]);                          \
        unsigned b0 = cvtpk(P[B_+4], P[B_+5]), b1 = cvtpk(P[B_+6], P[B_+7]);                                             \
        auto r0 = __builtin_amdgcn_permlane32_swap(a0, b0, false, false); auto r1 = __builtin_amdgcn_permlane32_swap(a1, b1, false, false); \
        u32x4 w = {r0[0], r1[0], r0[1], r1[1]}; OUT = *reinterpret_cast<bf16x8*>(&w); } while (0)
    PK4(p0, 0, pa0); PK4(p0, 8, pa1); PK4(p1, 0, pa2); PK4(p1, 8, pa3);
#undef PK4
}
template <int KB>
__device__ __forceinline__ void qkt(f32x16& p0, f32x16& p1, const char* K_lds, int r32, int hi, const bf16x8* qr, bool act) {
    if (!act) { const float NEG = -__builtin_inff();
#pragma unroll
        for (int r = 0; r < 16; ++r) { p0[r] = NEG; p1[r] = NEG; } return; }
    p0 = f32x16{}; p1 = f32x16{};
    const char* kb[4];
#pragma unroll
    for (int dd = 0; dd < 4; ++dd) kb[dd] = K_lds + KB * SHM_K + KSWZ(r32, (dd * 16 + hi * 8) * 2);
#pragma unroll
    for (int d0 = 0; d0 < 8; ++d0) { const char* a = kb[d0 & 3] + (d0 >> 2) * 128;
        bf16x8 b0 = *reinterpret_cast<const bf16x8*>(a);
        bf16x8 b1 = *reinterpret_cast<const bf16x8*>(a + 32 * 256);
        p0 = SWA_MFMA(b0, qr[d0], p0);
        p1 = SWA_MFMA(b1, qr[d0], p1); }
}
template <int VB>
__device__ __forceinline__ void pv_tile(f32x16* o, int vb0, bf16x8 pa0, bf16x8 pa1, bf16x8 pa2, bf16x8 pa3, bool act) {
    if (!act) return;
#define TRRD(dst, off) asm volatile("ds_read_b64_tr_b16 %0, %1 offset:%2" : "=&v"(dst) : "v"(vb0), "i"(off) : "memory")
#define PV_D0(d0) do { s16x4 l0, l1, l2, l3, h0, h1, h2, h3; constexpr int b_ = VB * SHM_V + v_rd_off(d0, 0, 0); \
        TRRD(l0, b_); TRRD(h0, b_ + 2048); TRRD(l1, b_ + 4096); TRRD(h1, b_ + 6144); TRRD(l2, b_ + 8192); TRRD(h2, b_ + 10240); TRRD(l3, b_ + 12288); TRRD(h3, b_ + 14336); \
        asm volatile("s_waitcnt lgkmcnt(0)" ::: "memory"); SBAR();   \
        o[d0] = SWA_MFMA(pa0, ((bf16x8){l0[0], l0[1], l0[2], l0[3], h0[0], h0[1], h0[2], h0[3]}), o[d0]);   \
        o[d0] = SWA_MFMA(pa1, ((bf16x8){l1[0], l1[1], l1[2], l1[3], h1[0], h1[1], h1[2], h1[3]}), o[d0]);   \
        o[d0] = SWA_MFMA(pa2, ((bf16x8){l2[0], l2[1], l2[2], l2[3], h2[0], h2[1], h2[2], h2[3]}), o[d0]);   \
        o[d0] = SWA_MFMA(pa3, ((bf16x8){l3[0], l3[1], l3[2], l3[3], h3[0], h3[1], h3[2], h3[3]}), o[d0]); } while (0)
    PV_D0(0); PV_D0(1); PV_D0(2); PV_D0(3);
#undef PV_D0
#undef TRRD
}
struct BlockRef { const u16* Q; const u16* K; const u16* V; int P0, skv, trow0, tstep, h; };
struct Seam { bf16x8 qr[8]; bf16x8 st_v0, st_v1, st_k0, st_k1; };
__device__ __forceinline__ int swa_jlo(int P0) { const int lowk = P0 - W + 1; return lowk > 0 ? lowk / KVBLK : 0; }
#define ROW(p, k0, rr) ((p) + (size_t)((k0) + (rr)) * D + sc)
#define VMW() asm volatile("s_waitcnt vmcnt(0)" ::: "memory")
#define VMWN(n) asm volatile("s_waitcnt vmcnt(%0)" :: "i"(n) : "memory")
#define SLOAD_H(Kp, Vp, k0) do { S.st_v0 = load8(ROW(Vp, k0, sr)); S.st_v1 = load8(ROW(Vp, k0, 32 + sr));              \
                         S.st_k0 = load8(ROW(Kp, k0, sr)); S.st_k1 = load8(ROW(Kp, k0, 32 + sr)); } while (0)
#define SWRITE_HK(bf) do { *(bf16x8*)(K_lds + (bf) * SHM_K + kws) = S.st_k0; *(bf16x8*)(K_lds + (bf) * SHM_K + kws + 32 * 256) = S.st_k1; } while (0)
#define SWRITE_HV(bf) do { *(bf16x8*)(V_lds + (bf) * SHM_V + vst0) = S.st_v0; *(bf16x8*)(V_lds + (bf) * SHM_V + vst1) = S.st_v1; } while (0)
#define SWRITE_H(bf) do { SWRITE_HV(bf); SWRITE_HK(bf); } while (0)
__device__ __forceinline__ void swa_prime(const BlockRef& cur, char* lds, Seam& S) {
    int tid = threadIdx.x; asm volatile("" : "+v"(tid));
    const int wid = __builtin_amdgcn_readfirstlane(tid >> 6), lane = tid & 63, r32 = lane & 31, hi = lane >> 5;
    const int sr = tid >> 4, sc = (tid & 15) * 8, kws = KSWZ(sr, sc * 2); char* K_lds = lds + 2 * SHM_V;
    const int kb0 = swa_jlo(cur.P0) * KVBLK;
    for (int d0 = 0; d0 < 8; ++d0) S.qr[d0] = load8(cur.Q + (size_t)(cur.P0 + wid * QBLK + r32) * D + d0 * 16 + hi * 8);
    SLOAD_H(cur.K, cur.V, kb0); VMW(); SWRITE_HK(0);
    __syncthreads();
}
__device__ __forceinline__ void swa_block(const BlockRef& cur, const BlockRef& nxt, char* lds, Seam& S, u16* OM, float* LSE, int first_group) {
    int tid = threadIdx.x; asm volatile("" : "+v"(tid));
    const int wid = __builtin_amdgcn_readfirstlane(tid >> 6), lane = tid & 63, r32 = lane & 31, hi = lane >> 5;
    const int j_lo = swa_jlo(cur.P0);
    int j_hi = (cur.P0 + QB - 1) / KVBLK + 1; if (j_hi > cur.skv / KVBLK) j_hi = cur.skv / KVBLK;
    const int NT = j_hi - j_lo;
    const int kbn = swa_jlo(nxt.P0) * KVBLK;
    const int qlo = cur.P0 + wid * QBLK, qm = qlo + r32 - 4 * hi;
    char* V_lds = lds; char* K_lds = lds + 2 * SHM_V;
    float* ws = (float*)(lds + 2 * SHM_V + 2 * SHM_K) + wid * 64; float* li_l = ws, * al_l = ws + 32;
    float m_reg = -1e30f, l_reg = 0; f32x16 o[4] = {};
    const int sr = tid >> 4, sc = (tid & 15) * 8, vst0 = v_st(sr, sc), vst1 = v_st(32 + sr, sc), kws = KSWZ(sr, sc * 2);
    const int vb0 = (int)(uintptr_t)V_lds + v_rd_base(lane);
    const u16* Kh = cur.K; const u16* Vh = cur.V;
#define RESC(a) do { if (__any((a) < 1.f)) { if (hi == 0) al_l[r32] = (a); asm volatile("s_waitcnt lgkmcnt(0)" ::: "memory");              \
                     for (int d_ = 0; d_ < 4; ++d_) for (int r = 0; r < 16; ++r) o[d_][r] *= al_l[crow(r, hi)]; } } while (0)
#define KBASE(t) ((j_lo + (t)) * KVBLK)
#define ACT(t) (KBASE(t) <= qlo + QBLK - 1 && KBASE(t) + KVBLK - 1 >= qlo - W + 1)
#define MASKT(P0_, P1_, t) do { const int kb_ = KBASE(t); if (ACT(t) && (kb_ + KVBLK - 1 > qlo || kb_ <= qlo + QBLK - 1 - W)) mask_tile(P0_, P1_, qm - kb_, (unsigned)W); } while (0)
    constexpr int NQL = 8;
#define SEAM_K0() do { VMWN(NQL); SWRITE_HK(0); SBAR(); } while (0)
    f32x16 pA0, pA1, pB0, pB1; float mnA, mnB, alA, alB; bf16x8 pa0, pa1, pa2, pa3;
    SWRITE_HV(0); SBAR();
    if (NT > 1) { SLOAD_H(Kh, Vh, KBASE(1)); }
    SBAR(); qkt<0>(pA0, pA1, K_lds, r32, hi, S.qr, ACT(0));
    MASKT(pA0, pA1, 0); partialSM(pA0, pA1, m_reg, mnA, alA);
    if (NT > 1) { VMW(); SWRITE_H(1); }
    __syncthreads();
#define HALF_STEP(PX0, PX1, mnX, alX, PY0, PY1, alY, t, KB, VB, SB) do {                                                      \
        SBAR(); qkt<KB>(PX0, PX1, K_lds, r32, hi, S.qr, ACT(t));                                             \
        finishSM(PY0, PY1, alY, l_reg, pa0, pa1, pa2, pa3); SBAR();                                                           \
        if ((t) + 1 < NT) { SLOAD_H(Kh, Vh, KBASE((t) + 1)); SBAR(); }                                               \
        pv_tile<VB>(o, vb0, pa0, pa1, pa2, pa3, ACT((t) - 1)); MASKT(PX0, PX1, (t)); partialSM(PX0, PX1, m_reg, mnX, alX);                                        \
        __syncthreads();                                                                                                      \
        if ((t) + 1 < NT) { VMW(); SWRITE_H(SB); }                                                                          \
        RESC(alX); __syncthreads(); } while (0)
    for (int t = 1; t + 1 < NT; t += 2) {
        HALF_STEP(pB0, pB1, mnB, alB, pA0, pA1, alA, t, 1, 0, 0);
        HALF_STEP(pA0, pA1, mnA, alA, pB0, pB1, alB, t + 1, 0, 1, 1);
    }
    const bool even = (NT & 1) == 0;
    if (even) { SBAR(); qkt<1>(pB0, pB1, K_lds, r32, hi, S.qr, ACT(NT - 1)); SBAR(); }
    SLOAD_H(nxt.K, nxt.V, kbn); SBAR();
#pragma unroll
    for (int d0 = 0; d0 < 8; ++d0) S.qr[d0] = load8(nxt.Q + (size_t)(nxt.P0 + wid * QBLK + r32) * D + d0 * 16 + hi * 8);
    SBAR();
    finishSM(pA0, pA1, alA, l_reg, pa0, pa1, pa2, pa3); SBAR();
    pv_tile<0>(o, vb0, pa0, pa1, pa2, pa3, ACT(even ? NT - 2 : NT - 1));
    if (even) { MASKT(pB0, pB1, NT - 1); partialSM(pB0, pB1, m_reg, mnB, alB); __syncthreads(); RESC(alB);
        finishSM(pB0, pB1, alB, l_reg, pa0, pa1, pa2, pa3); SBAR(); pv_tile<1>(o, vb0, pa0, pa1, pa2, pa3, ACT(NT - 1)); }
    SBAR(); SEAM_K0();
    if (hi == 0) { const size_t li = (size_t)(cur.trow0 + cur.tstep * (wid * QBLK + r32)) * 8 + cur.h; const float lse_n = m_reg * SCALE + __logf(l_reg);
        if (first_group) { li_l[r32] = 1.0f / l_reg; al_l[r32] = 0.f; LSE[li] = lse_n; }
        else { const float lo = LSE[li], mx = fmaxf(lo, lse_n), eo = __expf(lo - mx), en = __expf(lse_n - mx), inv = 1.0f / (eo + en);
               li_l[r32] = en * inv / l_reg; al_l[r32] = eo * inv; LSE[li] = mx + __logf(eo + en); } }
    asm volatile("s_waitcnt lgkmcnt(0)" ::: "memory");
    {
        u16* Ow = OM + (size_t)(cur.trow0 + cur.tstep * (wid * QBLK)) * 1024 + cur.h * D;
        const size_t rstep = (size_t)cur.tstep * 1024;
#pragma unroll
        for (int r = 0; r < 16; ++r) { const int orow = crow(r, hi); const float wn = li_l[orow], wo = al_l[orow];
            unsigned* rowp = (unsigned*)(Ow + (size_t)orow * rstep + r32);
#pragma unroll
            for (int d0 = 0; d0 < 4; ++d0) { float v = o[d0][r] * wn; float vn = __shfl_xor(v, 1);
                if ((r32 & 1) == 0) { unsigned* p = rowp + d0 * 16;
                    if (!first_group) { const unsigned ov = *p; v += wo * hlo(ov); vn += wo * hhi(ov); }
                    *p = cvtpk(v, vn); } } }
    }
    __syncthreads();
#undef RESC
#undef KBASE
#undef ACT
#undef MASKT
#undef SEAM_K0
#undef HALF_STEP
}
#undef ROW
#undef VMW
#undef VMWN
#undef SLOAD_H
#undef SWRITE_HK
#undef SWRITE_HV
#undef SWRITE_H
#undef KSWZ
#undef SBAR
#undef SWA_MFMA
__device__ __forceinline__ BlockRef swa_ref(int item, int ldil, const u16* Q, const u16* K, const u16* V) {
    const int L = 8192 >> ldil, nqb = L / QB, qb = item % nqb, seq = item / nqb;
    const int r = seq & ((1 << ldil) - 1), bh = seq >> ldil, b = bh >> 3, h = bh & 7;
    BlockRef x; const size_t base = (size_t)seq * L * D;
    x.Q = Q + base; x.K = K + base; x.V = V + base; x.P0 = qb * QB; x.skv = L; x.trow0 = b * 8192 + r + ((qb * QB) << ldil); x.tstep = 1 << ldil; x.h = h;
    return x;
}
__device__ __forceinline__ void attn_phase(char* lds, int vcu, int G, int ldil, const u16* Q, const u16* K, const u16* V, u16* OM, float* LSE, int first_group) {
    const int total = 512;
    int it = 2 * vcu; if (it >= total) return;
    const int per = 2;
    BlockRef cur = swa_ref(it, ldil, Q, K, V);
    Seam S;
    swa_prime(cur, lds, S);
    for (int k = 0; k < per; ++k) {
        const bool last = (k == per - 1);
        const BlockRef nxt = last ? cur : swa_ref(it + k + 1, ldil, Q, K, V);
        swa_block(cur, nxt, lds, S, OM, LSE, first_group);
        cur = nxt;
    }
}
}

namespace gla {
typedef unsigned short u16;
typedef short bf16x8 __attribute__((ext_vector_type(8)));
typedef short s16x4 __attribute__((ext_vector_type(4)));
typedef float f32x16 __attribute__((ext_vector_type(16)));
typedef float f32x4 __attribute__((ext_vector_type(4)));
typedef unsigned u32x4 __attribute__((ext_vector_type(4)));
typedef unsigned u32x2 __attribute__((ext_vector_type(2)));
#define GLAS __attribute__((address_space(3)))
constexpr int RQ = 320, RV = 576;
constexpr int O_QT = 0, O_KT = 64 * RQ, O_KD = 2 * 64 * RQ, O_V = 3 * 64 * RQ, O_DEC = O_V + 64 * RV, O_BL = O_DEC + 512, O_END = O_BL + 512;
constexpr int O_OS = 0;
constexpr int NSEG = 32, SEGC = 4;
typedef float f32x2_t __attribute__((ext_vector_type(2))); typedef __bf16 bf16x2_t __attribute__((ext_vector_type(2)));
__device__ __forceinline__ unsigned cvtpk_bf(float lo, float hi) { const f32x2_t v = {lo, hi}; return __builtin_bit_cast(unsigned, __builtin_convertvector(v, bf16x2_t)); }
__device__ __forceinline__ int crow(int r, int hi) { return (r & 3) + 8 * (r >> 2) + 4 * hi; }
__device__ __forceinline__ float bf_lo(unsigned w) { return __builtin_bit_cast(float, w << 16); }
__device__ __forceinline__ float bf_hi(unsigned w) { return __builtin_bit_cast(float, w & 0xffff0000u); }
__device__ __forceinline__ s16x4 trrd(GLAS const unsigned char* p) { typedef short v4i16_t __attribute__((ext_vector_type(4))); return __builtin_bit_cast(s16x4, __builtin_amdgcn_ds_read_tr16_b64_v4i16((GLAS v4i16_t*)p)); }
template <int PITCH> __device__ __forceinline__ int tr_lane_off(int lane) { const int g = lane >> 4, q = (lane >> 2) & 3, p = lane & 3; return (8 * (g >> 1) + q) * PITCH + (16 * (g & 1) + 4 * p) * 2; }
template <int PITCH> __device__ __forceinline__ bf16x8 tr_frag(GLAS const unsigned char* base, int off) {
    const s16x4 lo = trrd(base + off), hi = trrd(base + off + 4 * PITCH);
    return (bf16x8){lo[0], lo[1], lo[2], lo[3], hi[0], hi[1], hi[2], hi[3]};
}
#define GLA_MFMA(a, b, c) __builtin_amdgcn_mfma_f32_32x32x16_bf16(a, b, c, 0, 0, 0)

struct Tensors { const u16* q; const u16* k; const u16* v; const u16* g; const float* Bc; const float* normw; float* GS; float* GD; u16* GO; };

struct ChunkRegs { u32x4 k0, k1, q0, q1, v0, v1, v2, v3; f32x4 bv[4]; float blt; };
template <bool FULL>
__device__ __forceinline__ void load_chunk_a(ChunkRegs& R, const Tensors& T, int b, int h, int tok0, int tid) {
    const int s = tid >> 3, d0 = (tid & 7) * 16; const size_t row = (size_t)b * 8192 + tok0 + s, rowl = (size_t)b * 8192 + tok0 + 63;
    const float* bp = T.Bc + row * 512 + h * 128 + d0;
    const u32x4* kp = (const u32x4*)(T.k + row * 512 + h * 128 + d0);
    R.k0 = kp[0]; R.k1 = kp[1];
    if (FULL) { const u32x4* qp = (const u32x4*)(T.q + row * 512 + h * 128 + d0); R.q0 = qp[0]; R.q1 = qp[1]; }
#pragma unroll
    for (int i = 0; i < 4; ++i) R.bv[i] = *(const f32x4*)(bp + 4 * i);
    R.blt = T.Bc[rowl * 512 + h * 128 + (tid & 127)];
}
__device__ __forceinline__ void load_chunk_v(ChunkRegs& R, const Tensors& T, int b, int h, int tok0, int tid) {
    const int s = tid >> 3; const size_t row = (size_t)b * 8192 + tok0 + s;
    const u32x4* vp = (const u32x4*)(T.v + row * 1024 + h * 256 + (tid & 7) * 32);
    R.v0 = vp[0]; R.v1 = vp[1]; R.v2 = vp[2]; R.v3 = vp[3];
}
__device__ __forceinline__ void write_chunk_1(GLAS unsigned char* L, const ChunkRegs& R, int tid) {
    const int s = tid >> 3;
    GLAS unsigned char* rv = L + O_V + s * RV + (tid & 7) * 64;
    *(GLAS u32x4*)(rv) = R.v0; *(GLAS u32x4*)(rv + 16) = R.v1; *(GLAS u32x4*)(rv + 32) = R.v2; *(GLAS u32x4*)(rv + 48) = R.v3;
    if (tid < 128) { ((GLAS float*)(L + O_BL))[tid] = R.blt; ((GLAS float*)(L + O_DEC))[tid] = __expf(R.blt); }
}
template <bool FULL>
__device__ __forceinline__ void write_chunk_2(GLAS unsigned char* L, const ChunkRegs& R, int tid) {
    const int s = tid >> 3, d0 = (tid & 7) * 16;
    f32x4 bl[4];
#pragma unroll
    for (int i = 0; i < 4; ++i) bl[i] = *(GLAS const f32x4*)(L + O_BL + (d0 + 4 * i) * 4);
    unsigned qt[8], kt[8], kd[8];
#pragma unroll
    for (int i = 0; i < 8; ++i) { const unsigned kw = i < 4 ? R.k0[i] : R.k1[i - 4], qw = i < 4 ? R.q0[i] : R.q1[i - 4];
        const float b0 = R.bv[i >> 1][(2 * i) & 3], b1 = R.bv[i >> 1][(2 * i + 1) & 3], l0 = bl[i >> 1][(2 * i) & 3], l1 = bl[i >> 1][(2 * i + 1) & 3];
        const float kf0 = bf_lo(kw), kf1 = bf_hi(kw);
        kd[i] = cvtpk_bf(kf0 * __expf(l0 - b0), kf1 * __expf(l1 - b1));
        if (FULL) { const float e0 = __expf(b0), e1 = __expf(b1);
            qt[i] = cvtpk_bf(bf_lo(qw) * (0.08838834764831845f * e0), bf_hi(qw) * (0.08838834764831845f * e1));
            kt[i] = cvtpk_bf(kf0 * __builtin_amdgcn_rcpf(e0), kf1 * __builtin_amdgcn_rcpf(e1)); } }
    GLAS unsigned char* r = L + s * RQ + d0 * 2;
    *(GLAS u32x4*)(r + O_KD) = (u32x4){kd[0], kd[1], kd[2], kd[3]}; *(GLAS u32x4*)(r + O_KD + 16) = (u32x4){kd[4], kd[5], kd[6], kd[7]};
    if (FULL) { *(GLAS u32x4*)(r + O_QT) = (u32x4){qt[0], qt[1], qt[2], qt[3]}; *(GLAS u32x4*)(r + O_QT + 16) = (u32x4){qt[4], qt[5], qt[6], qt[7]};
                *(GLAS u32x4*)(r + O_KT) = (u32x4){kt[0], kt[1], kt[2], kt[3]}; *(GLAS u32x4*)(r + O_KT + 16) = (u32x4){kt[4], kt[5], kt[6], kt[7]}; }
}
__device__ __forceinline__ void state_update(GLAS const unsigned char* Ltq, GLAS const unsigned char* Ld, f32x16 (&S)[4], const bf16x8 (&vf)[4]) {
#pragma unroll
    for (int T = 0; T < 4; ++T) {
#pragma unroll
        for (int i = 0; i < 4; ++i) { const f32x4 dc = *(GLAS const f32x4*)(Ld + O_DEC + 128 * T + 32 * i);
#pragma unroll
            for (int e = 0; e < 4; ++e) S[T][4 * i + e] *= dc[e]; }
#pragma unroll
        for (int kk = 0; kk < 4; ++kk) { const bf16x8 a = tr_frag<RQ>(Ltq, O_KD + 16 * kk * RQ + 64 * T); S[T] = GLA_MFMA(a, vf[kk], S[T]); }
    }
}
__device__ __forceinline__ void load_vfrags(GLAS const unsigned char* Ltv, bf16x8 (&vf)[4]) {
#pragma unroll
    for (int kk = 0; kk < 4; ++kk) vf[kk] = tr_frag<RV>(Ltv, 16 * kk * RV);
}
#define GLA_OPAQUE(p) asm volatile("" : "+v"(p))
__device__ __forceinline__ void gla1_phase(GLAS unsigned char* L, int unit, const Tensors& T) {
    int tid = threadIdx.x; asm volatile("" : "+v"(tid));
    const int wid = __builtin_amdgcn_readfirstlane(tid >> 6), lane = tid & 63, hi = lane >> 5, n = lane & 31;
    const int bh = unit / NSEG, seg = unit % NSEG, b = bh >> 2, h = bh & 3;
    f32x16 S[4] = {};
    float dsum = 0.f;
    ChunkRegs R; load_chunk_a<false>(R, T, b, h, seg * 256, tid); load_chunk_v(R, T, b, h, seg * 256, tid);
    for (int c = 0; c < SEGC; ++c) {
        write_chunk_1(L, R, tid);
        asm volatile("s_waitcnt lgkmcnt(0)" ::: "memory"); __syncthreads();
        write_chunk_2<false>(L, R, tid);
        asm volatile("s_waitcnt lgkmcnt(0)" ::: "memory"); __syncthreads();
        if (c + 1 < SEGC) { load_chunk_a<false>(R, T, b, h, seg * 256 + (c + 1) * 64, tid); load_chunk_v(R, T, b, h, seg * 256 + (c + 1) * 64, tid); }
        if (tid < 128) dsum += ((GLAS const float*)(L + O_BL))[tid];
        GLAS const unsigned char* Ltq = L + tr_lane_off<RQ>(lane); GLAS const unsigned char* Ltv = L + O_V + tr_lane_off<RV>(lane) + 64 * wid; GLAS const unsigned char* Ld = L + 16 * hi;
        GLA_OPAQUE(Ltq); GLA_OPAQUE(Ltv); GLA_OPAQUE(Ld);
        bf16x8 vf[4]; load_vfrags(Ltv, vf);
        state_update(Ltq, Ld, S, vf);
        __syncthreads();
    }
    float* gs = T.GS + (size_t)unit * (128 * 256);
#pragma unroll
    for (int Tt = 0; Tt < 4; ++Tt)
#pragma unroll
        for (int r = 0; r < 16; ++r) gs[(size_t)(32 * Tt + crow(r, hi)) * 256 + 32 * wid + n] = S[Tt][r];
    if (tid < 128) T.GD[(size_t)unit * 128 + tid] = __expf(dsum);
}
__device__ __forceinline__ void gla2_phase(int vcu, int G, const Tensors& T) {
    int tid = threadIdx.x; asm volatile("" : "+v"(tid));
    for (int e = vcu * 512 + tid; e < 8 * 128 * 256; e += G * 512) { const int bh = e >> 15, dv = e & 32767, d = dv >> 8;
        float* p0 = T.GS + ((size_t)(bh * NSEG) << 15) + dv; const float* d0 = T.GD + (size_t)(bh * NSEG) * 128 + d;
        float loc[NSEG], dec[NSEG];
#pragma unroll
        for (int seg = 0; seg < NSEG; ++seg) { loc[seg] = p0[(size_t)seg << 15]; dec[seg] = d0[seg * 128]; }
        float run = 0.f;
#pragma unroll
        for (int seg = 0; seg < NSEG; ++seg) { p0[(size_t)seg << 15] = run; run = dec[seg] * run + loc[seg]; } }
}
__device__ __forceinline__ void gla3_phase(GLAS unsigned char* L, int unit, const Tensors& T) {
    int tid = threadIdx.x; asm volatile("" : "+v"(tid));
    const int wid = __builtin_amdgcn_readfirstlane(tid >> 6), lane = tid & 63, hi = lane >> 5, n = lane & 31;
    const int bh = unit / NSEG, seg = unit % NSEG, b = bh >> 2, h = bh & 3;
    f32x16 S[4];
    { const float* gs = T.GS + (size_t)unit * (128 * 256);
#pragma unroll
      for (int Tt = 0; Tt < 4; ++Tt)
#pragma unroll
          for (int r = 0; r < 16; ++r) S[Tt][r] = gs[(size_t)(32 * Tt + crow(r, hi)) * 256 + 32 * wid + n]; }
    const f32x4 nw4 = *(const f32x4*)(T.normw + 4 * lane);
    ChunkRegs R; load_chunk_a<true>(R, T, b, h, seg * 256, tid); load_chunk_v(R, T, b, h, seg * 256, tid);
    for (int c = 0; c < SEGC; ++c) { const int tok0 = seg * 256 + c * 64;
        write_chunk_1(L, R, tid);
        asm volatile("s_waitcnt lgkmcnt(0)" ::: "memory"); __syncthreads();
        write_chunk_2<true>(L, R, tid);
        asm volatile("s_waitcnt lgkmcnt(0)" ::: "memory"); __syncthreads();
        if (c + 1 < SEGC) load_chunk_a<true>(R, T, b, h, tok0 + 64, tid);
        GLAS const unsigned char* Ltq = L + tr_lane_off<RQ>(lane); GLAS const unsigned char* Ltv = L + O_V + tr_lane_off<RV>(lane) + 64 * wid; GLAS const unsigned char* Ld = L + 16 * hi;
        GLAS const unsigned char* Lq = L + n * RQ + 16 * hi; GLAS const unsigned char* Lp = L + n * RQ + 8 * hi;
        GLAS unsigned char* Lo = L + O_OS + 4096 * hi + (32 * wid + n) * 4; GLAS const unsigned char* Lr = L + O_OS + 8192 * wid + 16 * lane;
        GLA_OPAQUE(Ltq); GLA_OPAQUE(Ltv); GLA_OPAQUE(Ld); GLA_OPAQUE(Lq); GLA_OPAQUE(Lp); GLA_OPAQUE(Lo); GLA_OPAQUE(Lr);
        bf16x8 vf[4]; load_vfrags(Ltv, vf);
        f32x16 o[2] = {};
#pragma unroll
        for (int bq = 0; bq < 2; ++bq)
#pragma unroll
            for (int a = 0; a <= bq; ++a) {
                f32x16 x = {};
#pragma unroll
                for (int kk = 0; kk < 8; ++kk) { const bf16x8 ka = *(GLAS const bf16x8*)(Lq + O_KT + 32 * a * RQ + 32 * kk);
                                                 const bf16x8 qb = *(GLAS const bf16x8*)(Lq + O_QT + 32 * bq * RQ + 32 * kk);
                                                 x = GLA_MFMA(ka, qb, x); }
                if (a == bq) {
#pragma unroll
                    for (int r = 0; r < 16; ++r) if (crow(r, hi) > n) x[r] = 0.f; }
                bf16x8 pa0, pa1;
#define PK4(P, B_, OUT) do { unsigned a0 = cvtpk_bf(P[B_+0], P[B_+1]), a1 = cvtpk_bf(P[B_+2], P[B_+3]), b0 = cvtpk_bf(P[B_+4], P[B_+5]), b1 = cvtpk_bf(P[B_+6], P[B_+7]); \
        auto r0 = __builtin_amdgcn_permlane32_swap(a0, b0, false, false); auto r1 = __builtin_amdgcn_permlane32_swap(a1, b1, false, false); \
        u32x4 w = {r0[0], r1[0], r0[1], r1[1]}; OUT = __builtin_bit_cast(bf16x8, w); } while (0)
                PK4(x, 0, pa0); PK4(x, 8, pa1);
#undef PK4
                o[bq] = GLA_MFMA(pa0, vf[2 * a], o[bq]); o[bq] = GLA_MFMA(pa1, vf[2 * a + 1], o[bq]);
            }
#pragma unroll
        for (int Tt = 0; Tt < 4; ++Tt)
#pragma unroll
            for (int s2 = 0; s2 < 2; ++s2) {
                u32x4 sw; sw.x = cvtpk_bf(S[Tt][8 * s2 + 0], S[Tt][8 * s2 + 1]); sw.y = cvtpk_bf(S[Tt][8 * s2 + 2], S[Tt][8 * s2 + 3]); sw.z = cvtpk_bf(S[Tt][8 * s2 + 4], S[Tt][8 * s2 + 5]); sw.w = cvtpk_bf(S[Tt][8 * s2 + 6], S[Tt][8 * s2 + 7]);
                const bf16x8 sb = __builtin_bit_cast(bf16x8, sw);
#pragma unroll
                for (int bq = 0; bq < 2; ++bq) { GLAS const unsigned char* qp = Lp + O_QT + 32 * bq * RQ + 64 * Tt + 32 * s2;
                    const u32x2 lo = *(GLAS const u32x2*)qp, hi2 = *(GLAS const u32x2*)(qp + 16);
                    const bf16x8 qa = __builtin_bit_cast(bf16x8, (u32x4){lo.x, lo.y, hi2.x, hi2.y});
                    o[bq] = GLA_MFMA(qa, sb, o[bq]); }
            }
        state_update(Ltq, Ld, S, vf);
        if (c + 1 < SEGC) load_chunk_v(R, T, b, h, tok0 + 64, tid);
        __syncthreads();
        {
#pragma unroll
          for (int bq = 0; bq < 2; ++bq)
#pragma unroll
              for (int r = 0; r < 16; ++r) *(GLAS float*)(Lo + (32 * bq + (r & 3) + 8 * (r >> 2)) * 1024) = o[bq][r]; }
        asm volatile("s_waitcnt lgkmcnt(0)" ::: "memory"); __syncthreads();
#pragma unroll
        for (int t8 = 0; t8 < 8; ++t8) { const int tk = 8 * wid + t8; const size_t row = (size_t)b * 8192 + tok0 + tk;
            const f32x4 ov = *(GLAS const f32x4*)(Lr + t8 * 1024);
            const u32x2 gw = *(const u32x2*)(T.g + row * 1024 + h * 256 + 4 * lane);
            float sq = (ov[0] * ov[0] + ov[1] * ov[1]) + (ov[2] * ov[2] + ov[3] * ov[3]);
#pragma unroll
            for (int of = 1; of < 64; of <<= 1) sq += __shfl_xor(sq, of);
            const float rstd = 1.0f / sqrtf(sq * (1.0f / 256.0f) + 1e-5f);
            const float g0 = bf_lo(gw.x), g1 = bf_hi(gw.x), g2 = bf_lo(gw.y), g3 = bf_hi(gw.y);
            const float y0 = ov[0] * rstd * nw4[0] * (g0 / (1.0f + __expf(-g0))), y1 = ov[1] * rstd * nw4[1] * (g1 / (1.0f + __expf(-g1)));
            const float y2 = ov[2] * rstd * nw4[2] * (g2 / (1.0f + __expf(-g2))), y3 = ov[3] * rstd * nw4[3] * (g3 / (1.0f + __expf(-g3)));
            u32x2 w; w.x = pg8::cvt_pk_h(y0, y1); w.y = pg8::cvt_pk_h(y2, y3);
            *(u32x2*)(T.GO + row * 1024 + h * 256 + 4 * lane) = w; }
        __syncthreads();
    }
}
#undef GLA_MFMA
#undef GLA_OPAQUE
#undef GLAS
}

constexpr int NWAVES = 8;
constexpr int BATCH = 2, SEQ = 8192, DM = 1024, MTOK = BATCH * SEQ, DFF = 4096;
constexpr int NGRP = 3, AH = 8, HD = 128, AIN = 9216;
constexpr int GH = 4, GDK = 128, GDV = 256, GKD = 512, GVD = 1024, GRANK = 16, GIN = 3088, GCH = 64;
constexpr float EPS = 1e-5f;
__host__ __device__ constexpr int grp_ldil(int g) { return g == 0 ? 0 : (g == 1 ? 2 : 4); }

constexpr size_t MiB = 1u << 20;
constexpr size_t WS_CTL = 0, CTL_ZERO_BYTES = 1 * MiB;
constexpr size_t WS_SSQ = 1 * MiB;
constexpr size_t WS_LSE = 2 * MiB;
constexpr size_t WS_COS = 3 * MiB, WS_SIN = 5 * MiB;
constexpr size_t WS_WG = 7 * MiB;
constexpr size_t WS_WQKV = 8 * MiB, WS_WO0 = 26 * MiB, WS_WUP0 = 28 * MiB, WS_WDN0 = 36 * MiB;
constexpr size_t WS_WGLA = 44 * MiB, WS_WO1 = 50 * MiB, WS_WUP1 = 52 * MiB, WS_WDN1 = 60 * MiB;
constexpr size_t WS_XB = 68 * MiB;
constexpr size_t WS_Q = 100 * MiB, WS_K = 132 * MiB, WS_V = 164 * MiB;
constexpr size_t WS_OM = 196 * MiB;
constexpr size_t WS_H = 100 * MiB;
constexpr size_t WS_GQ = 100 * MiB, WS_GK = 116 * MiB, WS_GV = 132 * MiB, WS_GG = 164 * MiB;
constexpr size_t WS_GB = 196 * MiB;
constexpr size_t WS_GS = 8 * MiB;
constexpr size_t WS_XB1 = 8 * MiB;
constexpr size_t WS_GD = 228 * MiB;
constexpr size_t WS_END = 256 * MiB;
constexpr int CW_TMO = 0, CW_CODE = 1, CW_BAR = 4096;

constexpr int RING_OFF = 0, RING_BYTES = 131072;
constexpr int LDSCTL_OFF = RING_BYTES, MISC_OFF = LDSCTL_OFF + 320;
constexpr int LDS_BYTES = 147456;
constexpr int INPTR_LDS_OFF = 131072 + 512 + 2048 + 512;
constexpr int GLR_LDS_OFF = 131072 + 512 + 2048;
static_assert(MISC_OFF + 128 <= LDS_BYTES, "LDS map");

#ifndef GLA_SIMPLE
#define GLA_SIMPLE 0
#endif
enum Phase { PH_PRO = 0, PH_QKV0 = 1, PH_ATT0 = 2, PH_QKV1 = 3, PH_ATT1 = 4, PH_QKV2 = 5, PH_ATT2 = 6, PH_WO0 = 7, PH_UP0 = 8, PH_DN0 = 9,
             PH_GLAP = 10, PH_GLA1 = 11, PH_GLA2 = 12, PH_GLA3 = 13, PH_WO1 = 14, PH_UP1 = 15, PH_DN1 = 16, PH_FIN = 17, PH_N = 18 };

struct Frame {
    LAS unsigned char* lds;
    volatile LAS unsigned* MISC;
    gu32* ctl;
    int tid, lane, wave;
    int vcu, G;
};
__device__ __forceinline__ float wave_sum(float v) {
#pragma unroll
    for (int o = 1; o < 64; o <<= 1) v += __shfl_xor(v, o);
    return v;
}
__device__ __forceinline__ float bf2f(unsigned short h) { return __builtin_bit_cast(float, (unsigned)h << 16); }
__device__ __forceinline__ unsigned pkh(float lo, float hi) { return pg8::cvt_pk_h(lo, hi); }
__device__ __forceinline__ float hlo(unsigned w) { return (float)__builtin_bit_cast(pg8::h16x2, w)[0]; }
__device__ __forceinline__ float hhi(unsigned w) { return (float)__builtin_bit_cast(pg8::h16x2, w)[1]; }
__device__ __forceinline__ float h2f(unsigned short h) { return (float)__builtin_bit_cast(_Float16, h); }

__device__ __forceinline__ void xpose_item(const float* W, int ldn, int K, const float* nw, bf16* WT, int dst_row0, int k0, int n0, int nvalid, LAS unsigned char* scr, int lane) {
    const bool cv = lane < nvalid;
    const float* wp = W + (size_t)k0 * ldn + n0 + (cv ? lane : 0);
#pragma unroll
    for (int h = 0; h < 2; ++h) { float w[32];
#pragma unroll
        for (int e = 0; e < 32; ++e) w[e] = wp[(size_t)(32 * h + e) * ldn];
        if (nw) {
#pragma unroll
            for (int e = 0; e < 32; ++e) w[e] *= nw[k0 + 32 * h + e]; }
#pragma unroll
        for (int q = 0; q < 4; ++q) { v4u o; o.x = pkh(w[8 * q], w[8 * q + 1]); o.y = pkh(w[8 * q + 2], w[8 * q + 3]); o.z = pkh(w[8 * q + 4], w[8 * q + 5]); o.w = pkh(w[8 * q + 6], w[8 * q + 7]);
            *(LAS v4u*)(scr + lane * 144 + (4 * h + q) * 16) = o; } }
    LDS_WAIT(); asm volatile("" ::: "memory");
    const int nl = lane >> 3, kc = lane & 7;
#pragma unroll
    for (int j = 0; j < 8; ++j) { const int n = 8 * j + nl; const v4u o = *(const LAS v4u*)(scr + n * 144 + kc * 16);
        if (n < nvalid) *(GAS v4u*)(WT + (size_t)(dst_row0 + n) * K + k0 + 8 * kc) = o; }
    LDS_WAIT(); asm volatile("" ::: "memory");
}
__device__ __forceinline__ void sincos_f(float x, float& s, float& c) {
    const float k = __builtin_rintf(x * 0.636619772f);
    float r = __builtin_fmaf(-k, 1.5703125f, x); r = __builtin_fmaf(-k, 0.0004837512969970703f, r); r = __builtin_fmaf(-k, 7.549533620476723e-08f, r); r = __builtin_fmaf(-k, 2.5632829192545614e-12f, r);
    const float r2 = r * r;
    const float sr = r + r * r2 * (-1.6666654611e-1f + r2 * (8.3321608736e-3f + r2 * -1.9515295891e-4f));
    const float cr = 1.0f - 0.5f * r2 + r2 * r2 * (4.166664568298827e-2f + r2 * (-1.388731625493765e-3f + r2 * 2.443315711809948e-5f));
    const int q = (int)k & 3;
    s = (q == 0) ? sr : (q == 1) ? cr : (q == 2) ? -sr : -cr;
    c = (q == 0) ? cr : (q == 1) ? -sr : (q == 2) ? -cr : sr;
}
__device__ const float ROPE_INVF[64] = {1.000000000e+00f, 8.659643531e-01f, 7.498942614e-01f, 6.493816376e-01f, 5.623413324e-01f, 4.869675338e-01f, 4.216965139e-01f, 3.651741147e-01f, 3.162277639e-01f, 2.738419771e-01f, 2.371373773e-01f, 2.053525001e-01f, 1.778279394e-01f, 1.539926529e-01f, 1.333521307e-01f, 1.154782027e-01f, 1.000000015e-01f, 8.659642935e-02f, 7.498941571e-02f, 6.493816525e-02f, 5.623413250e-02f, 4.869675264e-02f, 4.216965288e-02f, 3.651741147e-02f, 3.162277490e-02f, 2.738419734e-02f, 2.371373773e-02f, 2.053525113e-02f, 1.778279431e-02f, 1.539926510e-02f, 1.333521493e-02f, 1.154782064e-02f, 9.999999776e-03f, 8.659643121e-03f, 7.498941850e-03f, 6.493816152e-03f, 5.623413250e-03f, 4.869675264e-03f, 4.216964822e-03f, 3.651741194e-03f, 3.162277630e-03f, 2.738419687e-03f, 2.371373586e-03f, 2.053524833e-03f, 1.778279431e-03f, 1.539926510e-03f, 1.333521446e-03f, 1.154781901e-03f, 1.000000047e-03f, 8.659643354e-04f, 7.498942432e-04f, 6.493816618e-04f, 5.623413017e-04f, 4.869675322e-04f, 4.216965172e-04f, 3.651741426e-04f, 3.162277571e-04f, 2.738419571e-04f, 2.371373703e-04f, 2.053525095e-04f, 1.778279402e-04f, 1.539926452e-04f, 1.333521504e-04f, 1.154782003e-04f};

__device__ __forceinline__ const float* in_ptr(LAS unsigned char* lds, int k) {
    const unsigned long long v = ((volatile LAS unsigned long long*)(lds + INPTR_LDS_OFF))[k];
    const unsigned lo = __builtin_amdgcn_readfirstlane((unsigned)v), hi = __builtin_amdgcn_readfirstlane((unsigned)(v >> 32));
    return (const float*)(((unsigned long long)hi << 32) | lo);
}

__device__ __forceinline__ void gla_simple_phase(LAS unsigned char* ldsb, int vcu, const bf16* q, const bf16* k, const bf16* v, const bf16* g, const float* Bc, const float* normw, bf16* GO) {
    if (vcu >= BATCH * GH) return;
    int tid = threadIdx.x; asm volatile("" : "+v"(tid));
    LAS float* as_ = (LAS float*)ldsb; LAS float* ks_ = as_ + 256; LAS float* qs_ = ks_ + 256; LAS float* red = qs_ + 256;
    const int vp = tid >> 2, qt = tid & 3, wv = tid >> 6, lane = tid & 63;
    const int b = vcu >> 2, h = vcu & 3;
    float S0[32], S1[32];
#pragma unroll
    for (int j = 0; j < 32; ++j) { S0[j] = 0.f; S1[j] = 0.f; }
    const float nw0 = normw[vp], nw1 = normw[vp + 128];
    for (int t = 0; t < SEQ; ++t) { const size_t row = (size_t)b * SEQ + t; const int bf = t & 1;
        if (tid < 128) { const float* bp = Bc + row * GKD + h * GDK + tid; const float la = bp[0] - ((t & 63) ? bp[-GKD] : 0.f);
            as_[bf * 128 + tid] = expf(la); ks_[bf * 128 + tid] = bf2f(k[row * GKD + h * GDK + tid]); qs_[bf * 128 + tid] = bf2f(q[row * GKD + h * GDK + tid]) * 0.08838834764831845f; }
        const float v0 = bf2f(v[row * GVD + h * GDV + vp]), v1 = bf2f(v[row * GVD + h * GDV + vp + 128]);
        __syncthreads();
        float o0 = 0.f, o1 = 0.f;
#pragma unroll
        for (int c = 0; c < 8; ++c) { const f32x4 a4 = *(const LAS f32x4*)&as_[bf * 128 + qt * 32 + 4 * c], k4 = *(const LAS f32x4*)&ks_[bf * 128 + qt * 32 + 4 * c], q4 = *(const LAS f32x4*)&qs_[bf * 128 + qt * 32 + 4 * c];
#pragma unroll
            for (int e = 0; e < 4; ++e) { const int j = 4 * c + e; S0[j] = a4[e] * S0[j] + k4[e] * v0; o0 += q4[e] * S0[j]; S1[j] = a4[e] * S1[j] + k4[e] * v1; o1 += q4[e] * S1[j]; } }
        o0 += __shfl_xor(o0, 1); o0 += __shfl_xor(o0, 2); o1 += __shfl_xor(o1, 1); o1 += __shfl_xor(o1, 2);
        float sq = qt == 0 ? o0 * o0 + o1 * o1 : 0.f; sq = wave_sum(sq);
        if (lane == 0) red[bf * 8 + wv] = sq;
        __syncthreads();
        float tot = 0.f;
#pragma unroll
        for (int w = 0; w < 8; ++w) tot += red[bf * 8 + w];
        const float rstd = 1.0f / sqrtf(tot * (1.0f / GDV) + EPS);
        if (qt == 0) { const float g0 = bf2f(g[row * GVD + h * GDV + vp]), g1 = bf2f(g[row * GVD + h * GDV + vp + 128]);
            GO[row * GVD + h * GDV + vp] = __builtin_bit_cast(unsigned short, (_Float16)(o0 * rstd * nw0 * (g0 / (1.0f + expf(-g0)))));
            GO[row * GVD + h * GDV + vp + 128] = __builtin_bit_cast(unsigned short, (_Float16)(o1 * rstd * nw1 * (g1 / (1.0f + expf(-g1))))); }
    }
}

#ifndef REP_EXTRA
#define REP_EXTRA 0
#endif
#ifndef REP_MASK
#define REP_MASK 0
#endif
struct Args { const float* in[13]; float* out; unsigned char* ws; int ph_lo, ph_hi, li, skip_mask; };

__global__ void __launch_bounds__(NWAVES * 64, 2) mega_fwd(Args args) {
    extern __shared__ __attribute__((aligned(16))) unsigned char lds[];
    Frame F;
    F.lds = (LAS unsigned char*)lds;
    F.MISC = (volatile LAS unsigned*)(F.lds + MISC_OFF);
    F.tid = threadIdx.x; F.lane = F.tid & 63; F.wave = __builtin_amdgcn_readfirstlane(F.tid >> 6);
    F.G = gridDim.x; { const int bx = blockIdx.x; F.vcu = (F.G % 8 == 0) ? (bx % 8) * (F.G / 8) + bx / 8 : bx; }
    unsigned char* ws = args.ws;
    F.ctl = (gu32*)(ws + WS_CTL);
    for (int u = F.tid; u < (LDS_BYTES - LDSCTL_OFF) / 4; u += NWAVES * 64) ((LAS unsigned*)(F.lds + LDSCTL_OFF))[u] = 0u;
    __syncthreads();
    const bool multi = (args.ph_hi - args.ph_lo) > 1;
    XcdBarrier bar; bar.bar = (unsigned*)(F.ctl + CW_BAR) + args.li * XCD_BAR_WORDS; bar.x = 0; bar.st = nullptr;
    if (multi) bar = xcd_barrier_post((unsigned*)(F.ctl + CW_BAR) + args.li * XCD_BAR_WORDS, F.MISC + 8);

    if (F.tid == 0) {
#pragma unroll
        for (int k = 0; k < 13; ++k) ((LAS unsigned long long*)(F.lds + INPTR_LDS_OFF))[k] = (unsigned long long)args.in[k]; }
    __syncthreads();
#define INP(k) in_ptr(F.lds, (k))
    float* const xres = args.out;
    float* const ssq = (float*)(ws + WS_SSQ);
    bf16* const XB = (bf16*)(ws + WS_XB);
    const int gw = F.vcu * NWAVES + F.wave, NGW = F.G * NWAVES;
    LAS float* const rl = (LAS float*)(F.lds + pg8::RSTD_LDS_OFF);

    for (int ph = args.ph_lo; ph < args.ph_hi; ++ph) {
      const int reps = 1 + ((args.skip_mask >> ph) & 1) * REP_EXTRA;
      for (int rp = 0; rp < reps; ++rp) {
        if (rp) xcd_barrier(bar);
        if (ph == PH_PRO) {
#ifndef NO_PRO
            int tid = threadIdx.x; asm volatile("" : "+v"(tid)); const int lane = tid & 63;
            LAS unsigned char* scr = F.lds + RING_OFF + F.wave * 16384;
            constexpr int I_QKV = 16 * 144, I_O = 16 * 16, I_UP = 16 * 64, I_DN = 64 * 16, I_GLA = 16 * 49;
            constexpr int NITEMS = I_QKV + 2 * I_O + 2 * I_UP + 2 * I_DN + I_GLA;
            for (int it = gw; it < NITEMS; it += NGW) {
                int r = it; const float* W; int ldn, K = DM, nvalid = 64, dst_row0, k0, n0; const float* nw = nullptr; bf16* WT;
                if (r < I_QKV) { const int kb = r / 144, nb = r % 144; n0 = nb * 64; const int nin = n0 % 3072, which = nin / 1024, j = nin % 1024;
                    const int jd = which < 2 ? ((j & ~0xC0) | ((j & 0x40) << 1) | ((j & 0x80) >> 1)) : j;
                    W = INP(4); ldn = AIN; nw = INP(1); WT = (bf16*)(ws + WS_WQKV); dst_row0 = n0 - j + jd; k0 = kb * 64; }
                else if ((r -= I_QKV) < I_O) { W = INP(5); ldn = DM; WT = (bf16*)(ws + WS_WO0); n0 = dst_row0 = (r % 16) * 64; k0 = (r / 16) * 64; }
                else if ((r -= I_O) < I_O) { W = INP(10); ldn = DM; WT = (bf16*)(ws + WS_WO1); n0 = dst_row0 = (r % 16) * 64; k0 = (r / 16) * 64; }
                else if ((r -= I_O) < I_UP) { W = INP(11); ldn = DFF; nw = INP(2); WT = (bf16*)(ws + WS_WUP0); n0 = dst_row0 = (r % 64) * 64; k0 = (r / 64) * 64; }
                else if ((r -= I_UP) < I_UP) { W = INP(11) + (size_t)DM * DFF; ldn = DFF; nw = INP(2) + DM; WT = (bf16*)(ws + WS_WUP1); n0 = dst_row0 = (r % 64) * 64; k0 = (r / 64) * 64; }
                else if ((r -= I_UP) < I_DN) { W = INP(12); ldn = DM; K = DFF; WT = (bf16*)(ws + WS_WDN0); n0 = dst_row0 = (r % 16) * 64; k0 = (r / 16) * 64; }
                else if ((r -= I_DN) < I_DN) { W = INP(12) + (size_t)DFF * DM; ldn = DM; K = DFF; WT = (bf16*)(ws + WS_WDN1); n0 = dst_row0 = (r % 16) * 64; k0 = (r / 16) * 64; }
                else { r -= I_DN; const int kb = r / 49, nb = r % 49; W = INP(6); ldn = GIN; nw = INP(1) + DM; k0 = kb * 64; n0 = nb * 64;
                    if (nb < 48) { WT = (bf16*)(ws + WS_WGLA); dst_row0 = n0; } else { WT = (bf16*)(ws + WS_WG); dst_row0 = 0; nvalid = 16; } }
                xpose_item(W, ldn, K, nw, WT, dst_row0, k0, n0, nvalid, scr, lane);
            }
            { bf16* cosT = (bf16*)(ws + WS_COS); bf16* sinT = (bf16*)(ws + WS_SIN);
              for (int e = blockIdx.x * (NWAVES * 64) + tid; e < SEQ * 64; e += F.G * NWAVES * 64) { const int pos = e >> 6, i = e & 63;
                  const float ang = (float)pos * ROPE_INVF[i]; float sn, cs; sincos_f(ang, sn, cs); cosT[e] = __builtin_bit_cast(unsigned short, (_Float16)cs); sinT[e] = __builtin_bit_cast(unsigned short, (_Float16)sn); } }
            const float* x_in = INP(0);
            for (int m0 = 4 * gw; m0 < MTOK; m0 += 4 * NGW) {
                f32x4 v[4][4];
#pragma unroll
                for (int q = 0; q < 4; ++q) { const GAS f32x4* xr = (const GAS f32x4*)(x_in + (size_t)(m0 + q) * DM) + lane;
#pragma unroll
                    for (int j = 0; j < 4; ++j) v[q][j] = xr[64 * j]; }
#pragma unroll
                for (int q = 0; q < 4; ++q) { float s = 0.f; GAS unsigned long long* o8 = (GAS unsigned long long*)(XB + (size_t)(m0 + q) * DM) + lane;
#pragma unroll
                    for (int j = 0; j < 4; ++j) { const f32x4 w = v[q][j]; s += (w.x * w.x + w.y * w.y) + (w.z * w.z + w.w * w.w);
                        o8[64 * j] = (unsigned long long)pkh(w.x, w.y) | ((unsigned long long)pkh(w.z, w.w) << 32); }
                    s = wave_sum(s); if (lane < 16) ssq[(size_t)(m0 + q) * 16 + lane] = lane == 0 ? s : 0.f; } }
#endif
        }
        else if (ph == PH_QKV0 || ph == PH_QKV1 || ph == PH_QKV2) {
            const int g = (ph - PH_QKV0) >> 1;
            pg8::Gemm gm{XB, (const bf16*)(ws + WS_WQKV) + (size_t)g * 3072 * DM, MTOK, 3072, DM}; pg8::RstdOrder S; S.init(MTOK, 3072, F.G, (int)blockIdx.x); S.ssq = ssq; S.rl = rl;
            pg8::EpiQKV E{(bf16*)(ws + WS_Q), (bf16*)(ws + WS_K), (bf16*)(ws + WS_V), rl, (const bf16*)(ws + WS_COS), (const bf16*)(ws + WS_SIN), g == 0 ? 0 : (g == 1 ? 2 : 4)};
#ifndef NO_QKV
            pg8::gemm_phase<pg8::EpiQKV, pg8::RstdOrder, true, true>(F.lds + RING_OFF, gm, S, E);
#endif
        }
        else if (ph == PH_ATT0 || ph == PH_ATT1 || ph == PH_ATT2) {
            const int g = (ph - PH_ATT0) >> 1;
            swa::attn_phase((char*)lds, F.vcu, F.G, g == 0 ? 0 : (g == 1 ? 2 : 4), (const swa::u16*)(ws + WS_Q), (const swa::u16*)(ws + WS_K), (const swa::u16*)(ws + WS_V), (swa::u16*)(ws + WS_OM), (float*)(ws + WS_LSE), g == 0);
        }
        else if (ph == PH_WO0 || ph == PH_DN0 || ph == PH_WO1 || ph == PH_DN1) {
            const bf16* A; const bf16* Bt; int K; const float* resid = xres; bf16* xbo = XB;
            if (ph == PH_WO0) { A = (const bf16*)(ws + WS_OM); Bt = (const bf16*)(ws + WS_WO0); K = DM; resid = INP(0); }
            else if (ph == PH_DN0) { A = (const bf16*)(ws + WS_H); Bt = (const bf16*)(ws + WS_WDN0); K = DFF; }
            else if (ph == PH_WO1) { A = XB; Bt = (const bf16*)(ws + WS_WO1); K = DM; xbo = (bf16*)(ws + WS_XB1); }
            else { A = (const bf16*)(ws + WS_H); Bt = (const bf16*)(ws + WS_WDN1); K = DFF; }
            pg8::Gemm gm{A, Bt, MTOK, DM, K}; pg8::PlainOrder S; S.init(MTOK, DM, F.G, (int)blockIdx.x);
            pg8::EpiResid E{resid, xres, xbo, ssq};
#ifndef NO_RES
            pg8::gemm_phase<pg8::EpiResid, pg8::PlainOrder, false, true>(F.lds + RING_OFF, gm, S, E);
#endif
        }
        else if (ph == PH_UP0 || ph == PH_UP1) {
            const bf16* A = ph == PH_UP0 ? XB : (const bf16*)(ws + WS_XB1);
            pg8::Gemm gm{A, (const bf16*)(ws + (ph == PH_UP0 ? WS_WUP0 : WS_WUP1)), MTOK, DFF, DM}; pg8::RstdOrder S; S.init(MTOK, DFF, F.G, (int)blockIdx.x); S.ssq = ssq; S.rl = rl;
            pg8::EpiUp E{(bf16*)(ws + WS_H), rl};
#ifndef NO_UP
            pg8::gemm_phase<pg8::EpiUp, pg8::RstdOrder, true, true>(F.lds + RING_OFF, gm, S, E);
#endif
        }
        else if (ph == PH_GLAP) {
            { pg8::Gemm gm{XB, (const bf16*)(ws + WS_WGLA), MTOK, 3072, DM}; pg8::RstdOrder S; S.init(MTOK, 3072, F.G, (int)blockIdx.x); S.ssq = ssq; S.rl = rl;
              pg8::EpiGla E{(bf16*)(ws + WS_GQ), (bf16*)(ws + WS_GK), (bf16*)(ws + WS_GV), (bf16*)(ws + WS_GG), rl};
#ifndef NO_GLAP
              pg8::gemm_phase<pg8::EpiGla, pg8::RstdOrder, true, true>(F.lds + RING_OFF, gm, S, E);
#endif
 }
#ifndef NO_GATE
            __syncthreads();
            int tid = threadIdx.x; asm volatile("" : "+v"(tid)); const int lane = tid & 63;
            { LAS float* Pp = (LAS float*)(F.lds + RING_OFF);
              LAS float* Rr = Pp + 2048;
              LAS float* Gg = Pp + 2048 + 64;
              const bf16* WG = (const bf16*)(ws + WS_WG); const float* wgu = INP(7); const float* bg = INP(8); float* GB = (float*)(ws + WS_GB);
              for (int ch = F.vcu; ch < MTOK / GCH; ch += F.G) {
                  { const int mt = F.wave & 3, kh = F.wave >> 2, fr = lane & 15, fq = lane >> 4;
                    const GAS v4u* ap = (const GAS v4u*)(XB + (size_t)(ch * GCH + 16 * mt + fr) * DM + 512 * kh + 8 * fq);
                    const GAS v4u* bp = (const GAS v4u*)(WG + (size_t)fr * DM + 512 * kh + 8 * fq);
                    f32x4 acc = {0.f, 0.f, 0.f, 0.f};
#pragma unroll 8
                    for (int ks = 0; ks < 16; ++ks) { const v4u av = ap[4 * ks], bv = bp[4 * ks];
                        acc = __builtin_amdgcn_mfma_f32_16x16x32_f16(__builtin_bit_cast(pg8::f16x8, av), __builtin_bit_cast(pg8::f16x8, bv), acc, 0, 0, 0); }
#pragma unroll
                    for (int r = 0; r < 4; ++r) Pp[(kh * 64 + 16 * mt + 4 * fq + r) * 16 + fr] = acc[r];
                    if (tid < 64) { const f32x4* sp = (const f32x4*)(ssq + (size_t)(ch * GCH + tid) * 16); const f32x4 s0 = sp[0], s1 = sp[1], s2 = sp[2], s3 = sp[3];
                        const float sq = (((s0[0] + s0[1]) + (s0[2] + s0[3])) + ((s1[0] + s1[1]) + (s1[2] + s1[3]))) + (((s2[0] + s2[1]) + (s2[2] + s2[3])) + ((s3[0] + s3[1]) + (s3[2] + s3[3])));
                        Rr[tid] = 1.0f / sqrtf(sq * (1.0f / DM) + EPS); } }
                  LDS_WAIT(); __syncthreads();
                  { const int t = tid >> 3, j0 = (tid & 7) * 2; const float rs = Rr[t];
                    Gg[t * 16 + j0] = (Pp[t * 16 + j0] + Pp[1024 + t * 16 + j0]) * rs; Gg[t * 16 + j0 + 1] = (Pp[t * 16 + j0 + 1] + Pp[1024 + t * 16 + j0 + 1]) * rs; }
                  LDS_WAIT(); __syncthreads();
                  { const int c = tid; float wv[GRANK];
#pragma unroll
                    for (int j = 0; j < GRANK; ++j) wv[j] = wgu[j * GKD + c];
                    const float bc = bg[c]; float run = 0.f; float* gbp = GB + (size_t)(ch * GCH) * GKD + c;
#pragma unroll 4
                    for (int t = 0; t < GCH; ++t) { const f32x4 g0 = *(const LAS f32x4*)(Gg + t * 16), g1 = *(const LAS f32x4*)(Gg + t * 16 + 4), g2 = *(const LAS f32x4*)(Gg + t * 16 + 8), g3 = *(const LAS f32x4*)(Gg + t * 16 + 12);
                        float gk = bc;
#pragma unroll
                        for (int e = 0; e < 4; ++e) { gk += g0[e] * wv[e]; gk += g1[e] * wv[4 + e]; gk += g2[e] * wv[8 + e]; gk += g3[e] * wv[12 + e]; }
                        const float ls = fminf(gk, 0.f) - __logf(1.0f + __expf(-fabsf(gk)));
                        run += ls * (1.0f / 16.0f); gbp[(size_t)t * GKD] = run; } }
                  __syncthreads();
              } }
#endif
        }
        else if (ph == PH_GLA1 || ph == PH_GLA2 || ph == PH_GLA3) {
#if GLA_SIMPLE
            if (ph == PH_GLA3) gla_simple_phase(F.lds + RING_OFF, F.vcu, (const bf16*)(ws + WS_GQ), (const bf16*)(ws + WS_GK), (const bf16*)(ws + WS_GV), (const bf16*)(ws + WS_GG), (const float*)(ws + WS_GB), INP(9), XB);
#else
            const gla::Tensors T{(const bf16*)(ws + WS_GQ), (const bf16*)(ws + WS_GK), (const bf16*)(ws + WS_GV), (const bf16*)(ws + WS_GG), (const float*)(ws + WS_GB), INP(9), (float*)(ws + WS_GS), (float*)(ws + WS_GD), XB};
            if (ph == PH_GLA1) gla::gla1_phase(F.lds + RING_OFF, F.vcu, T);
            else if (ph == PH_GLA2) gla::gla2_phase(F.vcu, F.G, T);
            else gla::gla3_phase(F.lds + RING_OFF, F.vcu, T);
#endif
        }
        else if (ph == PH_FIN) {
            int tid = threadIdx.x; asm volatile("" : "+v"(tid)); const int lane = tid & 63;
            const float* final_w = INP(3);
            f32x4 fw[4];
#pragma unroll
            for (int j = 0; j < 4; ++j) fw[j] = *((const f32x4*)final_w + lane + 64 * j);
            for (int m0 = 4 * gw; m0 < MTOK; m0 += 4 * NGW) {
                f32x4 v[4][4];
#pragma unroll
                for (int q = 0; q < 4; ++q) { const GAS f32x4* xr = (const GAS f32x4*)(xres + (size_t)(m0 + q) * DM) + lane;
#pragma unroll
                    for (int j = 0; j < 4; ++j) v[q][j] = xr[64 * j]; }
#pragma unroll
                for (int q = 0; q < 4; ++q) { float s = 0.f; GAS f32x4* xr = (GAS f32x4*)(xres + (size_t)(m0 + q) * DM) + lane;
#pragma unroll
                    for (int j = 0; j < 4; ++j) s += (v[q][j].x * v[q][j].x + v[q][j].y * v[q][j].y) + (v[q][j].z * v[q][j].z + v[q][j].w * v[q][j].w);
                    const float rstd = 1.0f / sqrtf(wave_sum(s) * (1.0f / DM) + EPS);
#pragma unroll
                    for (int j = 0; j < 4; ++j) xr[64 * j] = v[q][j] * rstd * fw[j]; } }
        }
      }
      if (ph + 1 < args.ph_hi) xcd_barrier(bar);
    }
}

__global__ void __launch_bounds__(256) naive_attn(const bf16* __restrict__ Q, const bf16* __restrict__ K, const bf16* __restrict__ V, bf16* OM, float* LSE, int g, int ldil) {
    __shared__ float qs[4][128];
    const int lane = threadIdx.x & 63, wv = threadIdx.x >> 6;
    const int item = blockIdx.x * 4 + wv, row = item >> 3, h = item & 7;
    const int b = row >> 13, t = row & (SEQ - 1), r = t & ((1 << ldil) - 1), i = t >> ldil, L = SEQ >> ldil;
    const size_t base = (size_t)((((b * AH + h) << ldil) + r)) * L;
    const bf16* Qr = Q + (base + i) * HD; const bf16* Ks = K + base * HD; const bf16* Vs = V + base * HD;
    qs[wv][lane] = h2f(Qr[lane]); qs[wv][lane + 64] = h2f(Qr[lane + 64]);
    __syncthreads();
    float sc[3];
#pragma unroll
    for (int sl = 0; sl < 3; ++sl) { const int jj = lane + 64 * sl; float s = -INFINITY;
        if (jj <= 128 && i - jj >= 0) { const v4u* kp = (const v4u*)(Ks + (size_t)(i - jj) * HD); s = 0.f;
            for (int c = 0; c < 16; ++c) { const v4u kv = kp[c];
#pragma unroll
                for (int e = 0; e < 4; ++e) s += qs[wv][8 * c + 2 * e] * hlo(kv[e]) + qs[wv][8 * c + 2 * e + 1] * hhi(kv[e]); }
            s *= 0.08838834764831845f; }
        sc[sl] = s; }
    float m = fmaxf(fmaxf(sc[0], sc[1]), sc[2]);
#pragma unroll
    for (int o = 1; o < 64; o <<= 1) m = fmaxf(m, __shfl_xor(m, o));
    float p[3], l = 0.f;
#pragma unroll
    for (int sl = 0; sl < 3; ++sl) { p[sl] = expf(sc[sl] - m); l += p[sl]; }
    l = wave_sum(l);
    float o0 = 0.f, o1 = 0.f;
#pragma unroll
    for (int sl = 0; sl < 3; ++sl)
        for (int ll = 0; ll < 64; ++ll) { const int jj = sl * 64 + ll; if (jj > 128 || i - jj < 0) break;
            const float pj = __shfl(p[sl], ll); const unsigned vv = ((const unsigned*)(Vs + (size_t)(i - jj) * HD))[lane];
            o0 += pj * hlo(vv); o1 += pj * hhi(vv); }
    o0 /= l; o1 /= l; float lse = m + logf(l);
    unsigned* op = (unsigned*)(OM + (size_t)row * DM + h * HD) + lane;
    if (g > 0) { const float lo = LSE[(size_t)row * 8 + h]; const unsigned ov = *op; const float mx = fmaxf(lo, lse), wo = expf(lo - mx), wn = expf(lse - mx), inv = 1.0f / (wo + wn);
        o0 = (wo * hlo(ov) + wn * o0) * inv; o1 = (wo * hhi(ov) + wn * o1) * inv; lse = mx + logf(wo + wn); }
    *op = pkh(o0, o1);
    if (lane == 0) LSE[(size_t)row * 8 + h] = lse;
}
__global__ void __launch_bounds__(1024) naive_gla(const bf16* __restrict__ q, const bf16* __restrict__ k, const bf16* __restrict__ v, const bf16* __restrict__ g, const float* __restrict__ Bc,
                                                    const float* __restrict__ normw, bf16* GO) {
    __shared__ float red[2][16];
    __shared__ __attribute__((aligned(16))) float as_[2][128], ks_[2][128], qs_[2][128];
    const int tid = threadIdx.x, vloc = tid >> 2, qt = tid & 3, wv = tid >> 6, lane = tid & 63;
    const int b = blockIdx.x >> 2, h = blockIdx.x & 3;
    float S[32];
#pragma unroll
    for (int j = 0; j < 32; ++j) S[j] = 0.f;
    const float nw = normw[vloc];
    for (int t = 0; t < SEQ; ++t) { const size_t row = (size_t)b * SEQ + t; const int bf = t & 1;
        if (tid < 128) { const float* bp = Bc + row * GKD + h * GDK + tid; const float la = bp[0] - ((t & 63) ? bp[-GKD] : 0.f);
            as_[bf][tid] = expf(la); ks_[bf][tid] = bf2f(k[row * GKD + h * GDK + tid]); qs_[bf][tid] = bf2f(q[row * GKD + h * GDK + tid]) * 0.08838834764831845f; }
        const float vv = bf2f(v[row * GVD + h * GDV + vloc]);
        __syncthreads();
        float o = 0.f;
#pragma unroll
        for (int c = 0; c < 8; ++c) { const f32x4 a4 = *(const f32x4*)&as_[bf][qt * 32 + 4 * c], k4 = *(const f32x4*)&ks_[bf][qt * 32 + 4 * c], q4 = *(const f32x4*)&qs_[bf][qt * 32 + 4 * c];
#pragma unroll
            for (int e = 0; e < 4; ++e) { const int j = 4 * c + e; S[j] = a4[e] * S[j] + k4[e] * vv; o += q4[e] * S[j]; } }
        o += __shfl_xor(o, 1); o += __shfl_xor(o, 2);
        float sq = qt == 0 ? o * o : 0.f; sq = wave_sum(sq);
        if (lane == 0) red[bf][wv] = sq;
        __syncthreads();
        float tot = 0.f;
#pragma unroll
        for (int w = 0; w < 16; ++w) tot += red[bf][w];
        const float rstd = 1.0f / sqrtf(tot * (1.0f / GDV) + EPS);
        if (qt == 0) { const float gg = bf2f(g[row * GVD + h * GDV + vloc]); const float y = o * rstd * nw * (gg / (1.0f + expf(-gg))); GO[row * GVD + h * GDV + vloc] = __builtin_bit_cast(unsigned short, (_Float16)y); }
    }
}


__global__ void __launch_bounds__(256) probe_maxdiff_h(const unsigned short* a, const unsigned short* b, size_t n, unsigned* slot) {
    float m = 0.f;
    for (size_t i = (size_t)blockIdx.x * 256 + threadIdx.x; i < n; i += (size_t)gridDim.x * 256) { const float d = fabsf(h2f(a[i]) - h2f(b[i])); m = (d > m || d != d) ? (d != d ? 1e30f : d) : m; }
#pragma unroll
    for (int o = 1; o < 64; o <<= 1) m = fmaxf(m, __shfl_xor(m, o));
    if ((threadIdx.x & 63) == 0) atomicMax(slot, __float_as_uint(m));
}
__global__ void __launch_bounds__(256) probe_maxdiff_f(const float* a, const float* b, size_t n, unsigned* slot) {
    float m = 0.f;
    for (size_t i = (size_t)blockIdx.x * 256 + threadIdx.x; i < n; i += (size_t)gridDim.x * 256) { const float d = fabsf(a[i] - b[i]); m = (d > m || d != d) ? (d != d ? 1e30f : d) : m; }
#pragma unroll
    for (int o = 1; o < 64; o <<= 1) m = fmaxf(m, __shfl_xor(m, o));
    if ((threadIdx.x & 63) == 0) atomicMax(slot, __float_as_uint(m));
}
__global__ void __launch_bounds__(256) probe_encode(float* out, size_t n, const unsigned* slot, float scale) {
    const float d = sqrtf(scale * __uint_as_float(*slot));
    for (size_t i = (size_t)blockIdx.x * 256 + threadIdx.x; i < n; i += (size_t)gridDim.x * 256) out[i] += d;
}

#ifndef MK_MODE
#define MK_MODE 2
#endif
extern "C" void kernel_launch(void* const* d_in, const int* in_sizes, int n_in, void* d_out, int out_size, void* d_ws, size_t ws_size, hipStream_t stream) {
    static int grid = 0;
    if (grid == 0) {
        if (n_in != 13 || in_sizes[0] != MTOK * DM || out_size != MTOK * DM || ws_size < WS_END) { fprintf(stderr, "kernel_launch: unexpected shapes (n_in %d, in0 %d, out %d, ws %zu); nothing launched\n", n_in, n_in > 0 ? in_sizes[0] : -1, out_size, ws_size); grid = -1; return; }
        int dev = 0, cus = 0;
        if (hipGetDevice(&dev) != hipSuccess || hipDeviceGetAttribute(&cus, hipDeviceAttributeMultiprocessorCount, dev) != hipSuccess) { grid = -1; return; }
        if (hipFuncSetAttribute((const void*)mega_fwd, hipFuncAttributeMaxDynamicSharedMemorySize, LDS_BYTES) != hipSuccess) { fprintf(stderr, "kernel_launch: hipFuncSetAttribute failed\n"); grid = -1; return; }
        (void)hipGetLastError();
        grid = cus;
        if (grid != 256) fprintf(stderr, "kernel_launch: %d CUs (built for 256)\n", grid);
    }
    if (grid < 0) return;
    unsigned char* ws = (unsigned char*)d_ws;
    (void)hipMemsetAsync(ws + WS_CTL, 0, CTL_ZERO_BYTES, stream);
    Args a{};
    for (int i = 0; i < 13; ++i) a.in[i] = (const float*)d_in[i];
    a.out = (float*)d_out; a.ws = ws;
#define MEGA(lo, hi, li_) do { a.ph_lo = (lo); a.ph_hi = (hi); a.li = (li_); hipLaunchKernelGGL(mega_fwd, dim3(grid), dim3(NWAVES * 64), LDS_BYTES, stream, a); } while (0)
#if MK_MODE == 0 || MK_MODE == 1
    a.skip_mask = 0;
    MEGA(PH_PRO, PH_PRO + 1, 0);
    for (int g = 0; g < NGRP; ++g) { MEGA(PH_QKV0 + 2 * g, PH_QKV0 + 2 * g + 1, 0);
#if MK_MODE == 0
        hipLaunchKernelGGL(naive_attn, dim3(MTOK * AH / 4), dim3(256), 0, stream, (const bf16*)(ws + WS_Q), (const bf16*)(ws + WS_K), (const bf16*)(ws + WS_V), (bf16*)(ws + WS_OM), (float*)(ws + WS_LSE), g, grp_ldil(g));
#else
        MEGA(PH_ATT0 + 2 * g, PH_ATT0 + 2 * g + 1, 0);
#endif
    }
    MEGA(PH_WO0, PH_WO0 + 1, 0); MEGA(PH_UP0, PH_UP0 + 1, 0); MEGA(PH_DN0, PH_DN0 + 1, 0); MEGA(PH_GLAP, PH_GLAP + 1, 0);
    hipLaunchKernelGGL(naive_gla, dim3(BATCH * GH), dim3(1024), 0, stream, (const bf16*)(ws + WS_GQ), (const bf16*)(ws + WS_GK), (const bf16*)(ws + WS_GV), (const bf16*)(ws + WS_GG), (const float*)(ws + WS_GB),
                       (const float*)d_in[9], (bf16*)(ws + WS_XB));
    MEGA(PH_WO1, PH_WO1 + 1, 0); MEGA(PH_UP1, PH_UP1 + 1, 0); MEGA(PH_DN1, PH_DN1 + 1, 0); MEGA(PH_FIN, PH_FIN + 1, 0);
#elif MK_MODE == 3
    a.skip_mask = 0;
    unsigned* slot = (unsigned*)(ws + WS_CTL) + 2048; unsigned* slot2 = slot + 64;
    unsigned short* OM2 = (unsigned short*)d_out; float* LSE2 = (float*)((char*)d_out + 48 * MiB);
    MEGA(PH_PRO, PH_PRO + 1, 0);
    for (int g = 0; g < NGRP; ++g) { MEGA(PH_QKV0 + 2 * g, PH_QKV0 + 2 * g + 1, 0);
        hipLaunchKernelGGL(naive_attn, dim3(MTOK * AH / 4), dim3(256), 0, stream, (const bf16*)(ws + WS_Q), (const bf16*)(ws + WS_K), (const bf16*)(ws + WS_V), (bf16*)OM2, LSE2, g, grp_ldil(g));
        MEGA(PH_ATT0 + 2 * g, PH_ATT0 + 2 * g + 1, 0); }
    hipLaunchKernelGGL(probe_maxdiff_h, dim3(2048), dim3(256), 0, stream, (const unsigned short*)(ws + WS_OM), (const unsigned short*)OM2, (size_t)MTOK * DM, slot);
    hipLaunchKernelGGL(probe_maxdiff_f, dim3(256), dim3(256), 0, stream, (const float*)(ws + WS_LSE), (const float*)LSE2, (size_t)MTOK * 8, slot2);
    MEGA(PH_WO0, PH_WO0 + 1, 0); MEGA(PH_UP0, PH_UP0 + 1, 0); MEGA(PH_DN0, PH_DN0 + 1, 0); MEGA(PH_GLAP, PH_GLAP + 1, 0);
    hipLaunchKernelGGL(naive_gla, dim3(BATCH * GH), dim3(1024), 0, stream, (const bf16*)(ws + WS_GQ), (const bf16*)(ws + WS_GK), (const bf16*)(ws + WS_GV), (const bf16*)(ws + WS_GG), (const float*)(ws + WS_GB),
                       (const float*)d_in[9], (bf16*)(ws + WS_XB));
    MEGA(PH_WO1, PH_WO1 + 1, 0); MEGA(PH_UP1, PH_UP1 + 1, 0); MEGA(PH_DN1, PH_DN1 + 1, 0); MEGA(PH_FIN, PH_FIN + 1, 0);
    hipLaunchKernelGGL(probe_encode, dim3(2048), dim3(256), 0, stream, (float*)d_out, (size_t)MTOK * DM, slot, 1.0f);
    hipLaunchKernelGGL(probe_encode, dim3(2048), dim3(256), 0, stream, (float*)d_out, (size_t)MTOK * DM, slot2, 1e-3f);
#elif MK_MODE == 4
    a.skip_mask = 0;
    unsigned* slot = (unsigned*)(ws + WS_CTL) + 2048;
    for (int p = PH_PRO; p <= PH_GLA3; ++p) MEGA(p, p + 1, 0);
    hipLaunchKernelGGL(naive_gla, dim3(BATCH * GH), dim3(1024), 0, stream, (const bf16*)(ws + WS_GQ), (const bf16*)(ws + WS_GK), (const bf16*)(ws + WS_GV), (const bf16*)(ws + WS_GG), (const float*)(ws + WS_GB),
                       (const float*)d_in[9], (bf16*)(ws + WS_GS));
    hipLaunchKernelGGL(probe_maxdiff_h, dim3(2048), dim3(256), 0, stream, (const unsigned short*)(ws + WS_XB), (const unsigned short*)(ws + WS_GS), (size_t)MTOK * DM, slot);
    MEGA(PH_WO1, PH_WO1 + 1, 0); MEGA(PH_UP1, PH_UP1 + 1, 0); MEGA(PH_DN1, PH_DN1 + 1, 0); MEGA(PH_FIN, PH_FIN + 1, 0);
    hipLaunchKernelGGL(probe_encode, dim3(2048), dim3(256), 0, stream, (float*)d_out, (size_t)MTOK * DM, slot, 1e-2f);
#else
    a.skip_mask = REP_MASK;
    MEGA(0, PH_N, 0);
#endif
#undef MEGA
}
```

```cpp
#include <hip/hip_runtime.h>
#include <cstdio>
#include <cstdint>
#include <cmath>
#include <hip/hip_runtime.h>
#include <cstdio>
#include <cstdint>
namespace pg8 {
#define PG8_LAS __attribute__((address_space(3)))
typedef unsigned short bf16_t;
typedef short bf16x8 __attribute__((ext_vector_type(8)));
typedef _Float16 f16x8 __attribute__((ext_vector_type(8)));
typedef float f32x4 __attribute__((ext_vector_type(4)));
typedef unsigned u32x4 __attribute__((ext_vector_type(4)));
constexpr int BM = 256, BK = 64, HALF = 128, HTB = HALF * BK * 2  , STAGE_BYTES = 8 * HTB, NXCD = 8, WGM = 8;

__host__ __device__ __forceinline__ int lds_byte(int r, int c) { const int st = (r >> 4) * 2 + (c >> 5), rr = r & 15, cc = c & 31, ob = rr * 64 + cc * 2; return st * 1024 + (ob ^ (((ob >> 9) & 1) << 5)); }
__host__ __device__ __forceinline__ void stage_rc(int b, int& R, int& C) { const int st = b / 1024, sb = b % 1024, swz = sb ^ (((sb >> 9) & 1) << 5); R = (st >> 1) * 16 + swz / 64; C = (st & 1) * 32 + (swz % 64) / 2; }
__host__ __device__ __forceinline__ int perm32(int rho) { const int n = rho >> 4, i = rho & 15; return 8 * (i >> 2) + 4 * n + (i & 3); }

struct Unit { int pm, pn; };
struct Gemm { const bf16_t* A; const bf16_t* Bt; int M, N, K; };

struct StaticOrder {
    int nM, nN, nwg, G, c;
    __host__ __device__ void init(int M, int N, int G_, int c_) { nM = M / BM; nN = N / BM; nwg = nM * nN; G = G_; c = c_; }
    __host__ __device__ bool next(int i, Unit& u) const {
        const long L = (long)i * G + c; if (L >= nwg) return false;
        int wgid = (int)L; { const int q = nwg / NXCD, r = nwg % NXCD, xcd = wgid % NXCD, off = wgid / NXCD; wgid = (xcd < r ? xcd * (q + 1) : r * (q + 1) + (xcd - r) * q) + off; }
        const int nig = WGM * nN, gid = wgid / nig, fm = gid * WGM, gsz = (nM - fm) < WGM ? (nM - fm) : WGM;
        u.pm = fm + ((wgid % nig) % gsz); u.pn = (wgid % nig) / gsz; return true;
    }
    __device__ __forceinline__ void a_ready(const Unit&) const {}
    __device__ __forceinline__ void done(const Unit&) const {}
};

typedef __bf16 bf16x2_t __attribute__((ext_vector_type(2))); typedef float f32x2_t __attribute__((ext_vector_type(2)));
__device__ __forceinline__ unsigned cvt_pk_bf16(float lo, float hi) { const f32x2_t v = {lo, hi}; return __builtin_bit_cast(unsigned, __builtin_convertvector(v, bf16x2_t)); }
typedef unsigned u32x2 __attribute__((ext_vector_type(2)));
typedef _Float16 h16x2 __attribute__((ext_vector_type(2)));
typedef float f32x2 __attribute__((ext_vector_type(2)));
__device__ __forceinline__ unsigned cvt_pk_h(float lo, float hi) { const f32x2 v = {lo, hi}; return __builtin_bit_cast(unsigned, __builtin_convertvector(v, h16x2)); }
constexpr int P_SEQ = 8192, P_DM = 1024, P_DFF = 4096, P_AH = 8, P_HD = 128;
constexpr int RSTD_LDS_OFF = 131072 + 512;
struct PlainOrder : StaticOrder { __device__ __forceinline__ void a_ready(const Unit&, int) const {} };
struct RstdOrder : StaticOrder {
    const float* ssq; PG8_LAS float* rl;
    __device__ __forceinline__ void a_ready(const Unit& u, int ui) const {
        int t = threadIdx.x; asm volatile("" : "+v"(t));
        const int row = t >> 1, hf = t & 1;
        const f32x4* p = (const f32x4*)(ssq + (size_t)(u.pm * BM + row) * 16 + hf * 8); const f32x4 a = p[0], b = p[1];
        float s = ((a[0] + a[1]) + (a[2] + a[3])) + ((b[0] + b[1]) + (b[2] + b[3])); s += __shfl_xor(s, 1);
        if (hf == 0) rl[(ui & 1) * 256 + row] = 1.0f / sqrtf(s * (1.0f / 1024.0f) + 1e-5f);
    }
};
__device__ __forceinline__ void row_rstd(const PG8_LAS float* rl, int ui, int wr, int fr, float (&rs)[2][4]) {
#pragma unroll
    for (int ai = 0; ai < 2; ++ai)
#pragma unroll
        for (int m = 0; m < 4; ++m) rs[ai][m] = rl[(ui & 1) * 256 + ai * HALF + wr * 64 + m * 16 + fr];
}
__device__ __forceinline__ float hlo_(unsigned w) { return (float)__builtin_bit_cast(h16x2, w)[0]; }
__device__ __forceinline__ float hhi_(unsigned w) { return (float)__builtin_bit_cast(h16x2, w)[1]; }
__device__ __forceinline__ u32x4 pack8h(const f32x4 a, const f32x4 b) { u32x4 w; w.x = cvt_pk_h(a[0], a[1]); w.y = cvt_pk_h(a[2], a[3]); w.z = cvt_pk_h(b[0], b[1]); w.w = cvt_pk_h(b[2], b[3]); return w; }
__device__ __forceinline__ u32x4 pack8(const f32x4 a, const f32x4 b) { u32x4 w; w.x = cvt_pk_bf16(a[0], a[1]); w.y = cvt_pk_bf16(a[2], a[3]); w.z = cvt_pk_bf16(b[0], b[1]); w.w = cvt_pk_bf16(b[2], b[3]); return w; }

struct EpiQKV {
    static constexpr bool PERM = true, AFTER_DRAIN = false;
    bf16_t* Q; bf16_t* K; bf16_t* V; const PG8_LAS float* rl; const bf16_t* cosT; const bf16_t* sinT; int ldil;
    __device__ __forceinline__ void operator()(const f32x4 (&acc)[2][2][4][2], const Unit& u, int wr, int wc, int fr, int fq, int ui) const {
        const int row0 = u.pm * BM + wr * 64 + fr;
        float rs[2][4]; row_rstd(rl, ui, wr, fr, rs);
        const int which = u.pn >> 2, hp = u.pn & 3, dmask = (1 << ldil) - 1, L = P_SEQ >> ldil;
        if (which < 2) {
            bf16_t* dst = which == 0 ? Q : K;
            const int head = 2 * hp + (wc >> 1), d0 = 32 * (wc & 1) + 8 * fq;
#pragma unroll
            for (int ai = 0; ai < 2; ++ai) {
                u32x4 cw[4], sw[4];
#pragma unroll
                for (int m = 0; m < 4; ++m) { const int t = (row0 + ai * HALF + m * 16) & (P_SEQ - 1);
                    cw[m] = *(const u32x4*)(cosT + t * 64 + d0); sw[m] = *(const u32x4*)(sinT + t * 64 + d0); }
#pragma unroll
                for (int m = 0; m < 4; ++m) { const int row = row0 + ai * HALF + m * 16, b = row >> 13, t = row & (P_SEQ - 1), r = t & dmask, i = t >> ldil;
                    bf16_t* p = dst + ((size_t)((((b * P_AH + head) << ldil) + r)) * L + i) * P_HD + d0;
                    const u32x4 cq = cw[m], sq = sw[m];
                    const f32x4 c0 = {hlo_(cq.x), hhi_(cq.x), hlo_(cq.y), hhi_(cq.y)}, c1 = {hlo_(cq.z), hhi_(cq.z), hlo_(cq.w), hhi_(cq.w)};
                    const f32x4 s0 = {hlo_(sq.x), hhi_(sq.x), hlo_(sq.y), hhi_(sq.y)}, s1 = {hlo_(sq.z), hhi_(sq.z), hlo_(sq.w), hhi_(sq.w)};
                    const float sc = rs[ai][m];
                    const f32x4 x1a = acc[ai][0][m][0] * sc, x1b = acc[ai][0][m][1] * sc, x2a = acc[ai][1][m][0] * sc, x2b = acc[ai][1][m][1] * sc;
                    const f32x4 o1a = x1a * c0 - x2a * s0, o1b = x1b * c1 - x2b * s1, o2a = x2a * c0 + x1a * s0, o2b = x2b * c1 + x1b * s1;
                    *(u32x4*)p = pack8h(o1a, o1b); *(u32x4*)(p + 64) = pack8h(o2a, o2b); }
                asm volatile("" ::: "memory"); }
        } else {
            const int dd = 32 * wc + 8 * fq;
#pragma unroll
            for (int ai = 0; ai < 2; ++ai)
#pragma unroll
                for (int m = 0; m < 4; ++m) { const int row = row0 + ai * HALF + m * 16, b = row >> 13, t = row & (P_SEQ - 1), r = t & dmask, i = t >> ldil;
                    const float sc = rs[ai][m];
#pragma unroll
                    for (int bj = 0; bj < 2; ++bj) { const int head = 2 * hp + bj;
                        bf16_t* p = V + ((size_t)((((b * P_AH + head) << ldil) + r)) * L + i) * P_HD + dd;
                        *(u32x4*)p = pack8h(acc[ai][bj][m][0] * sc, acc[ai][bj][m][1] * sc); } }
        }
    }
};
struct EpiResid {
    static constexpr bool PERM = false, AFTER_DRAIN = false;
    const float* resid; float* out; bf16_t* xb; float* ssq;
    __device__ __forceinline__ void operator()(const f32x4 (&acc)[2][2][4][2], const Unit& u, int wr, int wc, int fr, int fq, int ui) const {
        const int row0 = u.pm * BM + wr * 64 + fr, col0 = u.pn * BM + wc * 32 + 4 * fq;
#pragma unroll
        for (int ai = 0; ai < 2; ++ai) {
            f32x4 rv[4][2][2];
#pragma unroll
            for (int m = 0; m < 4; ++m) { const size_t off = (size_t)(row0 + ai * HALF + m * 16) * P_DM + col0;
#pragma unroll
                for (int bj = 0; bj < 2; ++bj)
#pragma unroll
                    for (int n = 0; n < 2; ++n) rv[m][bj][n] = *(const f32x4*)(resid + off + bj * HALF + n * 16); }
#pragma unroll
            for (int m = 0; m < 4; ++m) { const int row = row0 + ai * HALF + m * 16; const size_t off = (size_t)row * P_DM + col0; float s = 0.f;
#pragma unroll
                for (int bj = 0; bj < 2; ++bj)
#pragma unroll
                    for (int n = 0; n < 2; ++n) { const f32x4 v = acc[ai][bj][m][n] + rv[m][bj][n];
                        *(f32x4*)(out + off + bj * HALF + n * 16) = v; s += (v[0] * v[0] + v[1] * v[1]) + (v[2] * v[2] + v[3] * v[3]);
                        u32x2 w; w.x = cvt_pk_h(v[0], v[1]); w.y = cvt_pk_h(v[2], v[3]); *(u32x2*)(xb + off + bj * HALF + n * 16) = w; }
                s += __shfl_xor(s, 16); s += __shfl_xor(s, 32);
                if (fq == 0) ssq[(size_t)row * 16 + u.pn * 4 + wc] = s; }
            asm volatile("" ::: "memory"); }
    }
};
struct EpiUp {
    static constexpr bool PERM = true, AFTER_DRAIN = false;
    bf16_t* H; const PG8_LAS float* rl;
    __device__ __forceinline__ void operator()(const f32x4 (&acc)[2][2][4][2], const Unit& u, int wr, int wc, int fr, int fq, int ui) const {
        const int row0 = u.pm * BM + wr * 64 + fr, col0 = u.pn * BM + wc * 32 + 8 * fq;
        float rs[2][4]; row_rstd(rl, ui, wr, fr, rs);
#pragma unroll
        for (int ai = 0; ai < 2; ++ai)
#pragma unroll
            for (int m = 0; m < 4; ++m) { bf16_t* rowp = H + (size_t)(row0 + ai * HALF + m * 16) * P_DFF + col0; const float sc = rs[ai][m];
#pragma unroll
                for (int bj = 0; bj < 2; ++bj) { f32x4 v0 = acc[ai][bj][m][0] * sc, v1 = acc[ai][bj][m][1] * sc;
                    v0 = __builtin_elementwise_max(v0, (f32x4){0.f, 0.f, 0.f, 0.f}); v1 = __builtin_elementwise_max(v1, (f32x4){0.f, 0.f, 0.f, 0.f});
                    const f32x4 cap = {65504.f, 65504.f, 65504.f, 65504.f};
                    *(u32x4*)(rowp + bj * HALF) = pack8h(__builtin_elementwise_min(v0 * v0, cap), __builtin_elementwise_min(v1 * v1, cap)); } }
    }
};
struct EpiGla {
    static constexpr bool PERM = true, AFTER_DRAIN = false;
    bf16_t* q; bf16_t* k; bf16_t* v; bf16_t* g; const PG8_LAS float* rl;
    __device__ __forceinline__ void operator()(const f32x4 (&acc)[2][2][4][2], const Unit& u, int wr, int wc, int fr, int fq, int ui) const {
        const int row0 = u.pm * BM + wr * 64 + fr;
        float rs[2][4]; row_rstd(rl, ui, wr, fr, rs);
        bf16_t* dst; int ld, coff;
        if (u.pn < 2) { dst = q; ld = 512; coff = u.pn * 256; } else if (u.pn < 4) { dst = k; ld = 512; coff = (u.pn - 2) * 256; }
        else if (u.pn < 8) { dst = v; ld = 1024; coff = (u.pn - 4) * 256; } else { dst = g; ld = 1024; coff = (u.pn - 8) * 256; }
        const int col0 = coff + wc * 32 + 8 * fq;
#pragma unroll
        for (int ai = 0; ai < 2; ++ai)
#pragma unroll
            for (int m = 0; m < 4; ++m) { bf16_t* rowp = dst + (size_t)(row0 + ai * HALF + m * 16) * ld + col0; const float sc = rs[ai][m];
#pragma unroll
                for (int bj = 0; bj < 2; ++bj) *(u32x4*)(rowp + bj * HALF) = pack8(acc[ai][bj][m][0] * sc, acc[ai][bj][m][1] * sc); }
    }
};
template <class Epi, class Sched, bool ALIGN_EPI = false, bool SP2 = false>
__device__ __forceinline__ void gemm_phase(PG8_LAS unsigned char* lds, const Gemm g, const Sched& S, const Epi& E) {
    int tid_ = threadIdx.x; asm volatile("" : "+v"(tid_));
    const int tid = tid_, wid = __builtin_amdgcn_readfirstlane(tid >> 6), lane = tid & 63, wr = wid >> 2, wc = wid & 3, fr = lane & 15, fq = lane >> 4;
    const int K = g.K, nt = K / BK;
    unsigned voffA[2], voffB[2];
#pragma unroll
    for (int i = 0; i < 2; ++i) { int R, C; stage_rc(tid * 16 + i * 8192, R, C); const int Rb = Epi::PERM ? ((R & ~31) + perm32(R & 31)) : R;
        voffA[i] = (unsigned)(R * K + C) * 2u; voffB[i] = (unsigned)(Rb * K + C) * 2u; }
    const size_t kstep = (size_t)(BK * 2);
    const size_t hstep = (size_t)HALF * K * 2;
    const size_t tstep = 2 * hstep;
    const unsigned ldsw = (unsigned)wid * 1024u;
    const int aoff = lds_byte(wr * 64 + fr, fq * 8), boff = lds_byte(wc * 32 + fr, fq * 8);
#define PG8_SA(b, h) (((b) * 2 + (h)) * HTB)
#define PG8_SB(b, h) ((4 + (b) * 2 + (h)) * HTB)
#define PG8_STAGE(bufoff, gbase, voff) do { _Pragma("unroll") for (int _i = 0; _i < 2; ++_i) \
        __builtin_amdgcn_global_load_lds((const unsigned*)((const char*)(gbase) + (voff)[_i]), (PG8_LAS unsigned*)(lds + (bufoff) + ldsw + _i * 8192), 16, 0, 0); } while (0)
#define PG8_LDA(dst, b, h) do { _Pragma("unroll") for (int m = 0; m < 4; ++m) _Pragma("unroll") for (int k = 0; k < 2; ++k) dst[m][k] = *(const PG8_LAS bf16x8*)(lds + PG8_SA(b, h) + aoff + m * 2048 + k * 1024); } while (0)
#define PG8_LDB(dst, b, h) do { _Pragma("unroll") for (int n = 0; n < 2; ++n) _Pragma("unroll") for (int k = 0; k < 2; ++k) dst[n][k] = *(const PG8_LAS bf16x8*)(lds + PG8_SB(b, h) + boff + n * 2048 + k * 1024); } while (0)
#define PG8_MMA(ai, bj, At, Bt) do { __builtin_amdgcn_s_setprio(1); _Pragma("unroll") for (int m = 0; m < 4; ++m) _Pragma("unroll") for (int n = 0; n < 2; ++n) _Pragma("unroll") for (int k = 0; k < 2; ++k) \
        acc[ai][bj][m][n] = __builtin_amdgcn_mfma_f32_16x16x32_f16(__builtin_bit_cast(f16x8, Bt[n][k]), __builtin_bit_cast(f16x8, At[m][k]), acc[ai][bj][m][n], 0, 0, 0); __builtin_amdgcn_s_setprio(0); } while (0)
#define PG8_WAIT_V(n) asm volatile("s_waitcnt vmcnt(" #n ")" ::: "memory")
#define PG8_WAIT_L(n) asm volatile("s_waitcnt lgkmcnt(" #n ")" ::: "memory")
#define PG8_BAR __builtin_amdgcn_s_barrier()
#define PG8_SCHED __builtin_amdgcn_sched_barrier(0)
    Unit cur, nxt; int ui = 0;
    if (!S.next(0, cur)) return;
    f32x4 acc[2][2][4][2];
#pragma unroll
    for (int a = 0; a < 2; ++a)
#pragma unroll
        for (int b = 0; b < 2; ++b)
#pragma unroll
            for (int m = 0; m < 4; ++m)
#pragma unroll
                for (int n = 0; n < 2; ++n) acc[a][b][m][n] = (f32x4){0.f, 0.f, 0.f, 0.f};
    bf16x8 At[4][2], B0[2][2], B1[2][2];
    const char* cA = (const char*)g.A + (size_t)cur.pm * tstep; const char* cB = (const char*)g.Bt + (size_t)cur.pn * tstep;
    S.a_ready(cur, 0);
    if constexpr (SP2) {
        PG8_STAGE(PG8_SB(0, 0), cB, voffB); PG8_STAGE(PG8_SB(0, 1), cB + hstep, voffB); PG8_STAGE(PG8_SA(0, 0), cA, voffA); PG8_STAGE(PG8_SA(0, 1), cA + hstep, voffA);
        if (wr == 1) PG8_BAR;
        PG8_WAIT_V(2); PG8_BAR;
        PG8_STAGE(PG8_SB(1, 0), cB + kstep, voffB); PG8_STAGE(PG8_SA(1, 0), cA + kstep, voffA); PG8_STAGE(PG8_SB(1, 1), cB + hstep + kstep, voffB);
        PG8_WAIT_V(6); PG8_BAR;
    } else {
        PG8_STAGE(PG8_SB(0, 0), cB, voffB); PG8_STAGE(PG8_SA(0, 0), cA, voffA); PG8_STAGE(PG8_SB(0, 1), cB + hstep, voffB); PG8_STAGE(PG8_SA(0, 1), cA + hstep, voffA);
        if (wr == 1) PG8_BAR;
        PG8_WAIT_V(4); PG8_BAR;
        PG8_STAGE(PG8_SB(1, 0), cB + kstep, voffB); PG8_STAGE(PG8_SA(1, 0), cA + kstep, voffA); PG8_STAGE(PG8_SB(1, 1), cB + hstep + kstep, voffB);
        PG8_WAIT_V(6); PG8_BAR;
    }
    for (;;) {
        const bool has_next = S.next(ui + 1, nxt);
        const char* nA = has_next ? (const char*)g.A + (size_t)nxt.pm * tstep : cA; const char* nB = has_next ? (const char*)g.Bt + (size_t)nxt.pn * tstep : cB;
        for (int t = 0; t < nt; t += 2) {
            const bool last = (t == nt - 2);
            const char* a1 = cA + (size_t)(t + 1) * kstep;
            const char* a2 = last ? nA : cA + (size_t)(t + 2) * kstep; const char* b2 = last ? nB : cB + (size_t)(t + 2) * kstep;
            const char* a3 = a2 + kstep; const char* b3 = b2 + kstep;
            if (last && has_next) S.a_ready(nxt, ui + 1);
            if constexpr (SP2) {
            PG8_LDB(B0, 0, 0); PG8_LDB(B1, 0, 1); PG8_SCHED; PG8_LDA(At, 0, 0); PG8_STAGE(PG8_SA(1, 1), a1 + hstep, voffA);
            PG8_WAIT_V(8); PG8_WAIT_L(0); PG8_BAR; PG8_MMA(0, 0, At, B0); PG8_MMA(0, 1, At, B1); PG8_BAR; PG8_SCHED;
            PG8_LDA(At, 0, 1); PG8_STAGE(PG8_SB(0, 0), b2, voffB); PG8_STAGE(PG8_SB(0, 1), b2 + hstep, voffB); PG8_STAGE(PG8_SA(0, 0), a2, voffA);
            PG8_WAIT_V(8); PG8_WAIT_L(0); PG8_BAR; PG8_MMA(1, 0, At, B0); PG8_MMA(1, 1, At, B1); PG8_BAR; PG8_SCHED;
            PG8_LDB(B0, 1, 0); PG8_LDB(B1, 1, 1); PG8_SCHED; PG8_LDA(At, 1, 0); PG8_STAGE(PG8_SA(0, 1), a2 + hstep, voffA);
            PG8_WAIT_V(8); PG8_WAIT_L(0); PG8_BAR; PG8_MMA(0, 0, At, B0); PG8_MMA(0, 1, At, B1); PG8_BAR; PG8_SCHED;
            PG8_LDA(At, 1, 1); PG8_STAGE(PG8_SB(1, 0), b3, voffB); PG8_STAGE(PG8_SB(1, 1), b3 + hstep, voffB); PG8_STAGE(PG8_SA(1, 0), a3, voffA);
            PG8_WAIT_V(8); PG8_WAIT_L(0); PG8_BAR; PG8_MMA(1, 0, At, B0); PG8_MMA(1, 1, At, B1); PG8_BAR; PG8_SCHED;
            } else {
            PG8_LDB(B0, 0, 0); PG8_SCHED; PG8_LDA(At, 0, 0); PG8_STAGE(PG8_SA(1, 1), a1 + hstep, voffA);
            PG8_WAIT_L(8); PG8_BAR; PG8_WAIT_L(0); PG8_MMA(0, 0, At, B0); PG8_BAR; PG8_SCHED;
            PG8_LDB(B1, 0, 1); PG8_STAGE(PG8_SB(0, 0), b2, voffB);
            PG8_BAR; PG8_WAIT_L(0); PG8_MMA(0, 1, At, B1); PG8_BAR;
            PG8_LDA(At, 0, 1); PG8_STAGE(PG8_SA(0, 0), a2, voffA);
            PG8_BAR; PG8_WAIT_L(0); PG8_MMA(1, 0, At, B0); PG8_BAR; PG8_SCHED;
            PG8_STAGE(PG8_SB(0, 1), b2 + hstep, voffB);
            PG8_WAIT_V(6); PG8_BAR; PG8_MMA(1, 1, At, B1); PG8_BAR;
            PG8_LDB(B0, 1, 0); PG8_SCHED; PG8_LDA(At, 1, 0); PG8_STAGE(PG8_SA(0, 1), a2 + hstep, voffA);
            PG8_WAIT_L(8); PG8_BAR; PG8_WAIT_L(0); PG8_MMA(0, 0, At, B0); PG8_BAR; PG8_SCHED;
            PG8_LDB(B1, 1, 1); PG8_STAGE(PG8_SB(1, 0), b3, voffB);
            PG8_BAR; PG8_WAIT_L(0); PG8_MMA(0, 1, At, B1); PG8_BAR;
            PG8_LDA(At, 1, 1); PG8_STAGE(PG8_SA(1, 0), a3, voffA);
            PG8_BAR; PG8_WAIT_L(0); PG8_MMA(1, 0, At, B0); PG8_BAR; PG8_SCHED;
            PG8_STAGE(PG8_SB(1, 1), b3 + hstep, voffB);
            PG8_WAIT_V(6); PG8_BAR; PG8_MMA(1, 1, At, B1); PG8_BAR;
            }
        }
        if constexpr (ALIGN_EPI) { if (wr == 0) PG8_BAR; }
        if constexpr (!Epi::AFTER_DRAIN) { E(acc, cur, wr, wc, fr, fq, ui); S.done(cur); }
        if (!has_next) break;
#pragma unroll
        for (int a = 0; a < 2; ++a)
#pragma unroll
            for (int b = 0; b < 2; ++b)
#pragma unroll
                for (int m = 0; m < 4; ++m)
#pragma unroll
                    for (int n = 0; n < 2; ++n) acc[a][b][m][n] = (f32x4){0.f, 0.f, 0.f, 0.f};
        cur = nxt; cA = nA; cB = nB; ++ui;
        if constexpr (ALIGN_EPI) { if (wr == 1) PG8_BAR; }
    }
    PG8_WAIT_V(0);
    if constexpr (!ALIGN_EPI) { if (wr == 0) PG8_BAR; }
    PG8_BAR;
    if constexpr (Epi::AFTER_DRAIN) { E.fused(acc, cur, wr, wc, fr, fq, lds, wid, lane); S.done(cur); }
#undef PG8_SA
#undef PG8_SB
#undef PG8_STAGE
#undef PG8_LDA
#undef PG8_LDB
#undef PG8_MMA
#undef PG8_WAIT_V
#undef PG8_WAIT_L
#undef PG8_BAR
#undef PG8_SCHED
}
}
#define GAS __attribute__((address_space(1)))
#define LAS __attribute__((address_space(3)))
typedef unsigned short bf16;
typedef unsigned v4u __attribute__((ext_vector_type(4)));
typedef float f32x4 __attribute__((ext_vector_type(4)));
typedef short bf16x8 __attribute__((ext_vector_type(8)));
typedef GAS unsigned gu32;
typedef GAS unsigned long long gu64;
#define RLX_AGENT __ATOMIC_RELAXED, __HIP_MEMORY_SCOPE_AGENT
#define LDS_WAIT() asm volatile("s_waitcnt lgkmcnt(0)" ::: "memory")
#define VM_WAIT() asm volatile("s_waitcnt vmcnt(0)" ::: "memory")
__device__ __forceinline__ unsigned long long rt() { return __builtin_amdgcn_s_memrealtime(); }
__device__ __forceinline__ unsigned f2bf(float f) { unsigned u = __builtin_bit_cast(unsigned, f); return (u + 0x7fffu + ((u >> 16) & 1u)) >> 16; }
__device__ __forceinline__ unsigned pk2(float lo, float hi) { return f2bf(lo) | (f2bf(hi) << 16); }

#define XB_TMO      128
#define XB_XCNT(j)  (256  + 64 * (j))
#define XB_XSUB(j)  (1280 + 64 * (j))
#define XB_XGEN(j)  (2304 + 64 * (j))
#define XB_TOP      3328
#define XB_TOPGEN   3392
#define XCD_BAR_WORDS 3456
#define XB_SPIN_CAP (1u << 18)

__device__ __forceinline__ unsigned xb_ld(unsigned* p)              { return __hip_atomic_load(p, __ATOMIC_RELAXED, __HIP_MEMORY_SCOPE_AGENT); }
__device__ __forceinline__ unsigned xb_add(unsigned* p, unsigned v) { return __hip_atomic_fetch_add(p, v, __ATOMIC_RELAXED, __HIP_MEMORY_SCOPE_AGENT); }
__device__ __forceinline__ unsigned xb_xcc_id() { return (unsigned)__builtin_amdgcn_s_getreg((3 << 11) | 20) & 0xFu; }
#define XB_SPIN(cond, bar) do { unsigned _sp = 0; while (cond) { __builtin_amdgcn_s_sleep(1); \
    if ((++_sp & 255u) == 0u) { if (xb_ld(&(bar)[XB_TMO])) break; if (_sp > XB_SPIN_CAP) { atomicAdd(&(bar)[XB_TMO], 1u); break; } } } } while (0)

struct XcdBarrier {
    unsigned* bar; unsigned x;
    volatile LAS unsigned* st;
};

__device__ __forceinline__ XcdBarrier xcd_barrier_post(unsigned* bar, volatile LAS unsigned* st) {
    XcdBarrier b; b.bar = bar; b.x = xb_xcc_id(); b.st = st;
    if (threadIdx.x == 0) (void)xb_add(&bar[XB_XCNT(b.x)], 1u);
    return b;
}
__device__ __forceinline__ void xcd_barrier_complete(unsigned* bar, unsigned x, unsigned& nloc, unsigned& nx) {
    const unsigned G = gridDim.x * gridDim.y * gridDim.z;
    unsigned sum, cnt, mine, sp = 0u;
    for (;;) {
        sum = 0u; cnt = 0u; mine = 0u;
#pragma unroll
        for (unsigned j = 0; j < 16; ++j) { const unsigned c = xb_ld(&bar[XB_XCNT(j)]); sum += c; cnt += (c > 0u) ? 1u : 0u; mine = (j == x) ? c : mine; }
        if (sum == G) break;
        __builtin_amdgcn_s_sleep(1);
        if ((++sp & 255u) == 0u) { if (xb_ld(&bar[XB_TMO])) break; if (sp > XB_SPIN_CAP) { atomicAdd(&bar[XB_TMO], 1u); break; } }
    }
    nloc = mine > 0u ? mine : 1u; nx = cnt > 0u ? cnt : 1u;
}

__device__ __forceinline__ void xcd_barrier(const XcdBarrier& b) {
    asm volatile("s_waitcnt vmcnt(0)" ::: "memory");
    __syncthreads();
    if (threadIdx.x == 0) {
        unsigned* bar = b.bar;
        __builtin_amdgcn_s_waitcnt(0);
        unsigned nloc = b.st[0], nx = b.st[1];
        if (nloc == 0u) { xcd_barrier_complete(bar, b.x, nloc, nx); b.st[0] = nloc; b.st[1] = nx; }
        const unsigned old = xb_add(&bar[XB_XSUB(b.x)], 1u);
        const unsigned gen = old / nloc;
        if (old + 1u == (gen + 1u) * nloc) {
            __builtin_amdgcn_fence(__ATOMIC_RELEASE, "agent");
            asm volatile("s_waitcnt vmcnt(0)" ::: "memory");
            const unsigned og = xb_add(&bar[XB_TOP], 1u);
            const unsigned tg = og / nx;
            if (og + 1u == (tg + 1u) * nx) xb_add(&bar[XB_TOPGEN], 1u);
            else XB_SPIN(xb_ld(&bar[XB_TOPGEN]) == tg, bar);
            __builtin_amdgcn_fence(__ATOMIC_ACQUIRE, "agent");
            xb_add(&bar[XB_XGEN(b.x)], 1u);
            asm volatile("s_waitcnt vmcnt(0)" ::: "memory");
        } else {
            XB_SPIN(xb_ld(&bar[XB_XGEN(b.x)]) == gen, bar);
            __builtin_amdgcn_fence(__ATOMIC_ACQUIRE, "agent");
            asm volatile("s_waitcnt vmcnt(0)" ::: "memory");
        }
    }
    __syncthreads();
}

namespace swa {
typedef unsigned short u16;
typedef short bf16x8 __attribute__((ext_vector_type(8)));
typedef _Float16 f16x8 __attribute__((ext_vector_type(8)));
typedef short s16x4 __attribute__((ext_vector_type(4)));
typedef float f32x16 __attribute__((ext_vector_type(16)));
typedef float f32x4 __attribute__((ext_vector_type(4)));
typedef unsigned u32x4 __attribute__((ext_vector_type(4)));
constexpr int D = 128, W = 129;
constexpr float THR = 8.f;
constexpr float SCALE = 0.08838834764831845f;
constexpr int NW = 8, QBLK = 32, KVBLK = 64, QB = NW * QBLK;
constexpr int SHM_V = KVBLK * D * 2, SHM_K = KVBLK * D * 2;
constexpr int LDS_BYTES = 2 * SHM_V + 2 * SHM_K + NW * 64 * 4;
#define KSWZ(row, colB) ((row) * 256 + ((colB) ^ (((row) & 7) << 4)))
#define SBAR() __builtin_amdgcn_sched_barrier(0)
__device__ __forceinline__ int v_st(int k, int c) { const int kk = (k & ~0xC) | ((k & 4) << 1) | ((k & 8) >> 1); return ((kk >> 3) * 4 + (c >> 5)) * 512 + ((kk & 7) * 32 + (c & 31)) * 2; }
__device__ __forceinline__ int v_rd_base(int lane) { return ((lane & 3) << 3) | (((lane >> 2) & 3) << 6) | (((lane >> 4) & 1) << 5) | (((lane >> 5) & 1) << 8); }
constexpr int v_rd_off(int d0, int ks, int half) { return d0 * 512 + ks * 4096 + half * 2048; }
__device__ __forceinline__ int crow(int r, int hi) { return (r & 3) + 8 * (r >> 2) + 4 * hi; }
__device__ __forceinline__ unsigned cvtpk(float lo, float hi) { return pg8::cvt_pk_h(lo, hi); }
__device__ __forceinline__ float hlo(unsigned w) { return (float)__builtin_bit_cast(pg8::h16x2, w)[0]; }
__device__ __forceinline__ float hhi(unsigned w) { return (float)__builtin_bit_cast(pg8::h16x2, w)[1]; }
__device__ __forceinline__ bf16x8 load8(const u16* p) { return *reinterpret_cast<const bf16x8*>(p); }
#define SWA_MFMA(a, b, c) __builtin_amdgcn_mfma_f32_32x32x16_f16(__builtin_bit_cast(f16x8, a), __builtin_bit_cast(f16x8, b), c, 0, 0, 0)
__device__ __forceinline__ void mask_tile(f32x16& p0, f32x16& p1, int dq, unsigned Wd) {
    const float NEG = -__builtin_inff();
#pragma unroll
    for (int r = 0; r < 16; ++r) {
        const int c = (r & 3) + 8 * (r >> 2);
        if ((unsigned)(dq - c) >= Wd) p0[r] = NEG;
        if ((unsigned)(dq - c - 32) >= Wd) p1[r] = NEG;
    }
}
__device__ __forceinline__ void partialSM(f32x16& p0, f32x16& p1, float& m_reg, float& mn, float& alpha) {
    float pmax = p0[0]; for (int r = 1; r < 16; ++r) pmax = fmaxf(pmax, p0[r]); for (int r = 0; r < 16; ++r) pmax = fmaxf(pmax, p1[r]);
    { auto rr = __builtin_amdgcn_permlane32_swap(__float_as_uint(pmax), __float_as_uint(pmax), false, false);
      pmax = fmaxf(__uint_as_float(rr[0]), __uint_as_float(rr[1])); }
    constexpr float C2 = 1.4426950408889634f * SCALE;
    if (__builtin_expect(__all((pmax - m_reg) * SCALE <= THR), 1)) { mn = m_reg; alpha = 1.f; }
    else { mn = fmaxf(m_reg, pmax); alpha = __builtin_amdgcn_exp2f((m_reg - mn) * C2); m_reg = mn; }
    const float mnL = -mn * C2;
    for (int r = 0; r < 16; ++r) p0[r] = fmaf(p0[r], C2, mnL); for (int r = 0; r < 16; ++r) p1[r] = fmaf(p1[r], C2, mnL);
    for (int r = 0; r < 16; ++r) p0[r] = __builtin_amdgcn_exp2f(p0[r]);
}
__device__ __forceinline__ void finishSM(f32x16& p0, f32x16& p1, float alpha, float& l_reg, bf16x8& pa0, bf16x8& pa1, bf16x8& pa2, bf16x8& pa3) {
    for (int r = 0; r < 16; ++r) p1[r] = __builtin_amdgcn_exp2f(p1[r]);
    float ps = 0; for (int r = 0; r < 16; ++r) ps += p0[r]; for (int r = 0; r < 16; ++r) ps += p1[r];
    { auto rr = __builtin_amdgcn_permlane32_swap(__float_as_uint(ps), __float_as_uint(ps), false, false);
      ps = __uint_as_float(rr[0]) + __uint_as_float(rr[1]); }
    l_reg = l_reg * alpha + ps;
#define PK4(P, B_, OUT) do { unsigned a0 = cvtpk(P[B_+0], P[B_+1]), a1 = cvtpk(P[B_+2], P[B_+3]);                          \
        unsigned b0 = cvtpk(P[B_+4], P[B_+5]), b1 = cvtpk(P[B_+6], P[B_+7]);                                             \
        auto r0 = __builtin_amdgcn_permlane32_swap(a0, b0, false, false); auto r1 = __builtin_amdgcn_permlane32_swap(a1, b1, false, false); \
        u32x4 w = {r0[0], r1[0], r0[1], r1[1]}; OUT = *reinterpret_cast<bf16x8*>(&w); } while (0)
    PK4(p0, 0, pa0); PK4(p0, 8, pa1); PK4(p1, 0, pa2); PK4(p1, 8, pa3);
#undef PK4
}
template <int KB>
__device__ __forceinline__ void qkt(f32x16& p0, f32x16& p1, const char* K_lds, int r32, int hi, const bf16x8* qr, bool act) {
    if (!act) { const float NEG = -__builtin_inff();
#pragma unroll
        for (int r = 0; r < 16; ++r) { p0[r] = NEG; p1[r] = NEG; } return; }
    p0 = f32x16{}; p1 = f32x16{};
    const char* kb[4];
#pragma unroll
    for (int dd = 0; dd < 4; ++dd) kb[dd] = K_lds + KB * SHM_K + KSWZ(r32, (dd * 16 + hi * 8) * 2);
#pragma unroll
    for (int d0 = 0; d0 < 8; ++d0) { const char* a = kb[d0 & 3] + (d0 >> 2) * 128;
        bf16x8 b0 = *reinterpret_cast<const bf16x8*>(a);
        bf16x8 b1 = *reinterpret_cast<const bf16x8*>(a + 32 * 256);
        p0 = SWA_MFMA(b0, qr[d0], p0);
        p1 = SWA_MFMA(b1, qr[d0], p1); }
}
template <int VB>
__device__ __forceinline__ void pv_tile(f32x16* o, int vb0, bf16x8 pa0, bf16x8 pa1, bf16x8 pa2, bf16x8 pa3, bool act) {
    if (!act) return;
#define TRRD(dst, off) asm volatile("ds_read_b64_tr_b16 %0, %1 offset:%2" : "=&v"(dst) : "v"(vb0), "i"(off) : "memory")
#define PV_D0(d0) do { s16x4 l0, l1, l2, l3, h0, h1, h2, h3; constexpr int b_ = VB * SHM_V + v_rd_off(d0, 0, 0); \
        TRRD(l0, b_); TRRD(h0, b_ + 2048); TRRD(l1, b_ + 4096); TRRD(h1, b_ + 6144); TRRD(l2, b_ + 8192); TRRD(h2, b_ + 10240); TRRD(l3, b_ + 12288); TRRD(h3, b_ + 14336); \
        asm volatile("s_waitcnt lgkmcnt(0)" ::: "memory"); SBAR();   \
        o[d0] = SWA_MFMA(pa0, ((bf16x8){l0[0], l0[1], l0[2], l0[3], h0[0], h0[1], h0[2], h0[3]}), o[d0]);   \
        o[d0] = SWA_MFMA(pa1, ((bf16x8){l1[0], l1[1], l1[2], l1[3], h1[0], h1[1], h1[2], h1[3]}), o[d0]);   \
        o[d0] = SWA_MFMA(pa2, ((bf16x8){l2[0], l2[1], l2[2], l2[3], h2[0], h2[1], h2[2], h2[3]}), o[d0]);   \
        o[d0] = SWA_MFMA(pa3, ((bf16x8){l3[0], l3[1], l3[2], l3[3], h3[0], h3[1], h3[2], h3[3]}), o[d0]); } while (0)
    PV_D0(0); PV_D0(1); PV_D0(2); PV_D0(3);
#undef PV_D0
#undef TRRD
}
struct BlockRef { const u16* Q; const u16* K; const u16* V; int P0, skv, trow0, tstep, h; };
struct Seam { bf16x8 qr[8]; bf16x8 st_v0, st_v1, st_k0, st_k1; };
__device__ __forceinline__ int swa_jlo(int P0) { const int lowk = P0 - W + 1; return lowk > 0 ? lowk / KVBLK : 0; }
#define ROW(p, k0, rr) ((p) + (size_t)((k0) + (rr)) * D + sc)
#define VMW() asm volatile("s_waitcnt vmcnt(0)" ::: "memory")
#define VMWN(n) asm volatile("s_waitcnt vmcnt(%0)" :: "i"(n) : "memory")
#define SLOAD_H(Kp, Vp, k0) do { S.st_v0 = load8(ROW(Vp, k0, sr)); S.st_v1 = load8(ROW(Vp, k0, 32 + sr));              \
                         S.st_k0 = load8(ROW(Kp, k0, sr)); S.st_k1 = load8(ROW(Kp, k0, 32 + sr)); } while (0)
#define SWRITE_HK(bf) do { *(bf16x8*)(K_lds + (bf) * SHM_K + kws) = S.st_k0; *(bf16x8*)(K_lds + (bf) * SHM_K + kws + 32 * 256) = S.st_k1; } while (0)
#define SWRITE_HV(bf) do { *(bf16x8*)(V_lds + (bf) * SHM_V + vst0) = S.st_v0; *(bf16x8*)(V_lds + (bf) * SHM_V + vst1) = S.st_v1; } while (0)
#define SWRITE_H(bf) do { SWRITE_HV(bf); SWRITE_HK(bf); } while (0)
__device__ __forceinline__ void swa_prime(const BlockRef& cur, char* lds, Seam& S) {
    int tid = threadIdx.x; asm volatile("" : "+v"(tid));
    const int wid = __builtin_amdgcn_readfirstlane(tid >> 6), lane = tid & 63, r32 = lane & 31, hi = lane >> 5;
    const int sr = tid >> 4, sc = (tid & 15) * 8, kws = KSWZ(sr, sc * 2); char* K_lds = lds + 2 * SHM_V;
    const int kb0 = swa_jlo(cur.P0) * KVBLK;
    for (int d0 = 0; d0 < 8; ++d0) S.qr[d0] = load8(cur.Q + (size_t)(cur.P0 + wid * QBLK + r32) * D + d0 * 16 + hi * 8);
    SLOAD_H(cur.K, cur.V, kb0); VMW(); SWRITE_HK(0);
    __syncthreads();
}
__device__ __forceinline__ void swa_block(const BlockRef& cur, const BlockRef& nxt, char* lds, Seam& S, u16* OM, float* LSE, int first_group) {
    int tid = threadIdx.x; asm volatile("" : "+v"(tid));
    const int wid = __builtin_amdgcn_readfirstlane(tid >> 6), lane = tid & 63, r32 = lane & 31, hi = lane >> 5;
    const int j_lo = swa_jlo(cur.P0);
    int j_hi = (cur.P0 + QB - 1) / KVBLK + 1; if (j_hi > cur.skv / KVBLK) j_hi = cur.skv / KVBLK;
    const int NT = j_hi - j_lo;
    const int kbn = swa_jlo(nxt.P0) * KVBLK;
    const int qlo = cur.P0 + wid * QBLK, qm = qlo + r32 - 4 * hi;
    char* V_lds = lds; char* K_lds = lds + 2 * SHM_V;
    float* ws = (float*)(lds + 2 * SHM_V + 2 * SHM_K) + wid * 64; float* li_l = ws, * al_l = ws + 32;
    float m_reg = -1e30f, l_reg = 0; f32x16 o[4] = {};
    const int sr = tid >> 4, sc = (tid & 15) * 8, vst0 = v_st(sr, sc), vst1 = v_st(32 + sr, sc), kws = KSWZ(sr, sc * 2);
    const int vb0 = (int)(uintptr_t)V_lds + v_rd_base(lane);
    const u16* Kh = cur.K; const u16* Vh = cur.V;
#define RESC(a) do { if (__any((a) < 1.f)) { if (hi == 0) al_l[r32] = (a); asm volatile("s_waitcnt lgkmcnt(0)" ::: "memory");              \
                     for (int d_ = 0; d_ < 4; ++d_) for (int r = 0; r < 16; ++r) o[d_][r] *= al_l[crow(r, hi)]; } } while (0)
#define KBASE(t) ((j_lo + (t)) * KVBLK)
#define ACT(t) (KBASE(t) <= qlo + QBLK - 1 && KBASE(t) + KVBLK - 1 >= qlo - W + 1)
#define MASKT(P0_, P1_, t) do { const int kb_ = KBASE(t); if (ACT(t) && (kb_ + KVBLK - 1 > qlo || kb_ <= qlo + QBLK - 1 - W)) mask_tile(P0_, P1_, qm - kb_, (unsigned)W); } while (0)
    constexpr int NQL = 8;
#define SEAM_K0() do { VMWN(NQL); SWRITE_HK(0); SBAR(); } while (0)
    f32x16 pA0, pA1, pB0, pB1; float mnA, mnB, alA, alB; bf16x8 pa0, pa1, pa2, pa3;
    SWRITE_HV(0); SBAR();
    if (NT > 1) { SLOAD_H(Kh, Vh, KBASE(1)); }
    SBAR(); qkt<0>(pA0, pA1, K_lds, r32, hi, S.qr, ACT(0));
    MASKT(pA0, pA1, 0); partialSM(pA0, pA1, m_reg, mnA, alA);
    if (NT > 1) { VMW(); SWRITE_H(1); }
    __syncthreads();
#define HALF_STEP(PX0, PX1, mnX, alX, PY0, PY1, alY, t, KB, VB, SB) do {                                                      \
        SBAR(); qkt<KB>(PX0, PX1, K_lds, r32, hi, S.qr, ACT(t));                                             \
        finishSM(PY0, PY1, alY, l_reg, pa0, pa1, pa2, pa3); SBAR();                                                           \
        if ((t) + 1 < NT) { SLOAD_H(Kh, Vh, KBASE((t) + 1)); SBAR(); }                                               \
        pv_tile<VB>(o, vb0, pa0, pa1, pa2, pa3, ACT((t) - 1)); MASKT(PX0, PX1, (t)); partialSM(PX0, PX1, m_reg, mnX, alX);                                        \
        __syncthreads();                                                                                                      \
        if ((t) + 1 < NT) { VMW(); SWRITE_H(SB); }                                                                          \
        RESC(alX); __syncthreads(); } while (0)
    for (int t = 1; t + 1 < NT; t += 2) {
        HALF_STEP(pB0, pB1, mnB, alB, pA0, pA1, alA, t, 1, 0, 0);
        HALF_STEP(pA0, pA1, mnA, alA, pB0, pB1, alB, t + 1, 0, 1, 1);
    }
    const bool even = (NT & 1) == 0;
    if (even) { SBAR(); qkt<1>(pB0, pB1, K_lds, r32, hi, S.qr, ACT(NT - 1)); SBAR(); }
    SLOAD_H(nxt.K, nxt.V, kbn); SBAR();
#pragma unroll
    for (int d0 = 0; d0 < 8; ++d0) S.qr[d0] = load8(nxt.Q + (size_t)(nxt.P0 + wid * QBLK + r32) * D + d0 * 16 + hi * 8);
    SBAR();
    finishSM(pA0, pA1, alA, l_reg, pa0, pa1, pa2, pa3); SBAR();
    pv_tile<0>(o, vb0, pa0, pa1, pa2, pa3, ACT(even ? NT - 2 : NT - 1));
    if (even) { MASKT(pB0, pB1, NT - 1); partialSM(pB0, pB1, m_reg, mnB, alB); __syncthreads(); RESC(alB);
        finishSM(pB0, pB1, alB, l_reg, pa0, pa1, pa2, pa3); SBAR(); pv_tile<1>(o, vb0, pa0, pa1, pa2, pa3, ACT(NT - 1)); }
    SBAR(); SEAM_K0();
    if (hi == 0) { const size_t li = (size_t)(cur.trow0 + cur.tstep * (wid * QBLK + r32)) * 8 + cur.h; const float lse_n = m_reg * SCALE + __logf(l_reg);
        if (first_group) { li_l[r32] = 1.0f / l_reg; al_l[r32] = 0.f; LSE[li] = lse_n; }
        else { const float lo = LSE[li], mx = fmaxf(lo, lse_n), eo = __expf(lo - mx), en = __expf(lse_n - mx), inv = 1.0f / (eo + en);
               li_l[r32] = en * inv / l_reg; al_l[r32] = eo * inv; LSE[li] = mx + __logf(eo + en); } }
    asm volatile("s_waitcnt lgkmcnt(0)" ::: "memory");
    {
        u16* Ow = OM + (size_t)(cur.trow0 + cur.tstep * (wid * QBLK)) * 1024 + cur.h * D;
        const size_t rstep = (size_t)cur.tstep * 1024;
#pragma unroll
        for (int r = 0; r < 16; ++r) { const int orow = crow(r, hi); const float wn = li_l[orow], wo = al_l[orow];
            unsigned* rowp = (unsigned*)(Ow + (size_t)orow * rstep + r32);
#pragma unroll
            for (int d0 = 0; d0 < 4; ++d0) { float v = o[d0][r] * wn; float vn = __shfl_xor(v, 1);
                if ((r32 & 1) == 0) { unsigned* p = rowp + d0 * 16;
                    if (!first_group) { const unsigned ov = *p; v += wo * hlo(ov); vn += wo * hhi(ov); }
                    *p = cvtpk(v, vn); } } }
    }
    __syncthreads();
#undef RESC
#undef KBASE
#undef ACT
#undef MASKT
#undef SEAM_K0
#undef HALF_STEP
}
#undef ROW
#undef VMW
#undef VMWN
#undef SLOAD_H
#undef SWRITE_HK
#undef SWRITE_HV
#undef SWRITE_H
#undef KSWZ
#undef SBAR
#undef SWA_MFMA
__device__ __forceinline__ BlockRef swa_ref(int item, int ldil, const u16* Q, const u16* K, const u16* V) {
    const int L = 8192 >> ldil, nqb = L / QB, qb = item % nqb, seq = item / nqb;
    const int r = seq & ((1 << ldil) - 1), bh = seq >> ldil, b = bh >> 3, h = bh & 7;
    BlockRef x; const size_t base = (size_t)seq * L * D;
    x.Q = Q + base; x.K = K + base; x.V = V + base; x.P0 = qb * QB; x.skv = L; x.trow0 = b * 8192 + r + ((qb * QB) << ldil); x.tstep = 1 << ldil; x.h = h;
    return x;
}
__device__ __forceinline__ void attn_phase(char* lds, int vcu, int G, int ldil, const u16* Q, const u16* K, const u16* V, u16* OM, float* LSE, int first_group) {
    const int total = 512;
    int it = 2 * vcu; if (it >= total) return;
    const int per = 2;
    BlockRef cur = swa_ref(it, ldil, Q, K, V);
    Seam S;
    swa_prime(cur, lds, S);
    for (int k = 0; k < per; ++k) {
        const bool last = (k == per - 1);
        const BlockRef nxt = last ? cur : swa_ref(it + k + 1, ldil, Q, K, V);
        swa_block(cur, nxt, lds, S, OM, LSE, first_group);
        cur = nxt;
    }
}

constexpr int R_K = 0, R_V = 3 * SHM_K, R_WS = 3 * SHM_K + 3 * SHM_V, R_OST = R_WS + NW * 64 * 4, RING_LDS = R_OST + NW * 2560;
__device__ __forceinline__ void glds16(const void* gsrc, unsigned lds_dst) { unsigned keep;
    asm volatile("s_mov_b32 %0, m0\n\ts_mov_b32 m0, %2\n\ts_nop 0\n\tglobal_load_lds_dwordx4 %1, off\n\ts_mov_b32 m0, %0" : "=&s"(keep) : "v"(gsrc), "s"(lds_dst) : "memory"); }
#define SWA_MFMA2(a, b, c) __builtin_amdgcn_mfma_f32_32x32x16_f16(__builtin_bit_cast(f16x8, a), __builtin_bit_cast(f16x8, b), c, 0, 0, 0)
#define SBAR2() __builtin_amdgcn_sched_barrier(0)
#define KSWZ2(row, colB) ((row) * 256 + ((colB) ^ (((row) & 7) << 4)))
__device__ __forceinline__ void qkt_r(f32x16& p0, f32x16& p1, const char* Kslot, int r32, int hi, const bf16x8* qr) {
    p0 = f32x16{}; p1 = f32x16{};
    const char* kb[4];
#pragma unroll
    for (int dd = 0; dd < 4; ++dd) kb[dd] = Kslot + KSWZ2(r32, (dd * 16 + hi * 8) * 2);
#pragma unroll
    for (int d0 = 0; d0 < 8; ++d0) { const char* a = kb[d0 & 3] + (d0 >> 2) * 128;
        bf16x8 b0 = *reinterpret_cast<const bf16x8*>(a);
        bf16x8 b1 = *reinterpret_cast<const bf16x8*>(a + 32 * 256);
        p0 = SWA_MFMA2(b0, qr[d0], p0);
        p1 = SWA_MFMA2(b1, qr[d0], p1); }
}
__device__ __forceinline__ void pv_r(f32x16* o, int vb, bf16x8 pa0, bf16x8 pa1, bf16x8 pa2, bf16x8 pa3) {
#define TRRD(dst, off) asm volatile("ds_read_b64_tr_b16 %0, %1 offset:%2" : "=&v"(dst) : "v"(vb), "i"(off) : "memory")
#define PV_D0(d0) do { s16x4 l0, l1, l2, l3, h0, h1, h2, h3; constexpr int b_ = v_rd_off(d0, 0, 0); \
        TRRD(l0, b_); TRRD(h0, b_ + 2048); TRRD(l1, b_ + 4096); TRRD(h1, b_ + 6144); TRRD(l2, b_ + 8192); TRRD(h2, b_ + 10240); TRRD(l3, b_ + 12288); TRRD(h3, b_ + 14336); \
        asm volatile("s_waitcnt lgkmcnt(0)" ::: "memory"); SBAR2();   \
        o[d0] = SWA_MFMA2(pa0, ((bf16x8){l0[0], l0[1], l0[2], l0[3], h0[0], h0[1], h0[2], h0[3]}), o[d0]);   \
        o[d0] = SWA_MFMA2(pa1, ((bf16x8){l1[0], l1[1], l1[2], l1[3], h1[0], h1[1], h1[2], h1[3]}), o[d0]);   \
        o[d0] = SWA_MFMA2(pa2, ((bf16x8){l2[0], l2[1], l2[2], l2[3], h2[0], h2[1], h2[2], h2[3]}), o[d0]);   \
        o[d0] = SWA_MFMA2(pa3, ((bf16x8){l3[0], l3[1], l3[2], l3[3], h3[0], h3[1], h3[2], h3[3]}), o[d0]); } while (0)
    PV_D0(0); PV_D0(1); PV_D0(2); PV_D0(3);
#undef PV_D0
#undef TRRD
}
struct DmaLane { unsigned koff[2], voff[2]; };
__device__ __forceinline__ DmaLane dma_lane(int wid, int lane) { DmaLane d;
#pragma unroll
    for (int i = 0; i < 2; ++i) { const int p = 2 * wid + i;
        { const int row = 4 * p + (lane >> 4), cp = lane & 15, c = cp ^ (row & 7); d.koff[i] = (unsigned)(row * 256 + c * 16); }
        { const int st = 2 * p + (lane >> 5), kk = 8 * (st >> 2) + ((lane & 31) >> 2), k = (kk & ~0xC) | ((kk & 4) << 1) | ((kk & 8) >> 1), c = 32 * (st & 3) + 8 * (lane & 3); d.voff[i] = (unsigned)(k * 256 + c * 2); } }
    return d; }
__device__ __forceinline__ void dma_tile(const DmaLane& dl, const u16* K, const u16* V, int kbase, unsigned lds0, int slot, int wid) {
    const char* kp = (const char*)K + (size_t)kbase * 256; const char* vp = (const char*)V + (size_t)kbase * 256;
    const unsigned kd = (unsigned)__builtin_amdgcn_readfirstlane(lds0 + R_K + slot * SHM_K + wid * 2048), vd = (unsigned)__builtin_amdgcn_readfirstlane(lds0 + R_V + slot * SHM_V + wid * 2048);
    glds16(kp + dl.koff[0], kd); glds16(kp + dl.koff[1], kd + 1024); glds16(vp + dl.voff[0], vd); glds16(vp + dl.voff[1], vd + 1024);
}
__device__ __forceinline__ void swa_block_dma(const BlockRef& cur, const BlockRef* nxt, char* lds, bf16x8 (&qr)[8], const DmaLane& dl, u16* OM, float* LSE, int first_group) {
    int tid = threadIdx.x; asm volatile("" : "+v"(tid));
    const int wid = __builtin_amdgcn_readfirstlane(tid >> 6), lane = tid & 63, r32 = lane & 31, hi = lane >> 5;
    const int j_lo = swa_jlo(cur.P0);
    int j_hi = (cur.P0 + QB - 1) / KVBLK + 1; if (j_hi > cur.skv / KVBLK) j_hi = cur.skv / KVBLK;
    const int NT = j_hi - j_lo;
    const int qlo = cur.P0 + wid * QBLK, qm = qlo + r32 - 4 * hi;
    const unsigned lds0 = (unsigned)(uintptr_t)lds;
    float* ws = (float*)(lds + R_WS) + wid * 64; float* li_l = ws, * al_l = ws + 32;
    float m_reg = -1e30f, l_reg = 0; f32x16 o[4] = {};
    const int vbl = (int)lds0 + R_V + v_rd_base(lane);
    int slot = 0;
    for (int t = 0; t < NT; ++t) {
        const int kb_ = (j_lo + t) * KVBLK;
        if (t == 0 || t + 1 >= NT) asm volatile("s_waitcnt vmcnt(0)" ::: "memory"); else asm volatile("s_waitcnt vmcnt(4)" ::: "memory");
        __builtin_amdgcn_s_barrier(); asm volatile("" ::: "memory");
        if (t + 2 < NT) { int s2 = slot + 2; if (s2 >= 3) s2 -= 3; dma_tile(dl, cur.K, cur.V, kb_ + 2 * KVBLK, lds0, s2, wid); }
        const bool act = kb_ <= qlo + QBLK - 1 && kb_ + KVBLK - 1 >= qlo - W + 1;
        if (act) {
            f32x16 p0, p1; float mn, al; bf16x8 pa0, pa1, pa2, pa3;
            SBAR2(); qkt_r(p0, p1, lds + R_K + slot * SHM_K, r32, hi, qr);
            if (kb_ + KVBLK - 1 > qlo || kb_ <= qlo + QBLK - 1 - W) mask_tile(p0, p1, qm - kb_, (unsigned)W);
            partialSM(p0, p1, m_reg, mn, al);
            if (__any(al < 1.f)) { if (hi == 0) al_l[r32] = al; asm volatile("s_waitcnt lgkmcnt(0)" ::: "memory");
                for (int d_ = 0; d_ < 4; ++d_) for (int r = 0; r < 16; ++r) o[d_][r] *= al_l[crow(r, hi)]; }
            finishSM(p0, p1, al, l_reg, pa0, pa1, pa2, pa3); SBAR2();
            pv_r(o, vbl + slot * SHM_V, pa0, pa1, pa2, pa3);
        }
        if (++slot == 3) slot = 0;
    }
    asm volatile("s_waitcnt lgkmcnt(0)" ::: "memory"); __builtin_amdgcn_s_barrier(); asm volatile("" ::: "memory");
    if (nxt) { const int kb0 = swa_jlo(nxt->P0) * KVBLK; dma_tile(dl, nxt->K, nxt->V, kb0, lds0, 0, wid); dma_tile(dl, nxt->K, nxt->V, kb0 + KVBLK, lds0, 1, wid);
#pragma unroll
        for (int d0 = 0; d0 < 8; ++d0) qr[d0] = load8(nxt->Q + (size_t)(nxt->P0 + wid * QBLK + r32) * D + d0 * 16 + hi * 8); }
    if (hi == 0) { const size_t li = (size_t)(cur.trow0 + cur.tstep * (wid * QBLK + r32)) * 8 + cur.h; const float lse_n = m_reg * SCALE + __logf(l_reg);
        if (first_group) { li_l[r32] = 1.0f / l_reg; al_l[r32] = 0.f; LSE[li] = lse_n; }
        else { const float lo = LSE[li], mx = fmaxf(lo, lse_n), eo = __expf(lo - mx), en = __expf(lse_n - mx), inv = 1.0f / (eo + en);
               li_l[r32] = en * inv / l_reg; al_l[r32] = eo * inv; LSE[li] = mx + __logf(eo + en); } }
    asm volatile("s_waitcnt lgkmcnt(0)" ::: "memory");
    {
        char* st = lds + R_OST + wid * 2560;
        const int erow = lane >> 1, eh = lane & 1;
        u16* gp = OM + (size_t)(cur.trow0 + cur.tstep * (wid * QBLK + erow)) * 1024 + cur.h * D + eh * 16;
        const float wo = al_l[erow];
        float wn[16];
#pragma unroll
        for (int r = 0; r < 16; ++r) wn[r] = li_l[crow(r, hi)];
#pragma unroll
        for (int d0 = 0; d0 < 4; ++d0) {
#pragma unroll
            for (int r = 0; r < 16; ++r) *(_Float16*)(st + crow(r, hi) * 80 + r32 * 2) = (_Float16)(o[d0][r] * wn[r]);
            asm volatile("s_waitcnt lgkmcnt(0)" ::: "memory");
            const u32x4 n0 = *(const u32x4*)(st + erow * 80 + eh * 32), n1 = *(const u32x4*)(st + erow * 80 + eh * 32 + 16);
            u32x4 r0 = n0, r1 = n1;
            if (!first_group) { const u32x4 o0 = *(const u32x4*)(gp + d0 * 32), o1 = *(const u32x4*)(gp + d0 * 32 + 8);
#pragma unroll
                for (int e = 0; e < 4; ++e) { r0[e] = cvtpk(hlo(n0[e]) + wo * hlo(o0[e]), hhi(n0[e]) + wo * hhi(o0[e])); r1[e] = cvtpk(hlo(n1[e]) + wo * hlo(o1[e]), hhi(n1[e]) + wo * hhi(o1[e])); } }
            *(u32x4*)(gp + d0 * 32) = r0; *(u32x4*)(gp + d0 * 32 + 8) = r1;
            asm volatile("s_waitcnt lgkmcnt(0)" ::: "memory");
        }
    }
}
__device__ __forceinline__ void attn_phase_dma(char* lds, int vcu, int ldil, const u16* Q, const u16* K, const u16* V, u16* OM, float* LSE, int first_group) {
    int tid = threadIdx.x; asm volatile("" : "+v"(tid));
    const int wid = __builtin_amdgcn_readfirstlane(tid >> 6), lane = tid & 63, r32 = lane & 31, hi = lane >> 5;
    const DmaLane dl = dma_lane(wid, lane);
    const unsigned lds0 = (unsigned)(uintptr_t)lds;
    const BlockRef b0 = swa_ref(2 * vcu, ldil, Q, K, V), b1 = swa_ref(2 * vcu + 1, ldil, Q, K, V);
    { const int kb0 = swa_jlo(b0.P0) * KVBLK; dma_tile(dl, b0.K, b0.V, kb0, lds0, 0, wid); dma_tile(dl, b0.K, b0.V, kb0 + KVBLK, lds0, 1, wid); }
    bf16x8 qr[8];
#pragma unroll
    for (int d0 = 0; d0 < 8; ++d0) qr[d0] = load8(b0.Q + (size_t)(b0.P0 + wid * QBLK + r32) * D + d0 * 16 + hi * 8);
    swa_block_dma(b0, &b1, lds, qr, dl, OM, LSE, first_group);
    swa_block_dma(b1, nullptr, lds, qr, dl, OM, LSE, first_group);
    asm volatile("s_waitcnt vmcnt(0) lgkmcnt(0)" ::: "memory"); __builtin_amdgcn_s_barrier(); asm volatile("" ::: "memory");
}
#undef SWA_MFMA2
#undef SBAR2
#undef KSWZ2
}

namespace gla {
typedef unsigned short u16;
typedef short bf16x8 __attribute__((ext_vector_type(8)));
typedef short s16x4 __attribute__((ext_vector_type(4)));
typedef float f32x16 __attribute__((ext_vector_type(16)));
typedef float f32x4 __attribute__((ext_vector_type(4)));
typedef unsigned u32x4 __attribute__((ext_vector_type(4)));
typedef unsigned u32x2 __attribute__((ext_vector_type(2)));
#define GLAS __attribute__((address_space(3)))
constexpr int RQ = 320, RV = 576;
constexpr int O_QT = 0, O_KT = 64 * RQ, O_KD = 2 * 64 * RQ, O_V = 3 * 64 * RQ, O_DEC = O_V + 64 * RV, O_BL = O_DEC + 512, O_END = O_BL + 512;
constexpr int O_OS = 0;
constexpr int NSEG = 32, SEGC = 4;
typedef float f32x2_t __attribute__((ext_vector_type(2))); typedef __bf16 bf16x2_t __attribute__((ext_vector_type(2)));
__device__ __forceinline__ unsigned cvtpk_bf(float lo, float hi) { const f32x2_t v = {lo, hi}; return __builtin_bit_cast(unsigned, __builtin_convertvector(v, bf16x2_t)); }
__device__ __forceinline__ int crow(int r, int hi) { return (r & 3) + 8 * (r >> 2) + 4 * hi; }
__device__ __forceinline__ float bf_lo(unsigned w) { return __builtin_bit_cast(float, w << 16); }
__device__ __forceinline__ float bf_hi(unsigned w) { return __builtin_bit_cast(float, w & 0xffff0000u); }
__device__ __forceinline__ s16x4 trrd(GLAS const unsigned char* p) { typedef short v4i16_t __attribute__((ext_vector_type(4))); return __builtin_bit_cast(s16x4, __builtin_amdgcn_ds_read_tr16_b64_v4i16((GLAS v4i16_t*)p)); }
template <int PITCH> __device__ __forceinline__ int tr_lane_off(int lane) { const int g = lane >> 4, q = (lane >> 2) & 3, p = lane & 3; return (8 * (g >> 1) + q) * PITCH + (16 * (g & 1) + 4 * p) * 2; }
template <int PITCH> __device__ __forceinline__ bf16x8 tr_frag(GLAS const unsigned char* base, int off) {
    const s16x4 lo = trrd(base + off), hi = trrd(base + off + 4 * PITCH);
    return (bf16x8){lo[0], lo[1], lo[2], lo[3], hi[0], hi[1], hi[2], hi[3]};
}
#define GLA_MFMA(a, b, c) __builtin_amdgcn_mfma_f32_32x32x16_bf16(a, b, c, 0, 0, 0)

struct Tensors { const u16* q; const u16* k; const u16* v; const u16* g; const float* Bc; const float* normw; float* GS; float* GD; u16* GO; };

struct ChunkRegs { u32x4 k0, k1, q0, q1, v0, v1, v2, v3; f32x4 bv[4]; float blt; };
template <bool FULL>
__device__ __forceinline__ void load_chunk_a(ChunkRegs& R, const Tensors& T, int b, int h, int tok0, int tid) {
    const int s = tid >> 3, d0 = (tid & 7) * 16; const size_t row = (size_t)b * 8192 + tok0 + s, rowl = (size_t)b * 8192 + tok0 + 63;
    const float* bp = T.Bc + row * 512 + h * 128 + d0;
    const u32x4* kp = (const u32x4*)(T.k + row * 512 + h * 128 + d0);
    R.k0 = kp[0]; R.k1 = kp[1];
    if (FULL) { const u32x4* qp = (const u32x4*)(T.q + row * 512 + h * 128 + d0); R.q0 = qp[0]; R.q1 = qp[1]; }
#pragma unroll
    for (int i = 0; i < 4; ++i) R.bv[i] = *(const f32x4*)(bp + 4 * i);
    R.blt = T.Bc[rowl * 512 + h * 128 + (tid & 127)];
}
__device__ __forceinline__ void load_chunk_v(ChunkRegs& R, const Tensors& T, int b, int h, int tok0, int tid) {
    const int s = tid >> 3; const size_t row = (size_t)b * 8192 + tok0 + s;
    const u32x4* vp = (const u32x4*)(T.v + row * 1024 + h * 256 + (tid & 7) * 32);
    R.v0 = vp[0]; R.v1 = vp[1]; R.v2 = vp[2]; R.v3 = vp[3];
}
__device__ __forceinline__ void write_chunk_1(GLAS unsigned char* L, const ChunkRegs& R, int tid) {
    const int s = tid >> 3;
    GLAS unsigned char* rv = L + O_V + s * RV + (tid & 7) * 64;
    *(GLAS u32x4*)(rv) = R.v0; *(GLAS u32x4*)(rv + 16) = R.v1; *(GLAS u32x4*)(rv + 32) = R.v2; *(GLAS u32x4*)(rv + 48) = R.v3;
    if (tid < 128) { ((GLAS float*)(L + O_BL))[tid] = R.blt; ((GLAS float*)(L + O_DEC))[tid] = __expf(R.blt); }
}
template <bool FULL>
__device__ __forceinline__ void write_chunk_2(GLAS unsigned char* L, const ChunkRegs& R, int tid) {
    const int s = tid >> 3, d0 = (tid & 7) * 16;
    f32x4 bl[4];
#pragma unroll
    for (int i = 0; i < 4; ++i) bl[i] = *(GLAS const f32x4*)(L + O_BL + (d0 + 4 * i) * 4);
    unsigned qt[8], kt[8], kd[8];
#pragma unroll
    for (int i = 0; i < 8; ++i) { const unsigned kw = i < 4 ? R.k0[i] : R.k1[i - 4], qw = i < 4 ? R.q0[i] : R.q1[i - 4];
        const float b0 = R.bv[i >> 1][(2 * i) & 3], b1 = R.bv[i >> 1][(2 * i + 1) & 3], l0 = bl[i >> 1][(2 * i) & 3], l1 = bl[i >> 1][(2 * i + 1) & 3];
        const float kf0 = bf_lo(kw), kf1 = bf_hi(kw);
        kd[i] = cvtpk_bf(kf0 * __expf(l0 - b0), kf1 * __expf(l1 - b1));
        if (FULL) { const float e0 = __expf(b0), e1 = __expf(b1);
            qt[i] = cvtpk_bf(bf_lo(qw) * (0.08838834764831845f * e0), bf_hi(qw) * (0.08838834764831845f * e1));
            kt[i] = cvtpk_bf(kf0 * __builtin_amdgcn_rcpf(e0), kf1 * __builtin_amdgcn_rcpf(e1)); } }
    GLAS unsigned char* r = L + s * RQ + d0 * 2;
    *(GLAS u32x4*)(r + O_KD) = (u32x4){kd[0], kd[1], kd[2], kd[3]}; *(GLAS u32x4*)(r + O_KD + 16) = (u32x4){kd[4], kd[5], kd[6], kd[7]};
    if (FULL) { *(GLAS u32x4*)(r + O_QT) = (u32x4){qt[0], qt[1], qt[2], qt[3]}; *(GLAS u32x4*)(r + O_QT + 16) = (u32x4){qt[4], qt[5], qt[6], qt[7]};
                *(GLAS u32x4*)(r + O_KT) = (u32x4){kt[0], kt[1], kt[2], kt[3]}; *(GLAS u32x4*)(r + O_KT + 16) = (u32x4){kt[4], kt[5], kt[6], kt[7]}; }
}
__device__ __forceinline__ void state_update(GLAS const unsigned char* Ltq, GLAS const unsigned char* Ld, f32x16 (&S)[4], const bf16x8 (&vf)[4]) {
#pragma unroll
    for (int T = 0; T < 4; ++T) {
#pragma unroll
        for (int i = 0; i < 4; ++i) { const f32x4 dc = *(GLAS const f32x4*)(Ld + O_DEC + 128 * T + 32 * i);
#pragma unroll
            for (int e = 0; e < 4; ++e) S[T][4 * i + e] *= dc[e]; }
#pragma unroll
        for (int kk = 0; kk < 4; ++kk) { const bf16x8 a = tr_frag<RQ>(Ltq, O_KD + 16 * kk * RQ + 64 * T); S[T] = GLA_MFMA(a, vf[kk], S[T]); }
    }
}
__device__ __forceinline__ void load_vfrags(GLAS const unsigned char* Ltv, bf16x8 (&vf)[4]) {
#pragma unroll
    for (int kk = 0; kk < 4; ++kk) vf[kk] = tr_frag<RV>(Ltv, 16 * kk * RV);
}
#define GLA_OPAQUE(p) asm volatile("" : "+v"(p))
__device__ __forceinline__ void gla1_phase(GLAS unsigned char* L, int unit, const Tensors& T) {
    int tid = threadIdx.x; asm volatile("" : "+v"(tid));
    const int wid = __builtin_amdgcn_readfirstlane(tid >> 6), lane = tid & 63, hi = lane >> 5, n = lane & 31;
    const int bh = unit / NSEG, seg = unit % NSEG, b = bh >> 2, h = bh & 3;
    f32x16 S[4] = {};
    float dsum = 0.f;
    ChunkRegs R; load_chunk_a<false>(R, T, b, h, seg * 256, tid); load_chunk_v(R, T, b, h, seg * 256, tid);
    for (int c = 0; c < SEGC; ++c) {
        write_chunk_1(L, R, tid);
        asm volatile("s_waitcnt lgkmcnt(0)" ::: "memory"); __syncthreads();
        write_chunk_2<false>(L, R, tid);
        asm volatile("s_waitcnt lgkmcnt(0)" ::: "memory"); __syncthreads();
        if (c + 1 < SEGC) { load_chunk_a<false>(R, T, b, h, seg * 256 + (c + 1) * 64, tid); load_chunk_v(R, T, b, h, seg * 256 + (c + 1) * 64, tid); }
        if (tid < 128) dsum += ((GLAS const float*)(L + O_BL))[tid];
        GLAS const unsigned char* Ltq = L + tr_lane_off<RQ>(lane); GLAS const unsigned char* Ltv = L + O_V + tr_lane_off<RV>(lane) + 64 * wid; GLAS const unsigned char* Ld = L + 16 * hi;
        GLA_OPAQUE(Ltq); GLA_OPAQUE(Ltv); GLA_OPAQUE(Ld);
        bf16x8 vf[4]; load_vfrags(Ltv, vf);
        state_update(Ltq, Ld, S, vf);
        __syncthreads();
    }
    float* gs = T.GS + (size_t)unit * (128 * 256) + (size_t)wid * 4096 + lane;
#pragma unroll
    for (int Tt = 0; Tt < 4; ++Tt)
#pragma unroll
        for (int r = 0; r < 16; ++r) gs[(Tt * 16 + r) * 64] = S[Tt][r];
    if (tid < 128) T.GD[(size_t)unit * 128 + tid] = __expf(dsum);
}
__device__ __forceinline__ void gla2_phase(int vcu, int G, const Tensors& T) {
    int tid = threadIdx.x; asm volatile("" : "+v"(tid));
    for (int e = vcu * 512 + tid; e < 8 * 128 * 256; e += G * 512) { const int bh = e >> 15, dv = e & 32767, r_ = (dv >> 6) & 15, d = 32 * ((dv >> 10) & 3) + (r_ & 3) + 8 * (r_ >> 2) + 4 * ((dv >> 5) & 1);
        float* p0 = T.GS + ((size_t)(bh * NSEG) << 15) + dv; const float* d0 = T.GD + (size_t)(bh * NSEG) * 128 + d;
        float loc[NSEG], dec[NSEG];
#pragma unroll
        for (int seg = 0; seg < NSEG; ++seg) { loc[seg] = p0[(size_t)seg << 15]; dec[seg] = d0[seg * 128]; }
        float run = 0.f;
#pragma unroll
        for (int seg = 0; seg < NSEG; ++seg) { p0[(size_t)seg << 15] = run; run = dec[seg] * run + loc[seg]; } }
}
__device__ __forceinline__ void gla3_phase(GLAS unsigned char* L, int unit, const Tensors& T) {
    int tid = threadIdx.x; asm volatile("" : "+v"(tid));
    const int wid = __builtin_amdgcn_readfirstlane(tid >> 6), lane = tid & 63, hi = lane >> 5, n = lane & 31;
    const int bh = unit / NSEG, seg = unit % NSEG, b = bh >> 2, h = bh & 3;
    f32x16 S[4];
    { const float* gs = T.GS + (size_t)unit * (128 * 256) + (size_t)wid * 4096 + lane;
#pragma unroll
      for (int Tt = 0; Tt < 4; ++Tt)
#pragma unroll
          for (int r = 0; r < 16; ++r) S[Tt][r] = gs[(Tt * 16 + r) * 64]; }
    const f32x4 nw4 = *(const f32x4*)(T.normw + 4 * lane);
    ChunkRegs R; load_chunk_a<true>(R, T, b, h, seg * 256, tid); load_chunk_v(R, T, b, h, seg * 256, tid);
    for (int c = 0; c < SEGC; ++c) { const int tok0 = seg * 256 + c * 64;
        write_chunk_1(L, R, tid);
        asm volatile("s_waitcnt lgkmcnt(0)" ::: "memory"); __syncthreads();
        write_chunk_2<true>(L, R, tid);
        asm volatile("s_waitcnt lgkmcnt(0)" ::: "memory"); __syncthreads();
        if (c + 1 < SEGC) load_chunk_a<true>(R, T, b, h, tok0 + 64, tid);
        GLAS const unsigned char* Ltq = L + tr_lane_off<RQ>(lane); GLAS const unsigned char* Ltv = L + O_V + tr_lane_off<RV>(lane) + 64 * wid; GLAS const unsigned char* Ld = L + 16 * hi;
        GLAS const unsigned char* Lq = L + n * RQ + 16 * hi; GLAS const unsigned char* Lp = L + n * RQ + 8 * hi;
        GLAS unsigned char* Lo = L + O_OS + 4096 * hi + (32 * wid + n) * 4; GLAS const unsigned char* Lr = L + O_OS + 8192 * wid + 16 * lane;
        GLA_OPAQUE(Ltq); GLA_OPAQUE(Ltv); GLA_OPAQUE(Ld); GLA_OPAQUE(Lq); GLA_OPAQUE(Lp); GLA_OPAQUE(Lo); GLA_OPAQUE(Lr);
        bf16x8 vf[4]; load_vfrags(Ltv, vf);
        f32x16 o[2] = {};
#pragma unroll
        for (int bq = 0; bq < 2; ++bq)
#pragma unroll
            for (int a = 0; a <= bq; ++a) {
                f32x16 x = {};
#pragma unroll
                for (int kk = 0; kk < 8; ++kk) { const bf16x8 ka = *(GLAS const bf16x8*)(Lq + O_KT + 32 * a * RQ + 32 * kk);
                                                 const bf16x8 qb = *(GLAS const bf16x8*)(Lq + O_QT + 32 * bq * RQ + 32 * kk);
                                                 x = GLA_MFMA(ka, qb, x); }
                if (a == bq) {
#pragma unroll
                    for (int r = 0; r < 16; ++r) if (crow(r, hi) > n) x[r] = 0.f; }
                bf16x8 pa0, pa1;
#define PK4(P, B_, OUT) do { unsigned a0 = cvtpk_bf(P[B_+0], P[B_+1]), a1 = cvtpk_bf(P[B_+2], P[B_+3]), b0 = cvtpk_bf(P[B_+4], P[B_+5]), b1 = cvtpk_bf(P[B_+6], P[B_+7]); \
        auto r0 = __builtin_amdgcn_permlane32_swap(a0, b0, false, false); auto r1 = __builtin_amdgcn_permlane32_swap(a1, b1, false, false); \
        u32x4 w = {r0[0], r1[0], r0[1], r1[1]}; OUT = __builtin_bit_cast(bf16x8, w); } while (0)
                PK4(x, 0, pa0); PK4(x, 8, pa1);
#undef PK4
                o[bq] = GLA_MFMA(pa0, vf[2 * a], o[bq]); o[bq] = GLA_MFMA(pa1, vf[2 * a + 1], o[bq]);
            }
#pragma unroll
        for (int Tt = 0; Tt < 4; ++Tt)
#pragma unroll
            for (int s2 = 0; s2 < 2; ++s2) {
                u32x4 sw; sw.x = cvtpk_bf(S[Tt][8 * s2 + 0], S[Tt][8 * s2 + 1]); sw.y = cvtpk_bf(S[Tt][8 * s2 + 2], S[Tt][8 * s2 + 3]); sw.z = cvtpk_bf(S[Tt][8 * s2 + 4], S[Tt][8 * s2 + 5]); sw.w = cvtpk_bf(S[Tt][8 * s2 + 6], S[Tt][8 * s2 + 7]);
                const bf16x8 sb = __builtin_bit_cast(bf16x8, sw);
#pragma unroll
                for (int bq = 0; bq < 2; ++bq) { GLAS const unsigned char* qp = Lp + O_QT + 32 * bq * RQ + 64 * Tt + 32 * s2;
                    const u32x2 lo = *(GLAS const u32x2*)qp, hi2 = *(GLAS const u32x2*)(qp + 16);
                    const bf16x8 qa = __builtin_bit_cast(bf16x8, (u32x4){lo.x, lo.y, hi2.x, hi2.y});
                    o[bq] = GLA_MFMA(qa, sb, o[bq]); }
            }
        state_update(Ltq, Ld, S, vf);
        if (c + 1 < SEGC) load_chunk_v(R, T, b, h, tok0 + 64, tid);
        __syncthreads();
        {
#pragma unroll
          for (int bq = 0; bq < 2; ++bq)
#pragma unroll
              for (int r = 0; r < 16; ++r) *(GLAS float*)(Lo + (32 * bq + (r & 3) + 8 * (r >> 2)) * 1024) = o[bq][r]; }
        asm volatile("s_waitcnt lgkmcnt(0)" ::: "memory"); __syncthreads();
#pragma unroll
        for (int t8 = 0; t8 < 8; ++t8) { const int tk = 8 * wid + t8; const size_t row = (size_t)b * 8192 + tok0 + tk;
            const f32x4 ov = *(GLAS const f32x4*)(Lr + t8 * 1024);
            const u32x2 gw = *(const u32x2*)(T.g + row * 1024 + h * 256 + 4 * lane);
            float sq = (ov[0] * ov[0] + ov[1] * ov[1]) + (ov[2] * ov[2] + ov[3] * ov[3]);
#pragma unroll
            for (int of = 1; of < 64; of <<= 1) sq += __shfl_xor(sq, of);
            const float rstd = 1.0f / sqrtf(sq * (1.0f / 256.0f) + 1e-5f);
            const float g0 = bf_lo(gw.x), g1 = bf_hi(gw.x), g2 = bf_lo(gw.y), g3 = bf_hi(gw.y);
            const float y0 = ov[0] * rstd * nw4[0] * (g0 / (1.0f + __expf(-g0))), y1 = ov[1] * rstd * nw4[1] * (g1 / (1.0f + __expf(-g1)));
            const float y2 = ov[2] * rstd * nw4[2] * (g2 / (1.0f + __expf(-g2))), y3 = ov[3] * rstd * nw4[3] * (g3 / (1.0f + __expf(-g3)));
            u32x2 w; w.x = pg8::cvt_pk_h(y0, y1); w.y = pg8::cvt_pk_h(y2, y3);
            *(u32x2*)(T.GO + row * 1024 + h * 256 + 4 * lane) = w; }
        __syncthreads();
    }
}
#undef GLA_MFMA
#undef GLA_OPAQUE
#undef GLAS
}

constexpr int NWAVES = 8;
constexpr int BATCH = 2, SEQ = 8192, DM = 1024, MTOK = BATCH * SEQ, DFF = 4096;
constexpr int NGRP = 3, AH = 8, HD = 128, AIN = 9216;
constexpr int GH = 4, GDK = 128, GDV = 256, GKD = 512, GVD = 1024, GRANK = 16, GIN = 3088, GCH = 64;
constexpr float EPS = 1e-5f;
__host__ __device__ constexpr int grp_ldil(int g) { return g == 0 ? 0 : (g == 1 ? 2 : 4); }

constexpr size_t MiB = 1u << 20;
constexpr size_t WS_CTL = 0, CTL_ZERO_BYTES = 1 * MiB;
constexpr size_t WS_SSQ = 1 * MiB;
constexpr size_t WS_LSE = 2 * MiB;
constexpr size_t WS_COS = 3 * MiB, WS_SIN = 5 * MiB;
constexpr size_t WS_WG = 7 * MiB;
constexpr size_t WS_WQKV = 8 * MiB, WS_WO0 = 26 * MiB, WS_WUP0 = 28 * MiB, WS_WDN0 = 36 * MiB;
constexpr size_t WS_WGLA = 44 * MiB, WS_WO1 = 50 * MiB, WS_WUP1 = 52 * MiB, WS_WDN1 = 60 * MiB;
constexpr size_t WS_XB = 68 * MiB;
constexpr size_t WS_Q = 100 * MiB, WS_K = 132 * MiB, WS_V = 164 * MiB;
constexpr size_t WS_OM = 196 * MiB;
constexpr size_t WS_H = 100 * MiB;
constexpr size_t WS_GQ = 100 * MiB, WS_GK = 116 * MiB, WS_GV = 132 * MiB, WS_GG = 164 * MiB;
constexpr size_t WS_GB = 196 * MiB;
constexpr size_t WS_GS = 8 * MiB;
constexpr size_t WS_XB1 = 8 * MiB;
constexpr size_t WS_GD = 228 * MiB;
constexpr size_t WS_END = 256 * MiB;
constexpr int CW_TMO = 0, CW_CODE = 1, CW_BAR = 4096;

constexpr int RING_OFF = 0, RING_BYTES = 131072;
constexpr int LDSCTL_OFF = RING_BYTES, MISC_OFF = LDSCTL_OFF + 320;
constexpr int LDS_BYTES = 147456;
constexpr int INPTR_LDS_OFF = 131072 + 512 + 2048 + 512;
constexpr int GLR_LDS_OFF = 131072 + 512 + 2048;
static_assert(MISC_OFF + 128 <= LDS_BYTES, "LDS map");

#ifndef ATTN_DMA
#define ATTN_DMA 1
#endif
#ifndef GLA_SIMPLE
#define GLA_SIMPLE 0
#endif
enum Phase { PH_PRO = 0, PH_QKV0 = 1, PH_ATT0 = 2, PH_QKV1 = 3, PH_ATT1 = 4, PH_QKV2 = 5, PH_ATT2 = 6, PH_WO0 = 7, PH_UP0 = 8, PH_DN0 = 9,
             PH_GLAP = 10, PH_GLA1 = 11, PH_GLA2 = 12, PH_GLA3 = 13, PH_WO1 = 14, PH_UP1 = 15, PH_DN1 = 16, PH_FIN = 17, PH_N = 18 };

struct Frame {
    LAS unsigned char* lds;
    volatile LAS unsigned* MISC;
    gu32* ctl;
    int tid, lane, wave;
    int vcu, G;
};
__device__ __forceinline__ float wave_sum(float v) {
#pragma unroll
    for (int o = 1; o < 64; o <<= 1) v += __shfl_xor(v, o);
    return v;
}
__device__ __forceinline__ float bf2f(unsigned short h) { return __builtin_bit_cast(float, (unsigned)h << 16); }
__device__ __forceinline__ unsigned pkh(float lo, float hi) { return pg8::cvt_pk_h(lo, hi); }
__device__ __forceinline__ float hlo(unsigned w) { return (float)__builtin_bit_cast(pg8::h16x2, w)[0]; }
__device__ __forceinline__ float hhi(unsigned w) { return (float)__builtin_bit_cast(pg8::h16x2, w)[1]; }
__device__ __forceinline__ float h2f(unsigned short h) { return (float)__builtin_bit_cast(_Float16, h); }

__device__ __forceinline__ void xpose_item(const float* W, int ldn, int K, const float* nw, bf16* WT, int dst_row0, int k0, int n0, int nvalid, LAS unsigned char* scr, int lane) {
    const bool cv = lane < nvalid;
    const float* wp = W + (size_t)k0 * ldn + n0 + (cv ? lane : 0);
#pragma unroll
    for (int h = 0; h < 2; ++h) { float w[32];
#pragma unroll
        for (int e = 0; e < 32; ++e) w[e] = wp[(size_t)(32 * h + e) * ldn];
        if (nw) {
#pragma unroll
            for (int e = 0; e < 32; ++e) w[e] *= nw[k0 + 32 * h + e]; }
#pragma unroll
        for (int q = 0; q < 4; ++q) { v4u o; o.x = pkh(w[8 * q], w[8 * q + 1]); o.y = pkh(w[8 * q + 2], w[8 * q + 3]); o.z = pkh(w[8 * q + 4], w[8 * q + 5]); o.w = pkh(w[8 * q + 6], w[8 * q + 7]);
            *(LAS v4u*)(scr + lane * 144 + (4 * h + q) * 16) = o; } }
    LDS_WAIT(); asm volatile("" ::: "memory");
    const int nl = lane >> 3, kc = lane & 7;
#pragma unroll
    for (int j = 0; j < 8; ++j) { const int n = 8 * j + nl; const v4u o = *(const LAS v4u*)(scr + n * 144 + kc * 16);
        if (n < nvalid) *(GAS v4u*)(WT + (size_t)(dst_row0 + n) * K + k0 + 8 * kc) = o; }
    LDS_WAIT(); asm volatile("" ::: "memory");
}
__device__ __forceinline__ void sincos_f(float x, float& s, float& c) {
    const float k = __builtin_rintf(x * 0.636619772f);
    float r = __builtin_fmaf(-k, 1.5703125f, x); r = __builtin_fmaf(-k, 0.0004837512969970703f, r); r = __builtin_fmaf(-k, 7.549533620476723e-08f, r); r = __builtin_fmaf(-k, 2.5632829192545614e-12f, r);
    const float r2 = r * r;
    const float sr = r + r * r2 * (-1.6666654611e-1f + r2 * (8.3321608736e-3f + r2 * -1.9515295891e-4f));
    const float cr = 1.0f - 0.5f * r2 + r2 * r2 * (4.166664568298827e-2f + r2 * (-1.388731625493765e-3f + r2 * 2.443315711809948e-5f));
    const int q = (int)k & 3;
    s = (q == 0) ? sr : (q == 1) ? cr : (q == 2) ? -sr : -cr;
    c = (q == 0) ? cr : (q == 1) ? -sr : (q == 2) ? -cr : sr;
}
__device__ const float ROPE_INVF[64] = {1.000000000e+00f, 8.659643531e-01f, 7.498942614e-01f, 6.493816376e-01f, 5.623413324e-01f, 4.869675338e-01f, 4.216965139e-01f, 3.651741147e-01f, 3.162277639e-01f, 2.738419771e-01f, 2.371373773e-01f, 2.053525001e-01f, 1.778279394e-01f, 1.539926529e-01f, 1.333521307e-01f, 1.154782027e-01f, 1.000000015e-01f, 8.659642935e-02f, 7.498941571e-02f, 6.493816525e-02f, 5.623413250e-02f, 4.869675264e-02f, 4.216965288e-02f, 3.651741147e-02f, 3.162277490e-02f, 2.738419734e-02f, 2.371373773e-02f, 2.053525113e-02f, 1.778279431e-02f, 1.539926510e-02f, 1.333521493e-02f, 1.154782064e-02f, 9.999999776e-03f, 8.659643121e-03f, 7.498941850e-03f, 6.493816152e-03f, 5.623413250e-03f, 4.869675264e-03f, 4.216964822e-03f, 3.651741194e-03f, 3.162277630e-03f, 2.738419687e-03f, 2.371373586e-03f, 2.053524833e-03f, 1.778279431e-03f, 1.539926510e-03f, 1.333521446e-03f, 1.154781901e-03f, 1.000000047e-03f, 8.659643354e-04f, 7.498942432e-04f, 6.493816618e-04f, 5.623413017e-04f, 4.869675322e-04f, 4.216965172e-04f, 3.651741426e-04f, 3.162277571e-04f, 2.738419571e-04f, 2.371373703e-04f, 2.053525095e-04f, 1.778279402e-04f, 1.539926452e-04f, 1.333521504e-04f, 1.154782003e-04f};

__device__ __forceinline__ const float* in_ptr(LAS unsigned char* lds, int k) {
    const unsigned long long v = ((volatile LAS unsigned long long*)(lds + INPTR_LDS_OFF))[k];
    const unsigned lo = __builtin_amdgcn_readfirstlane((unsigned)v), hi = __builtin_amdgcn_readfirstlane((unsigned)(v >> 32));
    return (const float*)(((unsigned long long)hi << 32) | lo);
}

__device__ __forceinline__ void gla_simple_phase(LAS unsigned char* ldsb, int vcu, const bf16* q, const bf16* k, const bf16* v, const bf16* g, const float* Bc, const float* normw, bf16* GO) {
    if (vcu >= BATCH * GH) return;
    int tid = threadIdx.x; asm volatile("" : "+v"(tid));
    LAS float* as_ = (LAS float*)ldsb; LAS float* ks_ = as_ + 256; LAS float* qs_ = ks_ + 256; LAS float* red = qs_ + 256;
    const int vp = tid >> 2, qt = tid & 3, wv = tid >> 6, lane = tid & 63;
    const int b = vcu >> 2, h = vcu & 3;
    float S0[32], S1[32];
#pragma unroll
    for (int j = 0; j < 32; ++j) { S0[j] = 0.f; S1[j] = 0.f; }
    const float nw0 = normw[vp], nw1 = normw[vp + 128];
    for (int t = 0; t < SEQ; ++t) { const size_t row = (size_t)b * SEQ + t; const int bf = t & 1;
        if (tid < 128) { const float* bp = Bc + row * GKD + h * GDK + tid; const float la = bp[0] - ((t & 63) ? bp[-GKD] : 0.f);
            as_[bf * 128 + tid] = expf(la); ks_[bf * 128 + tid] = bf2f(k[row * GKD + h * GDK + tid]); qs_[bf * 128 + tid] = bf2f(q[row * GKD + h * GDK + tid]) * 0.08838834764831845f; }
        const float v0 = bf2f(v[row * GVD + h * GDV + vp]), v1 = bf2f(v[row * GVD + h * GDV + vp + 128]);
        __syncthreads();
        float o0 = 0.f, o1 = 0.f;
#pragma unroll
        for (int c = 0; c < 8; ++c) { const f32x4 a4 = *(const LAS f32x4*)&as_[bf * 128 + qt * 32 + 4 * c], k4 = *(const LAS f32x4*)&ks_[bf * 128 + qt * 32 + 4 * c], q4 = *(const LAS f32x4*)&qs_[bf * 128 + qt * 32 + 4 * c];
#pragma unroll
            for (int e = 0; e < 4; ++e) { const int j = 4 * c + e; S0[j] = a4[e] * S0[j] + k4[e] * v0; o0 += q4[e] * S0[j]; S1[j] = a4[e] * S1[j] + k4[e] * v1; o1 += q4[e] * S1[j]; } }
        o0 += __shfl_xor(o0, 1); o0 += __shfl_xor(o0, 2); o1 += __shfl_xor(o1, 1); o1 += __shfl_xor(o1, 2);
        float sq = qt == 0 ? o0 * o0 + o1 * o1 : 0.f; sq = wave_sum(sq);
        if (lane == 0) red[bf * 8 + wv] = sq;
        __syncthreads();
        float tot = 0.f;
#pragma unroll
        for (int w = 0; w < 8; ++w) tot += red[bf * 8 + w];
        const float rstd = 1.0f / sqrtf(tot * (1.0f / GDV) + EPS);
        if (qt == 0) { const float g0 = bf2f(g[row * GVD + h * GDV + vp]), g1 = bf2f(g[row * GVD + h * GDV + vp + 128]);
            GO[row * GVD + h * GDV + vp] = __builtin_bit_cast(unsigned short, (_Float16)(o0 * rstd * nw0 * (g0 / (1.0f + expf(-g0)))));
            GO[row * GVD + h * GDV + vp + 128] = __builtin_bit_cast(unsigned short, (_Float16)(o1 * rstd * nw1 * (g1 / (1.0f + expf(-g1))))); }
    }
}

#ifndef REP_EXTRA
#define REP_EXTRA 0
#endif
#ifndef REP_MASK
#define REP_MASK 0
#endif
struct Args { const float* in[13]; float* out; unsigned char* ws; int ph_lo, ph_hi, li, skip_mask; };

__global__ void __launch_bounds__(NWAVES * 64, 2) mega_fwd(Args args) {
    extern __shared__ __attribute__((aligned(16))) unsigned char lds[];
    Frame F;
    F.lds = (LAS unsigned char*)lds;
    F.MISC = (volatile LAS unsigned*)(F.lds + MISC_OFF);
    F.tid = threadIdx.x; F.lane = F.tid & 63; F.wave = __builtin_amdgcn_readfirstlane(F.tid >> 6);
    F.G = gridDim.x; { const int bx = blockIdx.x; F.vcu = (F.G % 8 == 0) ? (bx % 8) * (F.G / 8) + bx / 8 : bx; }
    unsigned char* ws = args.ws;
    F.ctl = (gu32*)(ws + WS_CTL);
    for (int u = F.tid; u < (LDS_BYTES - LDSCTL_OFF) / 4; u += NWAVES * 64) ((LAS unsigned*)(F.lds + LDSCTL_OFF))[u] = 0u;
    __syncthreads();
    const bool multi = (args.ph_hi - args.ph_lo) > 1;
    XcdBarrier bar; bar.bar = (unsigned*)(F.ctl + CW_BAR) + args.li * XCD_BAR_WORDS; bar.x = 0; bar.st = nullptr;
    if (multi) bar = xcd_barrier_post((unsigned*)(F.ctl + CW_BAR) + args.li * XCD_BAR_WORDS, F.MISC + 8);

    if (F.tid == 0) {
#pragma unroll
        for (int k = 0; k < 13; ++k) ((LAS unsigned long long*)(F.lds + INPTR_LDS_OFF))[k] = (unsigned long long)args.in[k]; }
    __syncthreads();
#define INP(k) in_ptr(F.lds, (k))
    float* const xres = args.out;
    float* const ssq = (float*)(ws + WS_SSQ);
    bf16* const XB = (bf16*)(ws + WS_XB);
    const int gw = F.vcu * NWAVES + F.wave, NGW = F.G * NWAVES;
    LAS float* const rl = (LAS float*)(F.lds + pg8::RSTD_LDS_OFF);

    for (int ph = args.ph_lo; ph < args.ph_hi; ++ph) {
      const int reps = 1 + ((args.skip_mask >> ph) & 1) * REP_EXTRA;
      for (int rp = 0; rp < reps; ++rp) {
        if (rp) xcd_barrier(bar);
        if (ph == PH_PRO) {
#ifndef NO_PRO
            int tid = threadIdx.x; asm volatile("" : "+v"(tid)); const int lane = tid & 63;
            LAS unsigned char* scr = F.lds + RING_OFF + F.wave * 16384;
            constexpr int I_QKV = 16 * 144, I_O = 16 * 16, I_UP = 16 * 64, I_DN = 64 * 16, I_GLA = 16 * 49;
            constexpr int NITEMS = I_QKV + 2 * I_O + 2 * I_UP + 2 * I_DN + I_GLA;
            for (int it = gw; it < NITEMS; it += NGW) {
                int r = it; const float* W; int ldn, K = DM, nvalid = 64, dst_row0, k0, n0; const float* nw = nullptr; bf16* WT;
                if (r < I_QKV) { const int kb = r / 144, nb = r % 144; n0 = nb * 64; const int nin = n0 % 3072, which = nin / 1024, j = nin % 1024;
                    const int jd = which < 2 ? ((j & ~0xC0) | ((j & 0x40) << 1) | ((j & 0x80) >> 1)) : j;
                    W = INP(4); ldn = AIN; nw = INP(1); WT = (bf16*)(ws + WS_WQKV); dst_row0 = n0 - j + jd; k0 = kb * 64; }
                else if ((r -= I_QKV) < I_O) { W = INP(5); ldn = DM; WT = (bf16*)(ws + WS_WO0); n0 = dst_row0 = (r % 16) * 64; k0 = (r / 16) * 64; }
                else if ((r -= I_O) < I_O) { W = INP(10); ldn = DM; WT = (bf16*)(ws + WS_WO1); n0 = dst_row0 = (r % 16) * 64; k0 = (r / 16) * 64; }
                else if ((r -= I_O) < I_UP) { W = INP(11); ldn = DFF; nw = INP(2); WT = (bf16*)(ws + WS_WUP0); n0 = dst_row0 = (r % 64) * 64; k0 = (r / 64) * 64; }
                else if ((r -= I_UP) < I_UP) { W = INP(11) + (size_t)DM * DFF; ldn = DFF; nw = INP(2) + DM; WT = (bf16*)(ws + WS_WUP1); n0 = dst_row0 = (r % 64) * 64; k0 = (r / 64) * 64; }
                else if ((r -= I_UP) < I_DN) { W = INP(12); ldn = DM; K = DFF; WT = (bf16*)(ws + WS_WDN0); n0 = dst_row0 = (r % 16) * 64; k0 = (r / 16) * 64; }
                else if ((r -= I_DN) < I_DN) { W = INP(12) + (size_t)DFF * DM; ldn = DM; K = DFF; WT = (bf16*)(ws + WS_WDN1); n0 = dst_row0 = (r % 16) * 64; k0 = (r / 16) * 64; }
                else { r -= I_DN; const int kb = r / 49, nb = r % 49; W = INP(6); ldn = GIN; nw = INP(1) + DM; k0 = kb * 64; n0 = nb * 64;
                    if (nb < 48) { WT = (bf16*)(ws + WS_WGLA); dst_row0 = n0; } else { WT = (bf16*)(ws + WS_WG); dst_row0 = 0; nvalid = 16; } }
                xpose_item(W, ldn, K, nw, WT, dst_row0, k0, n0, nvalid, scr, lane);
            }
            { bf16* cosT = (bf16*)(ws + WS_COS); bf16* sinT = (bf16*)(ws + WS_SIN);
              for (int e = blockIdx.x * (NWAVES * 64) + tid; e < SEQ * 64; e += F.G * NWAVES * 64) { const int pos = e >> 6, i = e & 63;
                  const float ang = (float)pos * ROPE_INVF[i]; float sn, cs; sincos_f(ang, sn, cs); cosT[e] = __builtin_bit_cast(unsigned short, (_Float16)cs); sinT[e] = __builtin_bit_cast(unsigned short, (_Float16)sn); } }
            const float* x_in = INP(0);
            for (int m0 = 4 * gw; m0 < MTOK; m0 += 4 * NGW) {
                f32x4 v[4][4];
#pragma unroll
                for (int q = 0; q < 4; ++q) { const GAS f32x4* xr = (const GAS f32x4*)(x_in + (size_t)(m0 + q) * DM) + lane;
#pragma unroll
                    for (int j = 0; j < 4; ++j) v[q][j] = xr[64 * j]; }
#pragma unroll
                for (int q = 0; q < 4; ++q) { float s = 0.f; GAS unsigned long long* o8 = (GAS unsigned long long*)(XB + (size_t)(m0 + q) * DM) + lane;
#pragma unroll
                    for (int j = 0; j < 4; ++j) { const f32x4 w = v[q][j]; s += (w.x * w.x + w.y * w.y) + (w.z * w.z + w.w * w.w);
                        o8[64 * j] = (unsigned long long)pkh(w.x, w.y) | ((unsigned long long)pkh(w.z, w.w) << 32); }
                    s = wave_sum(s); if (lane < 16) ssq[(size_t)(m0 + q) * 16 + lane] = lane == 0 ? s : 0.f; } }
#endif
        }
        else if (ph == PH_QKV0 || ph == PH_QKV1 || ph == PH_QKV2) {
            const int g = (ph - PH_QKV0) >> 1;
            pg8::Gemm gm{XB, (const bf16*)(ws + WS_WQKV) + (size_t)g * 3072 * DM, MTOK, 3072, DM}; pg8::RstdOrder S; S.init(MTOK, 3072, F.G, (int)blockIdx.x); S.ssq = ssq; S.rl = rl;
            pg8::EpiQKV E{(bf16*)(ws + WS_Q), (bf16*)(ws + WS_K), (bf16*)(ws + WS_V), rl, (const bf16*)(ws + WS_COS), (const bf16*)(ws + WS_SIN), g == 0 ? 0 : (g == 1 ? 2 : 4)};
#ifndef NO_QKV
            pg8::gemm_phase<pg8::EpiQKV, pg8::RstdOrder, true, true>(F.lds + RING_OFF, gm, S, E);
#endif
        }
        else if (ph == PH_ATT0 || ph == PH_ATT1 || ph == PH_ATT2) {
            const int g = (ph - PH_ATT0) >> 1;
#if ATTN_DMA
            swa::attn_phase_dma((char*)lds, F.vcu, g == 0 ? 0 : (g == 1 ? 2 : 4), (const swa::u16*)(ws + WS_Q), (const swa::u16*)(ws + WS_K), (const swa::u16*)(ws + WS_V), (swa::u16*)(ws + WS_OM), (float*)(ws + WS_LSE), g == 0);
#else
            swa::attn_phase((char*)lds, F.vcu, F.G, g == 0 ? 0 : (g == 1 ? 2 : 4), (const swa::u16*)(ws + WS_Q), (const swa::u16*)(ws + WS_K), (const swa::u16*)(ws + WS_V), (swa::u16*)(ws + WS_OM), (float*)(ws + WS_LSE), g == 0);
#endif
        }
        else if (ph == PH_WO0 || ph == PH_DN0 || ph == PH_WO1 || ph == PH_DN1) {
            const bf16* A; const bf16* Bt; int K; const float* resid = xres; bf16* xbo = XB;
            if (ph == PH_WO0) { A = (const bf16*)(ws + WS_OM); Bt = (const bf16*)(ws + WS_WO0); K = DM; resid = INP(0); }
            else if (ph == PH_DN0) { A = (const bf16*)(ws + WS_H); Bt = (const bf16*)(ws + WS_WDN0); K = DFF; }
            else if (ph == PH_WO1) { A = XB; Bt = (const bf16*)(ws + WS_WO1); K = DM; xbo = (bf16*)(ws + WS_XB1); }
            else { A = (const bf16*)(ws + WS_H); Bt = (const bf16*)(ws + WS_WDN1); K = DFF; }
            pg8::Gemm gm{A, Bt, MTOK, DM, K}; pg8::PlainOrder S; S.init(MTOK, DM, F.G, (int)blockIdx.x);
            pg8::EpiResid E{resid, xres, xbo, ssq};
#ifndef NO_RES
            pg8::gemm_phase<pg8::EpiResid, pg8::PlainOrder, false, true>(F.lds + RING_OFF, gm, S, E);
#endif
        }
        else if (ph == PH_UP0 || ph == PH_UP1) {
            const bf16* A = ph == PH_UP0 ? XB : (const bf16*)(ws + WS_XB1);
            pg8::Gemm gm{A, (const bf16*)(ws + (ph == PH_UP0 ? WS_WUP0 : WS_WUP1)), MTOK, DFF, DM}; pg8::RstdOrder S; S.init(MTOK, DFF, F.G, (int)blockIdx.x); S.ssq = ssq; S.rl = rl;
            pg8::EpiUp E{(bf16*)(ws + WS_H), rl};
#ifndef NO_UP
            pg8::gemm_phase<pg8::EpiUp, pg8::RstdOrder, true, true>(F.lds + RING_OFF, gm, S, E);
#endif
        }
        else if (ph == PH_GLAP) {
            { pg8::Gemm gm{XB, (const bf16*)(ws + WS_WGLA), MTOK, 3072, DM}; pg8::RstdOrder S; S.init(MTOK, 3072, F.G, (int)blockIdx.x); S.ssq = ssq; S.rl = rl;
              pg8::EpiGla E{(bf16*)(ws + WS_GQ), (bf16*)(ws + WS_GK), (bf16*)(ws + WS_GV), (bf16*)(ws + WS_GG), rl};
#ifndef NO_GLAP
              pg8::gemm_phase<pg8::EpiGla, pg8::RstdOrder, true, true>(F.lds + RING_OFF, gm, S, E);
#endif
 }
#ifndef NO_GATE
            __syncthreads();
            int tid = threadIdx.x; asm volatile("" : "+v"(tid)); const int lane = tid & 63;
            { LAS float* Pp = (LAS float*)(F.lds + RING_OFF);
              LAS float* Rr = Pp + 2048;
              LAS float* Gg = Pp + 2048 + 64;
              const bf16* WG = (const bf16*)(ws + WS_WG); const float* wgu = INP(7); const float* bg = INP(8); float* GB = (float*)(ws + WS_GB);
              for (int ch = F.vcu; ch < MTOK / GCH; ch += F.G) {
                  { const int mt = F.wave & 3, kh = F.wave >> 2, fr = lane & 15, fq = lane >> 4;
                    const GAS v4u* ap = (const GAS v4u*)(XB + (size_t)(ch * GCH + 16 * mt + fr) * DM + 512 * kh + 8 * fq);
                    const GAS v4u* bp = (const GAS v4u*)(WG + (size_t)fr * DM + 512 * kh + 8 * fq);
                    f32x4 acc = {0.f, 0.f, 0.f, 0.f};
#pragma unroll 8
                    for (int ks = 0; ks < 16; ++ks) { const v4u av = ap[4 * ks], bv = bp[4 * ks];
                        acc = __builtin_amdgcn_mfma_f32_16x16x32_f16(__builtin_bit_cast(pg8::f16x8, av), __builtin_bit_cast(pg8::f16x8, bv), acc, 0, 0, 0); }
#pragma unroll
                    for (int r = 0; r < 4; ++r) Pp[(kh * 64 + 16 * mt + 4 * fq + r) * 16 + fr] = acc[r];
                    if (tid < 64) { const f32x4* sp = (const f32x4*)(ssq + (size_t)(ch * GCH + tid) * 16); const f32x4 s0 = sp[0], s1 = sp[1], s2 = sp[2], s3 = sp[3];
                        const float sq = (((s0[0] + s0[1]) + (s0[2] + s0[3])) + ((s1[0] + s1[1]) + (s1[2] + s1[3]))) + (((s2[0] + s2[1]) + (s2[2] + s2[3])) + ((s3[0] + s3[1]) + (s3[2] + s3[3])));
                        Rr[tid] = 1.0f / sqrtf(sq * (1.0f / DM) + EPS); } }
                  LDS_WAIT(); __syncthreads();
                  { const int t = tid >> 3, j0 = (tid & 7) * 2; const float rs = Rr[t];
                    Gg[t * 16 + j0] = (Pp[t * 16 + j0] + Pp[1024 + t * 16 + j0]) * rs; Gg[t * 16 + j0 + 1] = (Pp[t * 16 + j0 + 1] + Pp[1024 + t * 16 + j0 + 1]) * rs; }
                  LDS_WAIT(); __syncthreads();
                  { const int c = tid; float wv[GRANK];
#pragma unroll
                    for (int j = 0; j < GRANK; ++j) wv[j] = wgu[j * GKD + c];
                    const float bc = bg[c]; float run = 0.f; float* gbp = GB + (size_t)(ch * GCH) * GKD + c;
#pragma unroll 4
                    for (int t = 0; t < GCH; ++t) { const f32x4 g0 = *(const LAS f32x4*)(Gg + t * 16), g1 = *(const LAS f32x4*)(Gg + t * 16 + 4), g2 = *(const LAS f32x4*)(Gg + t * 16 + 8), g3 = *(const LAS f32x4*)(Gg + t * 16 + 12);
                        float gk = bc;
#pragma unroll
                        for (int e = 0; e < 4; ++e) { gk += g0[e] * wv[e]; gk += g1[e] * wv[4 + e]; gk += g2[e] * wv[8 + e]; gk += g3[e] * wv[12 + e]; }
                        const float ls = fminf(gk, 0.f) - __logf(1.0f + __expf(-fabsf(gk)));
                        run += ls * (1.0f / 16.0f); gbp[(size_t)t * GKD] = run; } }
                  __syncthreads();
              } }
#endif
        }
        else if (ph == PH_GLA1 || ph == PH_GLA2 || ph == PH_GLA3) {
#if GLA_SIMPLE
            if (ph == PH_GLA3) gla_simple_phase(F.lds + RING_OFF, F.vcu, (const bf16*)(ws + WS_GQ), (const bf16*)(ws + WS_GK), (const bf16*)(ws + WS_GV), (const bf16*)(ws + WS_GG), (const float*)(ws + WS_GB), INP(9), XB);
#else
            const gla::Tensors T{(const bf16*)(ws + WS_GQ), (const bf16*)(ws + WS_GK), (const bf16*)(ws + WS_GV), (const bf16*)(ws + WS_GG), (const float*)(ws + WS_GB), INP(9), (float*)(ws + WS_GS), (float*)(ws + WS_GD), XB};
            if (ph == PH_GLA1) gla::gla1_phase(F.lds + RING_OFF, F.vcu, T);
            else if (ph == PH_GLA2) gla::gla2_phase(F.vcu, F.G, T);
            else gla::gla3_phase(F.lds + RING_OFF, F.vcu, T);
#endif
        }
        else if (ph == PH_FIN) {
            int tid = threadIdx.x; asm volatile("" : "+v"(tid)); const int lane = tid & 63;
            const float* final_w = INP(3);
            f32x4 fw[4];
#pragma unroll
            for (int j = 0; j < 4; ++j) fw[j] = *((const f32x4*)final_w + lane + 64 * j);
            for (int m0 = 4 * gw; m0 < MTOK; m0 += 4 * NGW) {
                f32x4 v[4][4];
#pragma unroll
                for (int q = 0; q < 4; ++q) { const GAS f32x4* xr = (const GAS f32x4*)(xres + (size_t)(m0 + q) * DM) + lane;
#pragma unroll
                    for (int j = 0; j < 4; ++j) v[q][j] = xr[64 * j]; }
#pragma unroll
                for (int q = 0; q < 4; ++q) { float s = 0.f; GAS f32x4* xr = (GAS f32x4*)(xres + (size_t)(m0 + q) * DM) + lane;
#pragma unroll
                    for (int j = 0; j < 4; ++j) s += (v[q][j].x * v[q][j].x + v[q][j].y * v[q][j].y) + (v[q][j].z * v[q][j].z + v[q][j].w * v[q][j].w);
                    const float rstd = 1.0f / sqrtf(wave_sum(s) * (1.0f / DM) + EPS);
#pragma unroll
                    for (int j = 0; j < 4; ++j) xr[64 * j] = v[q][j] * rstd * fw[j]; } }
        }
      }
      if (ph + 1 < args.ph_hi) xcd_barrier(bar);
    }
}

__global__ void __launch_bounds__(256) naive_attn(const bf16* __restrict__ Q, const bf16* __restrict__ K, const bf16* __restrict__ V, bf16* OM, float* LSE, int g, int ldil) {
    __shared__ float qs[4][128];
    const int lane = threadIdx.x & 63, wv = threadIdx.x >> 6;
    const int item = blockIdx.x * 4 + wv, row = item >> 3, h = item & 7;
    const int b = row >> 13, t = row & (SEQ - 1), r = t & ((1 << ldil) - 1), i = t >> ldil, L = SEQ >> ldil;
    const size_t base = (size_t)((((b * AH + h) << ldil) + r)) * L;
    const bf16* Qr = Q + (base + i) * HD; const bf16* Ks = K + base * HD; const bf16* Vs = V + base * HD;
    qs[wv][lane] = h2f(Qr[lane]); qs[wv][lane + 64] = h2f(Qr[lane + 64]);
    __syncthreads();
    float sc[3];
#pragma unroll
    for (int sl = 0; sl < 3; ++sl) { const int jj = lane + 64 * sl; float s = -INFINITY;
        if (jj <= 128 && i - jj >= 0) { const v4u* kp = (const v4u*)(Ks + (size_t)(i - jj) * HD); s = 0.f;
            for (int c = 0; c < 16; ++c) { const v4u kv = kp[c];
#pragma unroll
                for (int e = 0; e < 4; ++e) s += qs[wv][8 * c + 2 * e] * hlo(kv[e]) + qs[wv][8 * c + 2 * e + 1] * hhi(kv[e]); }
            s *= 0.08838834764831845f; }
        sc[sl] = s; }
    float m = fmaxf(fmaxf(sc[0], sc[1]), sc[2]);
#pragma unroll
    for (int o = 1; o < 64; o <<= 1) m = fmaxf(m, __shfl_xor(m, o));
    float p[3], l = 0.f;
#pragma unroll
    for (int sl = 0; sl < 3; ++sl) { p[sl] = expf(sc[sl] - m); l += p[sl]; }
    l = wave_sum(l);
    float o0 = 0.f, o1 = 0.f;
#pragma unroll
    for (int sl = 0; sl < 3; ++sl)
        for (int ll = 0; ll < 64; ++ll) { const int jj = sl * 64 + ll; if (jj > 128 || i - jj < 0) break;
            const float pj = __shfl(p[sl], ll); const unsigned vv = ((const unsigned*)(Vs + (size_t)(i - jj) * HD))[lane];
            o0 += pj * hlo(vv); o1 += pj * hhi(vv); }
    o0 /= l; o1 /= l; float lse = m + logf(l);
    unsigned* op = (unsigned*)(OM + (size_t)row * DM + h * HD) + lane;
    if (g > 0) { const float lo = LSE[(size_t)row * 8 + h]; const unsigned ov = *op; const float mx = fmaxf(lo, lse), wo = expf(lo - mx), wn = expf(lse - mx), inv = 1.0f / (wo + wn);
        o0 = (wo * hlo(ov) + wn * o0) * inv; o1 = (wo * hhi(ov) + wn * o1) * inv; lse = mx + logf(wo + wn); }
    *op = pkh(o0, o1);
    if (lane == 0) LSE[(size_t)row * 8 + h] = lse;
}
__global__ void __launch_bounds__(1024) naive_gla(const bf16* __restrict__ q, const bf16* __restrict__ k, const bf16* __restrict__ v, const bf16* __restrict__ g, const float* __restrict__ Bc,
                                                    const float* __restrict__ normw, bf16* GO) {
    __shared__ float red[2][16];
    __shared__ __attribute__((aligned(16))) float as_[2][128], ks_[2][128], qs_[2][128];
    const int tid = threadIdx.x, vloc = tid >> 2, qt = tid & 3, wv = tid >> 6, lane = tid & 63;
    const int b = blockIdx.x >> 2, h = blockIdx.x & 3;
    float S[32];
#pragma unroll
    for (int j = 0; j < 32; ++j) S[j] = 0.f;
    const float nw = normw[vloc];
    for (int t = 0; t < SEQ; ++t) { const size_t row = (size_t)b * SEQ + t; const int bf = t & 1;
        if (tid < 128) { const float* bp = Bc + row * GKD + h * GDK + tid; const float la = bp[0] - ((t & 63) ? bp[-GKD] : 0.f);
            as_[bf][tid] = expf(la); ks_[bf][tid] = bf2f(k[row * GKD + h * GDK + tid]); qs_[bf][tid] = bf2f(q[row * GKD + h * GDK + tid]) * 0.08838834764831845f; }
        const float vv = bf2f(v[row * GVD + h * GDV + vloc]);
        __syncthreads();
        float o = 0.f;
#pragma unroll
        for (int c = 0; c < 8; ++c) { const f32x4 a4 = *(const f32x4*)&as_[bf][qt * 32 + 4 * c], k4 = *(const f32x4*)&ks_[bf][qt * 32 + 4 * c], q4 = *(const f32x4*)&qs_[bf][qt * 32 + 4 * c];
#pragma unroll
            for (int e = 0; e < 4; ++e) { const int j = 4 * c + e; S[j] = a4[e] * S[j] + k4[e] * vv; o += q4[e] * S[j]; } }
        o += __shfl_xor(o, 1); o += __shfl_xor(o, 2);
        float sq = qt == 0 ? o * o : 0.f; sq = wave_sum(sq);
        if (lane == 0) red[bf][wv] = sq;
        __syncthreads();
        float tot = 0.f;
#pragma unroll
        for (int w = 0; w < 16; ++w) tot += red[bf][w];
        const float rstd = 1.0f / sqrtf(tot * (1.0f / GDV) + EPS);
        if (qt == 0) { const float gg = bf2f(g[row * GVD + h * GDV + vloc]); const float y = o * rstd * nw * (gg / (1.0f + expf(-gg))); GO[row * GVD + h * GDV + vloc] = __builtin_bit_cast(unsigned short, (_Float16)y); }
    }
}


__global__ void __launch_bounds__(256) probe_maxdiff_h(const unsigned short* a, const unsigned short* b, size_t n, unsigned* slot) {
    float m = 0.f;
    for (size_t i = (size_t)blockIdx.x * 256 + threadIdx.x; i < n; i += (size_t)gridDim.x * 256) { const float d = fabsf(h2f(a[i]) - h2f(b[i])); m = (d > m || d != d) ? (d != d ? 1e30f : d) : m; }
#pragma unroll
    for (int o = 1; o < 64; o <<= 1) m = fmaxf(m, __shfl_xor(m, o));
    if ((threadIdx.x & 63) == 0) atomicMax(slot, __float_as_uint(m));
}
__global__ void __launch_bounds__(256) probe_maxdiff_f(const float* a, const float* b, size_t n, unsigned* slot) {
    float m = 0.f;
    for (size_t i = (size_t)blockIdx.x * 256 + threadIdx.x; i < n; i += (size_t)gridDim.x * 256) { const float d = fabsf(a[i] - b[i]); m = (d > m || d != d) ? (d != d ? 1e30f : d) : m; }
#pragma unroll
    for (int o = 1; o < 64; o <<= 1) m = fmaxf(m, __shfl_xor(m, o));
    if ((threadIdx.x & 63) == 0) atomicMax(slot, __float_as_uint(m));
}
__global__ void __launch_bounds__(256) probe_encode(float* out, size_t n, const unsigned* slot, float scale) {
    const float d = sqrtf(scale * __uint_as_float(*slot));
    for (size_t i = (size_t)blockIdx.x * 256 + threadIdx.x; i < n; i += (size_t)gridDim.x * 256) out[i] += d;
}

#ifndef MK_MODE
#define MK_MODE 2
#endif
extern "C" void kernel_launch(void* const* d_in, const int* in_sizes, int n_in, void* d_out, int out_size, void* d_ws, size_t ws_size, hipStream_t stream) {
    static int grid = 0;
    if (grid == 0) {
        if (n_in != 13 || in_sizes[0] != MTOK * DM || out_size != MTOK * DM || ws_size < WS_END) { fprintf(stderr, "kernel_launch: unexpected shapes (n_in %d, in0 %d, out %d, ws %zu); nothing launched\n", n_in, n_in > 0 ? in_sizes[0] : -1, out_size, ws_size); grid = -1; return; }
        int dev = 0, cus = 0;
        if (hipGetDevice(&dev) != hipSuccess || hipDeviceGetAttribute(&cus, hipDeviceAttributeMultiprocessorCount, dev) != hipSuccess) { grid = -1; return; }
        if (hipFuncSetAttribute((const void*)mega_fwd, hipFuncAttributeMaxDynamicSharedMemorySize, LDS_BYTES) != hipSuccess) { fprintf(stderr, "kernel_launch: hipFuncSetAttribute failed\n"); grid = -1; return; }
        (void)hipGetLastError();
        grid = cus;
        if (grid != 256) fprintf(stderr, "kernel_launch: %d CUs (built for 256)\n", grid);
    }
    if (grid < 0) return;
    unsigned char* ws = (unsigned char*)d_ws;
    (void)hipMemsetAsync(ws + WS_CTL, 0, CTL_ZERO_BYTES, stream);
    Args a{};
    for (int i = 0; i < 13; ++i) a.in[i] = (const float*)d_in[i];
    a.out = (float*)d_out; a.ws = ws;
#define MEGA(lo, hi, li_) do { a.ph_lo = (lo); a.ph_hi = (hi); a.li = (li_); hipLaunchKernelGGL(mega_fwd, dim3(grid), dim3(NWAVES * 64), LDS_BYTES, stream, a); } while (0)
#if MK_MODE == 0 || MK_MODE == 1
    a.skip_mask = 0;
    MEGA(PH_PRO, PH_PRO + 1, 0);
    for (int g = 0; g < NGRP; ++g) { MEGA(PH_QKV0 + 2 * g, PH_QKV0 + 2 * g + 1, 0);
#if MK_MODE == 0
        hipLaunchKernelGGL(naive_attn, dim3(MTOK * AH / 4), dim3(256), 0, stream, (const bf16*)(ws + WS_Q), (const bf16*)(ws + WS_K), (const bf16*)(ws + WS_V), (bf16*)(ws + WS_OM), (float*)(ws + WS_LSE), g, grp_ldil(g));
#else
        MEGA(PH_ATT0 + 2 * g, PH_ATT0 + 2 * g + 1, 0);
#endif
    }
    MEGA(PH_WO0, PH_WO0 + 1, 0); MEGA(PH_UP0, PH_UP0 + 1, 0); MEGA(PH_DN0, PH_DN0 + 1, 0); MEGA(PH_GLAP, PH_GLAP + 1, 0);
    hipLaunchKernelGGL(naive_gla, dim3(BATCH * GH), dim3(1024), 0, stream, (const bf16*)(ws + WS_GQ), (const bf16*)(ws + WS_GK), (const bf16*)(ws + WS_GV), (const bf16*)(ws + WS_GG), (const float*)(ws + WS_GB),
                       (const float*)d_in[9], (bf16*)(ws + WS_XB));
    MEGA(PH_WO1, PH_WO1 + 1, 0); MEGA(PH_UP1, PH_UP1 + 1, 0); MEGA(PH_DN1, PH_DN1 + 1, 0); MEGA(PH_FIN, PH_FIN + 1, 0);
#elif MK_MODE == 3
    a.skip_mask = 0;
    unsigned* slot = (unsigned*)(ws + WS_CTL) + 2048; unsigned* slot2 = slot + 64;
    unsigned short* OM2 = (unsigned short*)d_out; float* LSE2 = (float*)((char*)d_out + 48 * MiB);
    MEGA(PH_PRO, PH_PRO + 1, 0);
    for (int g = 0; g < NGRP; ++g) { MEGA(PH_QKV0 + 2 * g, PH_QKV0 + 2 * g + 1, 0);
        hipLaunchKernelGGL(naive_attn, dim3(MTOK * AH / 4), dim3(256), 0, stream, (const bf16*)(ws + WS_Q), (const bf16*)(ws + WS_K), (const bf16*)(ws + WS_V), (bf16*)OM2, LSE2, g, grp_ldil(g));
        MEGA(PH_ATT0 + 2 * g, PH_ATT0 + 2 * g + 1, 0); }
    hipLaunchKernelGGL(probe_maxdiff_h, dim3(2048), dim3(256), 0, stream, (const unsigned short*)(ws + WS_OM), (const unsigned short*)OM2, (size_t)MTOK * DM, slot);
    hipLaunchKernelGGL(probe_maxdiff_f, dim3(256), dim3(256), 0, stream, (const float*)(ws + WS_LSE), (const float*)LSE2, (size_t)MTOK * 8, slot2);
    MEGA(PH_WO0, PH_WO0 + 1, 0); MEGA(PH_UP0, PH_UP0 + 1, 0); MEGA(PH_DN0, PH_DN0 + 1, 0); MEGA(PH_GLAP, PH_GLAP + 1, 0);
    hipLaunchKernelGGL(naive_gla, dim3(BATCH * GH), dim3(1024), 0, stream, (const bf16*)(ws + WS_GQ), (const bf16*)(ws + WS_GK), (const bf16*)(ws + WS_GV), (const bf16*)(ws + WS_GG), (const float*)(ws + WS_GB),
                       (const float*)d_in[9], (bf16*)(ws + WS_XB));
    MEGA(PH_WO1, PH_WO1 + 1, 0); MEGA(PH_UP1, PH_UP1 + 1, 0); MEGA(PH_DN1, PH_DN1 + 1, 0); MEGA(PH_FIN, PH_FIN + 1, 0);
    hipLaunchKernelGGL(probe_encode, dim3(2048), dim3(256), 0, stream, (float*)d_out, (size_t)MTOK * DM, slot, 1.0f);
    hipLaunchKernelGGL(probe_encode, dim3(2048), dim3(256), 0, stream, (float*)d_out, (size_t)MTOK * DM, slot2, 1e-3f);
#elif MK_MODE == 4
    a.skip_mask = 0;
    unsigned* slot = (unsigned*)(ws + WS_CTL) + 2048;
    for (int p = PH_PRO; p <= PH_GLA3; ++p) MEGA(p, p + 1, 0);
    hipLaunchKernelGGL(naive_gla, dim3(BATCH * GH), dim3(1024), 0, stream, (const bf16*)(ws + WS_GQ), (const bf16*)(ws + WS_GK), (const bf16*)(ws + WS_GV), (const bf16*)(ws + WS_GG), (const float*)(ws + WS_GB),
                       (const float*)d_in[9], (bf16*)(ws + WS_GS));
    hipLaunchKernelGGL(probe_maxdiff_h, dim3(2048), dim3(256), 0, stream, (const unsigned short*)(ws + WS_XB), (const unsigned short*)(ws + WS_GS), (size_t)MTOK * DM, slot);
    MEGA(PH_WO1, PH_WO1 + 1, 0); MEGA(PH_UP1, PH_UP1 + 1, 0); MEGA(PH_DN1, PH_DN1 + 1, 0); MEGA(PH_FIN, PH_FIN + 1, 0);
    hipLaunchKernelGGL(probe_encode, dim3(2048), dim3(256), 0, stream, (float*)d_out, (size_t)MTOK * DM, slot, 1e-2f);
#else
    a.skip_mask = REP_MASK;
    MEGA(0, PH_N, 0);
#endif
#undef MEGA
}
```
